# Optimizing an MI355X kernel written in HIP

```python
import jax, jax.numpy as jnp
from jax import lax
import numpy as np

D_MODEL = 1024
BATCH = 8
SEQ = 8192
DEPTH = 1

N_META = 16
GRID_W = 64
DN_HEADS = 4
DN_HEAD_DIM = 128
DN_WIDTH = DN_HEADS * DN_HEAD_DIM
DN_CHUNK = 64
CONV_W = 5
AT_Q_HEADS = 8
AT_KV_HEADS = 2
AT_HEAD_DIM = 64
AT_WIDTH = AT_Q_HEADS * AT_HEAD_DIM
AT_KV_WIDTH = AT_KV_HEADS * AT_HEAD_DIM
Q_BLOCK = 128
ROPE_THETA = 10000.0
ROPE_AXIS_DIM = AT_HEAD_DIM // 2
D_FF = 4 * D_MODEL
EPS = 1e-6
MIX_WIDTH = DN_WIDTH + AT_WIDTH
IN_SIZES = (DN_WIDTH, DN_WIDTH, DN_WIDTH, DN_WIDTH, 2 * DN_HEADS, 2 * DN_HEADS, AT_WIDTH, AT_KV_WIDTH, AT_KV_WIDTH)
IN_COLS = 4 * DN_WIDTH + 4 * DN_HEADS + AT_WIDTH + 2 * AT_KV_WIDTH

kernel_name = "hymba_deltanet_axial_gqa_encoder_block"


def rms_norm(x, w):
    xf = x.astype(jnp.float32)
    y = xf * lax.rsqrt(jnp.mean(xf * xf, axis=-1, keepdims=True) + EPS)
    return (y * w.astype(jnp.float32)).astype(x.dtype)


def l2_norm(x):
    xf = x.astype(jnp.float32)
    return xf * lax.rsqrt(jnp.sum(xf * xf, axis=-1, keepdims=True) + EPS)


def short_conv_silu(x, w):
    C = x.shape[-1]
    y = lax.conv_general_dilated(
        x, w[:, None, :].astype(x.dtype), window_strides=(1,),
        padding=[(CONV_W // 2, CONV_W // 2)],
        dimension_numbers=('NWC', 'WIO', 'NWC'), feature_group_count=C)
    return jax.nn.silu(y)


def to_scan_order(a_fwd, a_bwd):
    pad = jnp.zeros((a_fwd.shape[0], DN_CHUNK - N_META) + a_fwd.shape[2:], a_fwd.dtype)
    fwd = jnp.concatenate([pad, a_fwd], axis=1)
    bwd = jnp.concatenate([pad, a_bwd[:, :N_META], jnp.flip(a_bwd[:, N_META:], axis=1)], axis=1)
    return jnp.concatenate([fwd, bwd], axis=0)


def chunk_gated_delta_rule(q, k, v, g, beta):
    N, T, H, K = q.shape
    V = v.shape[-1]
    C = DN_CHUNK
    n = T // C

    def chunks(a):
        return jnp.moveaxis(a.reshape((N, n, C, H) + a.shape[3:]), 3, 2)

    q, k, v, g, beta = chunks(q), chunks(k), chunks(v), chunks(g), chunks(beta)
    gc = jnp.cumsum(g, axis=-1)
    incl = jnp.tril(jnp.ones((C, C), dtype=bool))
    strict = jnp.tril(jnp.ones((C, C), dtype=bool), -1)
    decay = jnp.exp(jnp.where(incl, gc[..., :, None] - gc[..., None, :], -jnp.inf))
    kk = jnp.einsum('bnhik,bnhjk->bnhij', k, k)
    a_low = jnp.where(strict, kk * decay * beta[..., :, None], 0.0)
    rhs = jnp.concatenate([v * beta[..., None], k * (beta * jnp.exp(gc))[..., None]], axis=-1)
    uw = lax.linalg.triangular_solve(a_low + jnp.eye(C, dtype=a_low.dtype), rhs,
                                     left_side=True, lower=True, unit_diagonal=True)
    u, w = uw[..., :V], uw[..., V:]
    qk = jnp.einsum('bnhik,bnhjk->bnhij', q, k) * decay
    q_dec = q * jnp.exp(gc)[..., None]
    k_dec = k * jnp.exp(gc[..., -1:] - gc)[..., None]
    g_last = jnp.exp(gc[..., -1])

    def step(S, xs):
        q_i, k_i, u_i, w_i, qk_i, gl_i = xs
        v_new = u_i - jnp.einsum('bhck,bhkv->bhcv', w_i, S)
        o_i = jnp.einsum('bhck,bhkv->bhcv', q_i, S) + jnp.einsum('bhij,bhjv->bhiv', qk_i, v_new)
        S = S * gl_i[..., None, None] + jnp.einsum('bhck,bhcv->bhkv', k_i, v_new)
        return S, o_i

    xs = tuple(jnp.moveaxis(a, 1, 0) for a in (q_dec, k_dec, u, w, qk, g_last))
    S0 = jnp.zeros((N, H, K, V), jnp.float32)
    _, o = lax.scan(step, S0, xs)
    o = jnp.moveaxis(o, 0, 1)
    return jnp.moveaxis(o, 3, 2).reshape(N, T, H, V)


def gated_deltanet_group(q, k, v, z, b, a, conv_w, a_log, dt_bias, o_norm_w):
    B, L, _ = q.shape
    out_dtype = q.dtype
    qkv = short_conv_silu(jnp.concatenate([q, k, v], axis=-1), conv_w)
    q, k, v = jnp.split(qkv, 3, axis=-1)
    heads = lambda t: t.reshape(B, L, DN_HEADS, DN_HEAD_DIM)
    q = l2_norm(heads(q)) * (DN_HEAD_DIM ** -0.5)
    k = l2_norm(heads(k))
    v = heads(v).astype(jnp.float32)
    beta = jax.nn.sigmoid(b.astype(jnp.float32)).reshape(B, L, 2, DN_HEADS)
    g = -jnp.exp(a_log.astype(jnp.float32)) * jax.nn.softplus(
        a.astype(jnp.float32).reshape(B, L, 2, DN_HEADS) + dt_bias.astype(jnp.float32))
    o = chunk_gated_delta_rule(
        to_scan_order(q, q), to_scan_order(k, k), to_scan_order(v, v),
        to_scan_order(g[:, :, 0], g[:, :, 1]), to_scan_order(beta[:, :, 0], beta[:, :, 1]))
    pad = DN_CHUNK - N_META
    o_f = o[:B, pad:]
    o_b = o[B:, pad:]
    o_b = jnp.concatenate([o_b[:, :N_META], jnp.flip(o_b[:, N_META:], axis=1)], axis=1)
    o = o_f + o_b
    o = rms_norm(o, o_norm_w) * jax.nn.silu(heads(z).astype(jnp.float32))
    return o.reshape(B, L, DN_WIDTH).astype(out_dtype)


def axial_rope_angles(n_real):
    rows = n_real // GRID_W
    r, c = jnp.meshgrid(jnp.arange(rows), jnp.arange(GRID_W), indexing='ij')
    r = r.reshape(-1).astype(jnp.float32)
    c = c.reshape(-1).astype(jnp.float32)
    F = ROPE_AXIS_DIM // 2
    freqs = ROPE_THETA ** (-jnp.arange(F, dtype=jnp.float32) / F)
    ang = jnp.concatenate([r[:, None] * freqs, c[:, None] * freqs], axis=-1)
    return jnp.concatenate([jnp.zeros((N_META, 2 * F), jnp.float32), ang], axis=0)


def apply_axial_rope(x, ang):
    B, L, H, D = x.shape
    F = ROPE_AXIS_DIM // 2
    xr = x.astype(jnp.float32).reshape(B, L, H, 2, 2, F)
    x1, x2 = xr[..., 0, :], xr[..., 1, :]
    an = ang.reshape(L, 1, 2, F)
    cos, sin = jnp.cos(an), jnp.sin(an)
    out = jnp.stack([x1 * cos - x2 * sin, x2 * cos + x1 * sin], axis=-2)
    return out.reshape(B, L, H, D).astype(x.dtype)


def axial_gqa_group(q, k, v, q_norm_w, k_norm_w):
    B, L, _ = q.shape
    G = AT_Q_HEADS // AT_KV_HEADS
    n_real = L - N_META
    q = rms_norm(q.reshape(B, L, AT_Q_HEADS, AT_HEAD_DIM), q_norm_w)
    k = rms_norm(k.reshape(B, L, AT_KV_HEADS, AT_HEAD_DIM), k_norm_w)
    v = v.reshape(B, L, AT_KV_HEADS, AT_HEAD_DIM)
    ang = axial_rope_angles(n_real)
    q = apply_axial_rope(q, ang) * (AT_HEAD_DIM ** -0.5)
    k = apply_axial_rope(k, ang)
    q = q.reshape(B, L, AT_KV_HEADS, G, AT_HEAD_DIM)

    def attend(qb):
        s = jnp.einsum('bqhgd,bkhd->bhgqk', qb, k, preferred_element_type=jnp.float32)
        p = jax.nn.softmax(s, axis=-1).astype(v.dtype)
        return jnp.einsum('bhgqk,bkhd->bqhgd', p, v)

    o_meta = attend(q[:, :N_META]).reshape(B, N_META, AT_WIDTH)
    nb = n_real // Q_BLOCK
    qr = q[:, N_META:].reshape(B, nb, Q_BLOCK, AT_KV_HEADS, G, AT_HEAD_DIM)
    o_real = lax.map(attend, jnp.moveaxis(qr, 1, 0))
    o_real = jnp.moveaxis(o_real, 0, 1).reshape(B, n_real, AT_WIDTH)
    return jnp.concatenate([o_meta, o_real], axis=1)


def setup_inputs(seed: int = 0) -> dict:
    key = jax.random.key(seed)
    ks = jax.random.split(key, 20)
    f32 = jnp.float32
    nrm = lambda k_, shape, scale: jax.random.normal(k_, shape, f32) * scale
    gain = lambda k_, shape: 1.0 + 0.02 * jax.random.normal(k_, shape, f32)
    x = jax.random.normal(ks[0], (BATCH, SEQ, D_MODEL), f32)
    meta_tokens = nrm(ks[1], (N_META, D_MODEL), 1.0)
    w_in = nrm(ks[2], (DEPTH, D_MODEL, IN_COLS), D_MODEL ** -0.5)
    conv_w = nrm(ks[3], (DEPTH, CONV_W, 3 * DN_WIDTH), CONV_W ** -0.5)
    a_log = jnp.log(jax.random.uniform(ks[4], (DEPTH, 2, DN_HEADS), f32, 1.0, 16.0))
    dt = jnp.exp(jax.random.uniform(ks[5], (DEPTH, 2, DN_HEADS), f32, np.log(1e-3), np.log(1e-1)))
    dt_bias = dt + jnp.log(-jnp.expm1(-dt))
    dn_out_norm = gain(ks[6], (DEPTH, DN_HEAD_DIM))
    q_norm = gain(ks[7], (DEPTH, AT_HEAD_DIM))
    k_norm = gain(ks[8], (DEPTH, AT_HEAD_DIM))
    w_out = nrm(ks[9], (DEPTH, MIX_WIDTH, D_MODEL), MIX_WIDTH ** -0.5)
    norm_mix_pre = gain(ks[10], (DEPTH, D_MODEL))
    norm_mix_post = gain(ks[11], (DEPTH, D_MODEL))
    w_up = nrm(ks[12], (DEPTH, D_MODEL, D_FF), D_MODEL ** -0.5)
    w_down = nrm(ks[13], (DEPTH, D_FF, D_MODEL), D_FF ** -0.5)
    norm_mlp_pre = gain(ks[14], (DEPTH, D_MODEL))
    norm_mlp_post = gain(ks[15], (DEPTH, D_MODEL))
    return {"x": x, "meta_tokens": meta_tokens, "w_in": w_in, "conv_w": conv_w,
            "a_log": a_log, "dt_bias": dt_bias, "dn_out_norm": dn_out_norm,
            "q_norm": q_norm, "k_norm": k_norm, "w_out": w_out,
            "norm_mix_pre": norm_mix_pre, "norm_mix_post": norm_mix_post,
            "w_up": w_up, "w_down": w_down,
            "norm_mlp_pre": norm_mlp_pre, "norm_mlp_post": norm_mlp_post}


def reference(x, meta_tokens, w_in, conv_w, a_log, dt_bias, dn_out_norm, q_norm, k_norm, w_out,
              norm_mix_pre, norm_mix_post, w_up, w_down, norm_mlp_pre, norm_mlp_post):
    B = x.shape[0]
    split_points = [int(s) for s in np.cumsum(IN_SIZES)[:-1]]
    meta = jnp.broadcast_to(meta_tokens[None].astype(x.dtype), (B, N_META, D_MODEL))
    h = jnp.concatenate([meta, x], axis=1)
    for l in range(DEPTH):
        u = rms_norm(h, norm_mix_pre[l])
        proj = u @ w_in[l]
        dq, dk, dv, dz, db, da, aq, ak, av = jnp.split(proj, split_points, axis=-1)
        o_dn = gated_deltanet_group(dq, dk, dv, dz, db, da, conv_w[l], a_log[l], dt_bias[l], dn_out_norm[l])
        o_at = axial_gqa_group(aq, ak, av, q_norm[l], k_norm[l])
        mix = jnp.concatenate([o_dn, o_at.astype(o_dn.dtype)], axis=-1) @ w_out[l]
        h = h + rms_norm(mix, norm_mix_post[l])
        u = rms_norm(h, norm_mlp_pre[l])
        f = jnp.square(jax.nn.relu(u @ w_up[l])) @ w_down[l]
        h = h + rms_norm(f, norm_mlp_post[l])
    return h[:, N_META:]
```

```cpp
#include <hip/hip_runtime.h>
#include <cstdio>
#include <cstdint>
namespace pg8 {
#define PG8_LAS __attribute__((address_space(3)))
typedef unsigned short bf16_t;
typedef short bf16x8 __attribute__((ext_vector_type(8)));
typedef float f32x4 __attribute__((ext_vector_type(4)));
typedef unsigned u32x4 __attribute__((ext_vector_type(4)));
constexpr int BM = 256, BK = 64, HALF = 128, HTB = HALF * BK * 2  , STAGE_BYTES = 8 * HTB, NXCD = 8, WGM = 8;

__host__ __device__ __forceinline__ int lds_byte(int r, int c) { const int st = (r >> 4) * 2 + (c >> 5), rr = r & 15, cc = c & 31, ob = rr * 64 + cc * 2; return st * 1024 + (ob ^ (((ob >> 9) & 1) << 5)); }
__host__ __device__ __forceinline__ void stage_rc(int b, int& R, int& C) { const int st = b / 1024, sb = b % 1024, swz = sb ^ (((sb >> 9) & 1) << 5); R = (st >> 1) * 16 + swz / 64; C = (st & 1) * 32 + (swz % 64) / 2; }
__host__ __device__ __forceinline__ int perm32(int rho) { const int n = rho >> 4, i = rho & 15; return 8 * (i >> 2) + 4 * n + (i & 3); }

struct Unit { int pm, pn; };
struct Gemm { const bf16_t* A; const bf16_t* Bt; int M, N, K; };

struct StaticOrder {
    int nM, nN, nwg, G, c;
    __host__ __device__ void init(int M, int N, int G_, int c_) { nM = M / BM; nN = N / BM; nwg = nM * nN; G = G_; c = c_; }
    __host__ __device__ bool next(int i, Unit& u) const {
        const long L = (long)i * G + c; if (L >= nwg) return false;
        int wgid = (int)L; { const int q = nwg / NXCD, r = nwg % NXCD, xcd = wgid % NXCD, off = wgid / NXCD; wgid = (xcd < r ? xcd * (q + 1) : r * (q + 1) + (xcd - r) * q) + off; }
        const int nig = WGM * nN, gid = wgid / nig, fm = gid * WGM, gsz = (nM - fm) < WGM ? (nM - fm) : WGM;
        u.pm = fm + ((wgid % nig) % gsz); u.pn = (wgid % nig) / gsz; return true;
    }
    __device__ __forceinline__ void a_ready(const Unit&) const {}
    __device__ __forceinline__ void done(const Unit&) const {}
};

__device__ __forceinline__ unsigned cvt_pk_bf16(float lo, float hi) { unsigned r; asm volatile("v_cvt_pk_bf16_f32 %0, %1, %2" : "=v"(r) : "v"(lo), "v"(hi)); return r; }
typedef float f32x2 __attribute__((ext_vector_type(2)));
__device__ __forceinline__ f32x2 gelu_pk(f32x2 v) {
    const f32x2 av = __builtin_elementwise_abs(v), d = av * 0.2316418882f + 1.0f;
    f32x2 t; t.x = __builtin_amdgcn_rcpf(d.x); t.y = __builtin_amdgcn_rcpf(d.y);
    f32x2 q = t * 0.5307027145f + (-0.7265760135f); q = q * t + 0.7107068705f; q = q * t + (-0.142248368f); q = q * t + 0.127414796f; q = q * t;
    const f32x2 s = (v * v) * (-0.72134752044f);
    f32x2 e; e.x = __builtin_amdgcn_exp2f(s.x); e.y = __builtin_amdgcn_exp2f(s.y);
    const f32x2 m = v * (q * e), r = v - m;
    f32x2 o; o.x = v.x < 0.f ? m.x : r.x; o.y = v.y < 0.f ? m.y : r.y; return o;
}

template <int ACT  > struct EpiBf16 {
    static constexpr bool PERM = true, AFTER_DRAIN = false; static_assert(ACT == 0 || ACT == 1, "EpiBf16: ACT is 0 (none) or 1 (gelu_pk)");
    bf16_t* O; int ldc; const float* bias; int split_cols; size_t split_stride; float scale0;
    __device__ __forceinline__ void operator()(const f32x4 (&acc)[2][2][4][2], const Unit& u, int wr, int wc, int fr, int fq) const {
        const int row0 = u.pm * BM + wr * 64 + fr; int colt = u.pn * BM; bf16_t* base = O;
        float sc = 1.f; if (split_cols) { const int t = colt / split_cols; base += (size_t)t * split_stride; colt -= t * split_cols; if (t == 0) sc = scale0; }
        const int col0 = colt + wc * 32 + 8 * fq, bcol0 = u.pn * BM + wc * 32 + 8 * fq;
        f32x4 bv[2][2];
#pragma unroll
        for (int bj = 0; bj < 2; ++bj)
#pragma unroll
            for (int n = 0; n < 2; ++n) bv[bj][n] = bias ? *(const f32x4*)(bias + bcol0 + bj * HALF + 4 * n) : (f32x4){0.f, 0.f, 0.f, 0.f};
#pragma unroll
        for (int ai = 0; ai < 2; ++ai)
#pragma unroll
            for (int m = 0; m < 4; ++m) { bf16_t* rowp = base + (size_t)(row0 + ai * HALF + m * 16) * ldc + col0;
#pragma unroll
                for (int bj = 0; bj < 2; ++bj) { f32x4 v0 = acc[ai][bj][m][0] + bv[bj][0], v1 = acc[ai][bj][m][1] + bv[bj][1];
                    if (ACT == 1) { f32x2 a = gelu_pk((f32x2){v0[0], v0[1]}), b = gelu_pk((f32x2){v0[2], v0[3]}), c = gelu_pk((f32x2){v1[0], v1[1]}), d = gelu_pk((f32x2){v1[2], v1[3]});
                        v0 = (f32x4){a.x, a.y, b.x, b.y}; v1 = (f32x4){c.x, c.y, d.x, d.y}; }
                    v0 = v0 * sc; v1 = v1 * sc; u32x4 w; w.x = cvt_pk_bf16(v0[0], v0[1]); w.y = cvt_pk_bf16(v0[2], v0[3]); w.z = cvt_pk_bf16(v1[0], v1[1]); w.w = cvt_pk_bf16(v1[2], v1[3]);
                    *(u32x4*)(rowp + bj * HALF) = w; } }
    }
};
struct PanelOrder {
    int pm, nN;
    __device__ __forceinline__ bool next(int i, Unit& u) const { if (i >= nN) return false; int p = i; asm volatile("" : "+s"(p)); u.pm = pm; u.pn = p; return true; }
    __device__ __forceinline__ void a_ready(const Unit&) const {}
    __device__ __forceinline__ void done(const Unit&) const {}
};
struct EpiProj {
    static constexpr bool PERM = true, AFTER_DRAIN = false;
    bf16_t* dqkv; bf16_t* dz; bf16_t* aqkv; float* ba;
    __device__ __forceinline__ void operator()(const f32x4 (&acc)[2][2][4][2], const Unit& u, int wr, int wc, int fr, int fq) const {
        const int row0 = u.pm * BM + 16 * ((u.pm >> 5) + 1) + wr * 64 + fr; const int pn = u.pn;
        if (pn == 11) {
            if (wc == 0 && fq < 2) {
#pragma unroll
                for (int ai = 0; ai < 2; ++ai)
#pragma unroll
                    for (int m = 0; m < 4; ++m) { float* p = ba + (size_t)(row0 + ai * HALF + m * 16) * 16 + 8 * fq; *(f32x4*)p = acc[ai][0][m][0]; *(f32x4*)(p + 4) = acc[ai][0][m][1]; }
            }
            return;
        }
        bf16_t* base; int ldc, colt;
        if (pn < 6) { base = dqkv; ldc = 1536; colt = pn * 256; } else if (pn < 8) { base = dz; ldc = 512; colt = (pn - 6) * 256; } else { base = aqkv; ldc = 768; colt = (pn - 8) * 256; }
        const int col0 = colt + wc * 32 + 8 * fq;
#pragma unroll
        for (int ai = 0; ai < 2; ++ai)
#pragma unroll
            for (int m = 0; m < 4; ++m) { bf16_t* rowp = base + (size_t)(row0 + ai * HALF + m * 16) * ldc + col0;
#pragma unroll
                for (int bj = 0; bj < 2; ++bj) { const f32x4 v0 = acc[ai][bj][m][0], v1 = acc[ai][bj][m][1];
                    u32x4 w; w.x = cvt_pk_bf16(v0[0], v0[1]); w.y = cvt_pk_bf16(v0[2], v0[3]); w.z = cvt_pk_bf16(v1[0], v1[1]); w.w = cvt_pk_bf16(v1[2], v1[3]);
                    *(u32x4*)(rowp + bj * HALF) = w; } }
    }
};
struct EpiRelu2 {
    static constexpr bool PERM = true, AFTER_DRAIN = false;
    bf16_t* O; int ldc;
    __device__ __forceinline__ void operator()(const f32x4 (&acc)[2][2][4][2], const Unit& u, int wr, int wc, int fr, int fq) const {
        const int row0 = u.pm * BM + wr * 64 + fr; const int col0 = u.pn * BM + wc * 32 + 8 * fq;
#pragma unroll
        for (int ai = 0; ai < 2; ++ai)
#pragma unroll
            for (int m = 0; m < 4; ++m) { bf16_t* rowp = O + (size_t)(row0 + ai * HALF + m * 16) * ldc + col0;
#pragma unroll
                for (int bj = 0; bj < 2; ++bj) { f32x4 v0 = acc[ai][bj][m][0], v1 = acc[ai][bj][m][1];
#pragma unroll
                    for (int e = 0; e < 4; ++e) { const float a = fmaxf(v0[e], 0.f), b = fmaxf(v1[e], 0.f); v0[e] = a * a; v1[e] = b * b; }
                    u32x4 w; w.x = cvt_pk_bf16(v0[0], v0[1]); w.y = cvt_pk_bf16(v0[2], v0[3]); w.z = cvt_pk_bf16(v1[0], v1[1]); w.w = cvt_pk_bf16(v1[2], v1[3]);
                    *(u32x4*)(rowp + bj * HALF) = w; } }
    }
};
struct EpiF32 {
    static constexpr bool PERM = false, AFTER_DRAIN = false;
    float* O; int ldc;
    __device__ __forceinline__ void operator()(const f32x4 (&acc)[2][2][4][2], const Unit& u, int wr, int wc, int fr, int fq) const {
        const int row0 = u.pm * BM + wr * 64 + fr; const int col0 = u.pn * BM + wc * 32 + 4 * fq;
#pragma unroll
        for (int ai = 0; ai < 2; ++ai)
#pragma unroll
            for (int m = 0; m < 4; ++m) { float* rowp = O + (size_t)(row0 + ai * HALF + m * 16) * ldc + col0;
#pragma unroll
                for (int bj = 0; bj < 2; ++bj)
#pragma unroll
                    for (int n = 0; n < 2; ++n) *(f32x4*)(rowp + bj * HALF + n * 16) = acc[ai][bj][m][n]; }
    }
};
template <class Epi, class Sched, bool ALIGN_EPI = false, bool SP2 = false>
__device__ __forceinline__ void gemm_phase(PG8_LAS unsigned char* lds, const Gemm g, const Sched& S, const Epi& E) {
    const int tid = threadIdx.x, wid = __builtin_amdgcn_readfirstlane(tid >> 6), lane = tid & 63, wr = wid >> 2, wc = wid & 3, fr = lane & 15, fq = lane >> 4;
    const int K = g.K, nt = K / BK;
    unsigned voffA[2], voffB[2];
#pragma unroll
    for (int i = 0; i < 2; ++i) { int R, C; stage_rc(tid * 16 + i * 8192, R, C); const int Rb = Epi::PERM ? ((R & ~31) + perm32(R & 31)) : R;
        voffA[i] = (unsigned)(R * K + C) * 2u; voffB[i] = (unsigned)(Rb * K + C) * 2u; }
    const size_t kstep = (size_t)(BK * 2);
    const size_t hstep = (size_t)HALF * K * 2;
    const size_t tstep = 2 * hstep;
    const unsigned ldsw = (unsigned)wid * 1024u;
    const int aoff = lds_byte(wr * 64 + fr, fq * 8), boff = lds_byte(wc * 32 + fr, fq * 8);
#define PG8_SA(b, h) (((b) * 2 + (h)) * HTB)
#define PG8_SB(b, h) ((4 + (b) * 2 + (h)) * HTB)
#define PG8_STAGE(bufoff, gbase, voff) do { _Pragma("unroll") for (int _i = 0; _i < 2; ++_i) \
        __builtin_amdgcn_global_load_lds((const unsigned*)((const char*)(gbase) + (voff)[_i]), (PG8_LAS unsigned*)(lds + (bufoff) + ldsw + _i * 8192), 16, 0, 0); } while (0)
#define PG8_LDA(dst, b, h) do { _Pragma("unroll") for (int m = 0; m < 4; ++m) _Pragma("unroll") for (int k = 0; k < 2; ++k) dst[m][k] = *(const PG8_LAS bf16x8*)(lds + PG8_SA(b, h) + aoff + m * 2048 + k * 1024); } while (0)
#define PG8_LDB(dst, b, h) do { _Pragma("unroll") for (int n = 0; n < 2; ++n) _Pragma("unroll") for (int k = 0; k < 2; ++k) dst[n][k] = *(const PG8_LAS bf16x8*)(lds + PG8_SB(b, h) + boff + n * 2048 + k * 1024); } while (0)
#define PG8_MMA(ai, bj, At, Bt) do { __builtin_amdgcn_s_setprio(1); _Pragma("unroll") for (int m = 0; m < 4; ++m) _Pragma("unroll") for (int n = 0; n < 2; ++n) _Pragma("unroll") for (int k = 0; k < 2; ++k) \
        acc[ai][bj][m][n] = __builtin_amdgcn_mfma_f32_16x16x32_bf16(Bt[n][k], At[m][k], acc[ai][bj][m][n], 0, 0, 0); __builtin_amdgcn_s_setprio(0); } while (0)
#define PG8_WAIT_V(n) asm volatile("s_waitcnt vmcnt(" #n ")" ::: "memory")
#define PG8_WAIT_L(n) asm volatile("s_waitcnt lgkmcnt(" #n ")" ::: "memory")
#define PG8_BAR __builtin_amdgcn_s_barrier()
#define PG8_SCHED __builtin_amdgcn_sched_barrier(0)
    Unit cur, nxt; int ui = 0;
    if (!S.next(0, cur)) return;
    f32x4 acc[2][2][4][2];
#pragma unroll
    for (int a = 0; a < 2; ++a)
#pragma unroll
        for (int b = 0; b < 2; ++b)
#pragma unroll
            for (int m = 0; m < 4; ++m)
#pragma unroll
                for (int n = 0; n < 2; ++n) acc[a][b][m][n] = (f32x4){0.f, 0.f, 0.f, 0.f};
    bf16x8 At[4][2], B0[2][2], B1[2][2];
    const char* cA = (const char*)g.A + (size_t)cur.pm * tstep; const char* cB = (const char*)g.Bt + (size_t)cur.pn * tstep;
    S.a_ready(cur);
    if constexpr (SP2) {
        PG8_STAGE(PG8_SB(0, 0), cB, voffB); PG8_STAGE(PG8_SB(0, 1), cB + hstep, voffB); PG8_STAGE(PG8_SA(0, 0), cA, voffA); PG8_STAGE(PG8_SA(0, 1), cA + hstep, voffA);
        if (wr == 1) PG8_BAR;
        PG8_WAIT_V(2); PG8_BAR;
        PG8_STAGE(PG8_SB(1, 0), cB + kstep, voffB); PG8_STAGE(PG8_SA(1, 0), cA + kstep, voffA); PG8_STAGE(PG8_SB(1, 1), cB + hstep + kstep, voffB);
        PG8_WAIT_V(6); PG8_BAR;
    } else {
        PG8_STAGE(PG8_SB(0, 0), cB, voffB); PG8_STAGE(PG8_SA(0, 0), cA, voffA); PG8_STAGE(PG8_SB(0, 1), cB + hstep, voffB); PG8_STAGE(PG8_SA(0, 1), cA + hstep, voffA);
        if (wr == 1) PG8_BAR;
        PG8_WAIT_V(4); PG8_BAR;
        PG8_STAGE(PG8_SB(1, 0), cB + kstep, voffB); PG8_STAGE(PG8_SA(1, 0), cA + kstep, voffA); PG8_STAGE(PG8_SB(1, 1), cB + hstep + kstep, voffB);
        PG8_WAIT_V(6); PG8_BAR;
    }
    for (;;) {
        const bool has_next = S.next(ui + 1, nxt);
        const char* nA = has_next ? (const char*)g.A + (size_t)nxt.pm * tstep : cA; const char* nB = has_next ? (const char*)g.Bt + (size_t)nxt.pn * tstep : cB;
        for (int t = 0; t < nt; t += 2) {
            const bool last = (t == nt - 2);
            const char* a1 = cA + (size_t)(t + 1) * kstep;
            const char* a2 = last ? nA : cA + (size_t)(t + 2) * kstep; const char* b2 = last ? nB : cB + (size_t)(t + 2) * kstep;
            const char* a3 = a2 + kstep; const char* b3 = b2 + kstep;
            if (last && has_next) S.a_ready(nxt);
            if constexpr (SP2) {
            PG8_LDB(B0, 0, 0); PG8_LDB(B1, 0, 1); PG8_SCHED; PG8_LDA(At, 0, 0); PG8_STAGE(PG8_SA(1, 1), a1 + hstep, voffA);
            PG8_WAIT_V(8); PG8_WAIT_L(0); PG8_BAR; PG8_MMA(0, 0, At, B0); PG8_MMA(0, 1, At, B1); PG8_BAR; PG8_SCHED;
            PG8_LDA(At, 0, 1); PG8_STAGE(PG8_SB(0, 0), b2, voffB); PG8_STAGE(PG8_SB(0, 1), b2 + hstep, voffB); PG8_STAGE(PG8_SA(0, 0), a2, voffA);
            PG8_WAIT_V(8); PG8_WAIT_L(0); PG8_BAR; PG8_MMA(1, 0, At, B0); PG8_MMA(1, 1, At, B1); PG8_BAR; PG8_SCHED;
            PG8_LDB(B0, 1, 0); PG8_LDB(B1, 1, 1); PG8_SCHED; PG8_LDA(At, 1, 0); PG8_STAGE(PG8_SA(0, 1), a2 + hstep, voffA);
            PG8_WAIT_V(8); PG8_WAIT_L(0); PG8_BAR; PG8_MMA(0, 0, At, B0); PG8_MMA(0, 1, At, B1); PG8_BAR; PG8_SCHED;
            PG8_LDA(At, 1, 1); PG8_STAGE(PG8_SB(1, 0), b3, voffB); PG8_STAGE(PG8_SB(1, 1), b3 + hstep, voffB); PG8_STAGE(PG8_SA(1, 0), a3, voffA);
            PG8_WAIT_V(8); PG8_WAIT_L(0); PG8_BAR; PG8_MMA(1, 0, At, B0); PG8_MMA(1, 1, At, B1); PG8_BAR; PG8_SCHED;
            } else {
            PG8_LDB(B0, 0, 0); PG8_SCHED; PG8_LDA(At, 0, 0); PG8_STAGE(PG8_SA(1, 1), a1 + hstep, voffA);
            PG8_WAIT_L(8); PG8_BAR; PG8_WAIT_L(0); PG8_MMA(0, 0, At, B0); PG8_BAR; PG8_SCHED;
            PG8_LDB(B1, 0, 1); PG8_STAGE(PG8_SB(0, 0), b2, voffB);
            PG8_BAR; PG8_WAIT_L(0); PG8_MMA(0, 1, At, B1); PG8_BAR;
            PG8_LDA(At, 0, 1); PG8_STAGE(PG8_SA(0, 0), a2, voffA);
            PG8_BAR; PG8_WAIT_L(0); PG8_MMA(1, 0, At, B0); PG8_BAR; PG8_SCHED;
            PG8_STAGE(PG8_SB(0, 1), b2 + hstep, voffB);
            PG8_WAIT_V(6); PG8_BAR; PG8_MMA(1, 1, At, B1); PG8_BAR;
            PG8_LDB(B0, 1, 0); PG8_SCHED; PG8_LDA(At, 1, 0); PG8_STAGE(PG8_SA(0, 1), a2 + hstep, voffA);
            PG8_WAIT_L(8); PG8_BAR; PG8_WAIT_L(0); PG8_MMA(0, 0, At, B0); PG8_BAR; PG8_SCHED;
            PG8_LDB(B1, 1, 1); PG8_STAGE(PG8_SB(1, 0), b3, voffB);
            PG8_BAR; PG8_WAIT_L(0); PG8_MMA(0, 1, At, B1); PG8_BAR;
            PG8_LDA(At, 1, 1); PG8_STAGE(PG8_SA(1, 0), a3, voffA);
            PG8_BAR; PG8_WAIT_L(0); PG8_MMA(1, 0, At, B0); PG8_BAR; PG8_SCHED;
            PG8_STAGE(PG8_SB(1, 1), b3 + hstep, voffB);
            PG8_WAIT_V(6); PG8_BAR; PG8_MMA(1, 1, At, B1); PG8_BAR;
            }
        }
        if constexpr (ALIGN_EPI) { if (wr == 0) PG8_BAR; }
        if constexpr (!Epi::AFTER_DRAIN) { E(acc, cur, wr, wc, fr, fq); S.done(cur); }
        if (!has_next) break;
#pragma unroll
        for (int a = 0; a < 2; ++a)
#pragma unroll
            for (int b = 0; b < 2; ++b)
#pragma unroll
                for (int m = 0; m < 4; ++m)
#pragma unroll
                    for (int n = 0; n < 2; ++n) acc[a][b][m][n] = (f32x4){0.f, 0.f, 0.f, 0.f};
        cur = nxt; cA = nA; cB = nB; ++ui;
        if constexpr (ALIGN_EPI) { if (wr == 1) PG8_BAR; }
    }
    PG8_WAIT_V(0);
    if constexpr (!ALIGN_EPI) { if (wr == 0) PG8_BAR; }
    PG8_BAR;
    if constexpr (Epi::AFTER_DRAIN) { E.fused(acc, cur, wr, wc, fr, fq, lds, wid, lane); S.done(cur); }
#undef PG8_SA
#undef PG8_SB
#undef PG8_STAGE
#undef PG8_LDA
#undef PG8_LDB
#undef PG8_MMA
#undef PG8_WAIT_V
#undef PG8_WAIT_L
#undef PG8_BAR
#undef PG8_SCHED
}
}

#ifndef PG8_SP2
#define PG8_SP2 true
#endif
#ifndef PG8_ALIGN
#define PG8_ALIGN true
#endif
#include <hip/hip_bf16.h>
#include <cmath>
namespace attn_body {
using bf16=__hip_bfloat16;
using bf16x8=__attribute__((ext_vector_type(8)))short;
using s16x4=__attribute__((ext_vector_type(4)))short;
using f32x16=__attribute__((ext_vector_type(16)))float;
using u32x4=__attribute__((ext_vector_type(4)))unsigned;
constexpr int D=64,QP=512,OP=1024,KP=64,NKT=130,NKEYS=8208;
constexpr int NW=8,QBLK=32,QB=QBLK*NW,KVBLK=64;
constexpr int ATTN_UNIT_ROWS=QB;
__device__ __forceinline__ int crow(int r,int hi){return (r&3)+8*(r>>2)+4*hi;}
#define SBAR() __builtin_amdgcn_sched_barrier(0)
__device__ __forceinline__ void kmask(f32x16&p0,f32x16&p1,int t,int hi){
  const float NEG=-INFINITY; int kb=64*t+4*hi;
  #pragma unroll
  for(int r=0;r<16;++r){int kv=kb+(r&3)+8*(r>>2); if(kv>=NKEYS)p0[r]=NEG; if(kv+32>=NKEYS)p1[r]=NEG;}
}

constexpr int NSLOT=3, SLOTB=8192;
constexpr int LDS_K=0, LDS_V=NSLOT*SLOTB, LDS_WS=2*NSLOT*SLOTB, LDS_OST=LDS_WS+NW*64*4, LDS_BYTES=LDS_OST+NW*4096;
constexpr float C2=0.125f*1.4426950408889634f;
__device__ __forceinline__ void glds16(const void*gsrc,unsigned lds_dst){unsigned keep;
  asm volatile("s_mov_b32 %0, m0\n\ts_mov_b32 m0, %2\n\ts_nop 0\n\tglobal_load_lds_dwordx4 %1, off\n\ts_mov_b32 m0, %0":"=&s"(keep):"v"(gsrc),"s"(lds_dst):"memory");}
__device__ __forceinline__ float max3f(float a,float b,float c){float r;asm("v_max3_f32 %0, %1, %2, %3":"=v"(r):"v"(a),"v"(b),"v"(c));return r;}
__device__ __forceinline__ float max2f(float a,float b){float r;asm("v_max_f32_e32 %0, %1, %2":"=v"(r):"v"(a),"v"(b));return r;}
__device__ __forceinline__ float fadd_s(float a,float b){float r;asm("v_add_f32_e32 %0, %1, %2":"=v"(r):"v"(a),"v"(b));return r;}
__device__ __forceinline__ float fsub_s(float a,float b){float r;asm("v_sub_f32_e32 %0, %1, %2":"=v"(r):"v"(a),"v"(b));return r;}
typedef float f32x2_t __attribute__((ext_vector_type(2))); typedef __bf16 bf16x2_t __attribute__((ext_vector_type(2)));
__device__ __forceinline__ unsigned cvtpk_s(float lo,float hi){f32x2_t v={lo,hi};bf16x2_t b=__builtin_convertvector(v,bf16x2_t);return __builtin_bit_cast(unsigned,b);}
#define WAIT_BAR(N) asm volatile("s_waitcnt vmcnt(" #N ") lgkmcnt(0)\n\ts_barrier":::"memory")

__device__ __forceinline__ void qkt(f32x16&p0,f32x16&p1,const char*Kslot,const bf16x8*qr,const f32x16&negm,int r32,int hi){
  const char*kb=Kslot+hi*1024+r32*16;
  #pragma unroll
  for(int d0=0;d0<4;++d0){
    const bf16x8 b0=*reinterpret_cast<const bf16x8*>(kb+d0*2048);
    const bf16x8 b1=*reinterpret_cast<const bf16x8*>(kb+d0*2048+512);
    if(d0==0){p0=__builtin_amdgcn_mfma_f32_32x32x16_bf16(b0,qr[0],negm,0,0,0);p1=__builtin_amdgcn_mfma_f32_32x32x16_bf16(b1,qr[0],negm,0,0,0);}
    else{p0=__builtin_amdgcn_mfma_f32_32x32x16_bf16(b0,qr[d0],p0,0,0,0);p1=__builtin_amdgcn_mfma_f32_32x32x16_bf16(b1,qr[d0],p1,0,0,0);}}
}
typedef __attribute__((address_space(3))) const char* lds_cptr;
typedef short v4i16_t __attribute__((ext_vector_type(4)));
__device__ __forceinline__ void kload8(bf16x8*kf,lds_cptr kp){
  kf[0]=*(const __attribute__((address_space(3))) bf16x8*)(kp);      kf[1]=*(const __attribute__((address_space(3))) bf16x8*)(kp+512);
  kf[2]=*(const __attribute__((address_space(3))) bf16x8*)(kp+2048); kf[3]=*(const __attribute__((address_space(3))) bf16x8*)(kp+2560);
  kf[4]=*(const __attribute__((address_space(3))) bf16x8*)(kp+4096); kf[5]=*(const __attribute__((address_space(3))) bf16x8*)(kp+4608);
  kf[6]=*(const __attribute__((address_space(3))) bf16x8*)(kp+6144); kf[7]=*(const __attribute__((address_space(3))) bf16x8*)(kp+6656);
}
__device__ __forceinline__ void kload2(bf16x8*kf,lds_cptr kp,int j){ kf[2*j]=*(const __attribute__((address_space(3))) bf16x8*)(kp+j*2048); kf[2*j+1]=*(const __attribute__((address_space(3))) bf16x8*)(kp+j*2048+512); }
__device__ __forceinline__ s16x4 vtr(lds_cptr p){ return __builtin_bit_cast(s16x4,__builtin_amdgcn_ds_read_tr16_b64_v4i16((__attribute__((address_space(3))) v4i16_t*)p)); }
__device__ __forceinline__ float rowmax(const f32x16&p0,const f32x16&p1){
  float a=max3f(p0[0],p0[1],p1[0]),b=max3f(p0[2],p0[3],p1[1]);a=max3f(a,p1[2],p1[3]);
  #pragma unroll
  for(int r=4;r<16;r+=4){a=max3f(a,p0[r],p0[r+1]);b=max3f(b,p0[r+2],p0[r+3]);a=max3f(a,p1[r],p1[r+1]);b=max3f(b,p1[r+2],p1[r+3]);}
  const float m=max2f(a,b);
  auto rr=__builtin_amdgcn_permlane32_swap(__float_as_uint(m),__float_as_uint(m),false,false);
  return max2f(__uint_as_float(rr[0]),__uint_as_float(rr[1]));
}
__device__ __forceinline__ void pv(f32x16*o,int vb,bf16x8 pa0,bf16x8 pa1,bf16x8 pa2,bf16x8 pa3){
  #pragma unroll
  for(int d0=0;d0<2;++d0){s16x4 lo[4],hi[4];
    #pragma unroll
    for(int ks=0;ks<4;++ks){
      asm volatile("ds_read_b64_tr_b16 %0,%1 offset:%c2":"=&v"(lo[ks]):"v"(vb),"i"(d0*4096+ks*1024):"memory");
      asm volatile("ds_read_b64_tr_b16 %0,%1 offset:%c2":"=&v"(hi[ks]):"v"(vb),"i"(d0*4096+ks*1024+512):"memory");}
    asm volatile("s_waitcnt lgkmcnt(0)":::"memory");SBAR();
    #define PK(k) (bf16x8){lo[k][0],lo[k][1],lo[k][2],lo[k][3],hi[k][0],hi[k][1],hi[k][2],hi[k][3]}
    o[d0]=__builtin_amdgcn_mfma_f32_32x32x16_bf16(pa0,PK(0),o[d0],0,0,0);
    o[d0]=__builtin_amdgcn_mfma_f32_32x32x16_bf16(pa1,PK(1),o[d0],0,0,0);
    o[d0]=__builtin_amdgcn_mfma_f32_32x32x16_bf16(pa2,PK(2),o[d0],0,0,0);
    o[d0]=__builtin_amdgcn_mfma_f32_32x32x16_bf16(pa3,PK(3),o[d0],0,0,0);
    #undef PK
  }
}

#ifndef ATTN_STORE16
#define ATTN_STORE16(p,v) (*(u32x4*)(p)=(v))
#endif
template<int THRL> __device__ __forceinline__ void attn_unit(const bf16*Qu,const bf16*__restrict__ Kh,const bf16*__restrict__ Vh,bf16*Ou,char*shm){
  const int tid=threadIdx.x,lane=tid&63,r32=lane&31,hi=lane>>5; const int wid=__builtin_amdgcn_readfirstlane(tid>>6);
  const bf16*Qw=Qu+(long)(wid*QBLK)*QP;
  const unsigned lds0=(unsigned)(uintptr_t)shm;
  float*wsf=(float*)(shm+LDS_WS)+wid*64;
  const bf16*ksrc=Kh+(long)lane*KP+wid*8;
  const bf16*vsrc=Vh+(long)(16*(wid&3)+(lane>>2))*KP+(wid>>2)*32+(lane&3)*8;
  const unsigned kdst=lds0+LDS_K+wid*1024, vdst=lds0+LDS_V+wid*1024;
  #define DMA_K(t,slot) glds16(ksrc+(long)(t)*KVBLK*KP,(unsigned)__builtin_amdgcn_readfirstlane(kdst+(slot)))
  #define DMA_V(t,slot) glds16(vsrc+(long)(t)*KVBLK*KP,(unsigned)__builtin_amdgcn_readfirstlane(vdst+(slot)))
  const int vb0=(int)(lds0+LDS_V)+((lane>>4)&1)*32+(lane&3)*8+(4*hi+((lane&15)>>2))*64;
  const char*Kbase=shm+LDS_K; bf16x8 kf[8];
  const lds_cptr shm3=(lds_cptr)shm; const lds_cptr kp0=shm3+LDS_K+hi*1024+r32*16; const lds_cptr vp0=shm3+LDS_V+((lane>>4)&1)*32+(lane&3)*8+(4*hi+((lane&15)>>2))*64;
  constexpr int NT=NKT;
  DMA_K(0,0);DMA_V(0,0);DMA_K(1,SLOTB);
  bf16x8 qr[4];
  #pragma unroll
  for(int d0=0;d0<4;++d0)qr[d0]=*reinterpret_cast<const bf16x8*>(&Qw[(long)r32*QP+d0*16+hi*8]);
  float mhat=0.f,l_reg=0.f;f32x16 o[2];o[0]=f32x16{};o[1]=f32x16{};f32x16 negm=f32x16{};asm volatile("":"+v"(negm));
  #define CMASK(P0,P1,t) do{ if((t)>=NT-2) kmask(P0,P1,(t),hi);}while(0)
  bool resc=false;
  #define START(P0,P1) do{ const float rm=rowmax(P0,P1); resc=false; \
    { const float dl=rm; mhat=fadd_s(mhat,dl); \
      _Pragma("unroll") for(int r=0;r<16;++r){P0[r]=fsub_s(P0[r],dl);P1[r]=fsub_s(P1[r],dl);} \
      _Pragma("unroll") for(int r=0;r<16;++r)negm[r]=-mhat; asm volatile("":"+v"(negm)); } \
    _Pragma("unroll") for(int r=0;r<16;++r)P0[r]=__builtin_amdgcn_exp2f(P0[r]); }while(0)
  #define RESC() do{ if(resc){ asm volatile("s_waitcnt lgkmcnt(0)":::"memory"); \
      _Pragma("unroll") for(int d_=0;d_<2;++d_) _Pragma("unroll") for(int r=0;r<16;++r)o[d_][r]*=wsf[crow(r,hi)]; } }while(0)
  f32x16 pA0,pA1,pB0,pB1;
  int sl_prev=0,sl_cur=0,sl_next=SLOTB;
  #define ROT() do{sl_prev=sl_cur;sl_cur=sl_next;sl_next=(sl_next==(NSLOT-1)*SLOTB)?0:sl_next+SLOTB;}while(0)
  DMA_K(2,2*SLOTB);
  WAIT_BAR(3);
  qkt(pA0,pA1,Kbase,qr,negm,r32,hi);asm volatile("s_nop 15\n\ts_nop 7":"+v"(pA0),"+v"(pA1));CMASK(pA0,pA1,0);
  START(pA0,pA1);
  _Pragma("unroll") for(int r=0;r<16;++r)pA1[r]=__builtin_amdgcn_exp2f(pA1[r]);
  WAIT_BAR(0);
  DMA_K(3,0);DMA_V(1,SLOTB);
  ROT();
  kload8(kf,kp0+sl_cur);
  WAIT_BAR(2);
  s16x4 vlo[8],vhi[8]; u32x4 pw0,pw1,pw2,pw3;
  #define PKW(P,B) cvtpk_s(P[B],P[B+1])
  #define PAF(k) __builtin_bit_cast(bf16x8,pw##k)
  #define VFR(i) (bf16x8){vlo[i][0],vlo[i][1],vlo[i][2],vlo[i][3],vhi[i][0],vhi[i][1],vhi[i][2],vhi[i][3]}
  #define PIN(x) asm volatile("":"+v"(x))
  #define MX3(a,b,c) __builtin_fmaxf(__builtin_fmaxf((a),(b)),(c))
  #define GAPA(MF,A0,A1,A2,A3,W0,W1,PW) do{ MF; sacc+=A0; sacc+=A1; sacc+=A2; sacc+=A3; PIN(sacc); W0; W1; PIN(PW); SBAR(); }while(0)
  #define EX(v) __builtin_amdgcn_exp2f(v)
  #define GAPB(MF,X,B) do{ MF; X[B]=EX(X[B]); X[B+1]=EX(X[B+1]); X[B+2]=EX(X[B+2]); X[B+3]=EX(X[B+3]); PIN(X); SBAR(); }while(0)
  #define VRD(i) do{ vlo[i]=vtr(vp_+(((i)>>2)*4096+((i)&3)*1024)); vhi[i]=vtr(vp_+(((i)>>2)*4096+((i)&3)*1024+512)); }while(0)
  #define KRD(G,j) do{ if(G){ kload2(kf,kp0+sl_next,j); SBAR(); } }while(0)
  #define STEP(C0,C1,P0,P1,t,GK,GV,GL) do{ SBAR(); \
    const lds_cptr vp_=vp0+sl_prev; \
    VRD(0); SBAR(); float sacc=(P0[0]+P0[1]); \
    GAPA(C0=__builtin_amdgcn_mfma_f32_32x32x16_bf16(kf[0],qr[0],negm,0,0,0), P0[2],P0[3],P0[4],P0[5],     pw0[0]=PKW(P0,0), pw0[1]=PKW(P0,2), pw0); \
    VRD(4); SBAR(); GAPA(C1=__builtin_amdgcn_mfma_f32_32x32x16_bf16(kf[1],qr[0],negm,0,0,0), P0[6],P0[7],P0[8],P0[9],     pw0[2]=PKW(P0,4), pw0[3]=PKW(P0,6), pw0); \
    VRD(1); SBAR(); GAPA(C0=__builtin_amdgcn_mfma_f32_32x32x16_bf16(kf[2],qr[1],C0,0,0,0),   P0[10],P0[11],P0[12],P0[13], pw1[0]=PKW(P0,8), pw1[1]=PKW(P0,10), pw1); \
    VRD(5); SBAR(); GAPA(C1=__builtin_amdgcn_mfma_f32_32x32x16_bf16(kf[3],qr[1],C1,0,0,0),   P0[14],P0[15],P1[0],P1[1],   pw1[2]=PKW(P0,12),pw1[3]=PKW(P0,14), pw1); \
    VRD(2); SBAR(); GAPA(C0=__builtin_amdgcn_mfma_f32_32x32x16_bf16(kf[4],qr[2],C0,0,0,0),   P1[2],P1[3],P1[4],P1[5],     pw2[0]=PKW(P1,0), pw2[1]=PKW(P1,2), pw2); \
    VRD(6); SBAR(); GAPA(C1=__builtin_amdgcn_mfma_f32_32x32x16_bf16(kf[5],qr[2],C1,0,0,0),   P1[6],P1[7],P1[8],P1[9],     pw2[2]=PKW(P1,4), pw2[3]=PKW(P1,6), pw2); \
    VRD(3); SBAR(); GAPA(C0=__builtin_amdgcn_mfma_f32_32x32x16_bf16(kf[6],qr[3],C0,0,0,0),   P1[10],P1[11],P1[12],P1[13], pw3[0]=PKW(P1,8), pw3[1]=PKW(P1,10), pw3); \
    VRD(7); SBAR(); GAPA(C1=__builtin_amdgcn_mfma_f32_32x32x16_bf16(kf[7],qr[3],C1,0,0,0),   P1[14],P1[15],0.f,0.f,       pw3[2]=PKW(P1,12),pw3[3]=PKW(P1,14), pw3); \
    l_reg+=sacc; \
    if(GK){DMA_K((t)+3,sl_cur);} if(GV){DMA_V((t)+1,sl_next);} \
    CMASK(C0,C1,t); \
    { float a=MX3(C0[0],C0[1],C1[0]),b=MX3(C0[2],C0[3],C1[1]); a=MX3(a,C1[2],C1[3]); \
      _Pragma("unroll") for(int r=4;r<16;r+=4){a=MX3(a,C0[r],C0[r+1]);b=MX3(b,C0[r+2],C0[r+3]);a=MX3(a,C1[r],C1[r+1]);b=MX3(b,C1[r+2],C1[r+3]);} \
      float rm=__builtin_fmaxf(a,b); { auto rr=__builtin_amdgcn_permlane32_swap(__float_as_uint(rm),__float_as_uint(rm),false,false); rm=__builtin_fmaxf(__uint_as_float(rr[0]),__uint_as_float(rr[1])); } \
      resc=false; \
      if(__builtin_expect(__any(rm>(float)THRL),0)){ const float dl=__builtin_fmaxf(rm,0.f); mhat+=dl; \
        _Pragma("unroll") for(int r=0;r<16;++r){C0[r]-=dl;C1[r]-=dl;} \
        _Pragma("unroll") for(int r=0;r<16;++r)negm[r]=-mhat; asm volatile("":"+v"(negm)); \
        const float f=__builtin_amdgcn_exp2f(-dl); l_reg*=f; if(hi==0)wsf[r32]=f; resc=true; } } \
    SBAR(); \
    GAPB(o[0]=__builtin_amdgcn_mfma_f32_32x32x16_bf16(PAF(0),VFR(0),o[0],0,0,0), C0,0); \
    GAPB(o[1]=__builtin_amdgcn_mfma_f32_32x32x16_bf16(PAF(0),VFR(4),o[1],0,0,0), C0,4); \
    KRD(GL,0); GAPB(o[0]=__builtin_amdgcn_mfma_f32_32x32x16_bf16(PAF(1),VFR(1),o[0],0,0,0), C0,8); \
    KRD(GL,1); GAPB(o[1]=__builtin_amdgcn_mfma_f32_32x32x16_bf16(PAF(1),VFR(5),o[1],0,0,0), C0,12); \
    KRD(GL,2); GAPB(o[0]=__builtin_amdgcn_mfma_f32_32x32x16_bf16(PAF(2),VFR(2),o[0],0,0,0), C1,0); \
    KRD(GL,3); GAPB(o[1]=__builtin_amdgcn_mfma_f32_32x32x16_bf16(PAF(2),VFR(6),o[1],0,0,0), C1,4); \
    GAPB(o[0]=__builtin_amdgcn_mfma_f32_32x32x16_bf16(PAF(3),VFR(3),o[0],0,0,0), C1,8); \
    GAPB(o[1]=__builtin_amdgcn_mfma_f32_32x32x16_bf16(PAF(3),VFR(7),o[1],0,0,0), C1,12); \
    }while(0)
  int t=1;
  #undef CMASK
  #define CMASK(P0,P1,t) do{}while(0)
  for(;t+5<NT;t+=2){
    STEP(pB0,pB1,pA0,pA1,t,true,true,true);     WAIT_BAR(2); RESC(); ROT();
    STEP(pA0,pA1,pB0,pB1,t+1,true,true,true);   WAIT_BAR(2); RESC(); ROT();
  }
  #undef CMASK
  #define CMASK(P0,P1,t) do{ if((t)>=NT-2) kmask(P0,P1,(t),hi);}while(0)
  #define ENDW(tt) do{ if((tt)+3<NT){WAIT_BAR(2);} else if((tt)+2<NT){WAIT_BAR(1);} else {WAIT_BAR(0);} }while(0)
  for(;t+1<NT;t+=2){
    STEP(pB0,pB1,pA0,pA1,t,(t+3<NT),(t+1<NT),(t+1<NT));       ENDW(t);   RESC(); ROT();
    STEP(pA0,pA1,pB0,pB1,t+1,(t+4<NT),(t+2<NT),(t+2<NT));     ENDW(t+1); RESC(); ROT();
  }
  STEP(pB0,pB1,pA0,pA1,NT-1,false,false,false); RESC();
  { float sacc=pB0[0]+pB0[1]; _Pragma("unroll") for(int r=2;r<16;++r)sacc+=pB0[r]; _Pragma("unroll") for(int r=0;r<16;++r)sacc+=pB1[r]; l_reg+=sacc;
    pw0=(u32x4){PKW(pB0,0),PKW(pB0,2),PKW(pB0,4),PKW(pB0,6)};pw1=(u32x4){PKW(pB0,8),PKW(pB0,10),PKW(pB0,12),PKW(pB0,14)};pw2=(u32x4){PKW(pB1,0),PKW(pB1,2),PKW(pB1,4),PKW(pB1,6)};pw3=(u32x4){PKW(pB1,8),PKW(pB1,10),PKW(pB1,12),PKW(pB1,14)};
    SBAR(); pv(o,vb0+sl_cur,PAF(0),PAF(1),PAF(2),PAF(3)); }
  #undef PKW
  #undef PAF
  #undef VFR
  #undef PIN
  #undef MX3
  #undef GAPA
  #undef GAPB
  #undef EX
  #undef VRD
  #undef KRD
  #undef STEP
  #undef ENDW
  {auto rr=__builtin_amdgcn_permlane32_swap(__float_as_uint(l_reg),__float_as_uint(l_reg),false,false);l_reg=__uint_as_float(rr[0])+__uint_as_float(rr[1]);}
  if(hi==0)wsf[32+r32]=l_reg;asm volatile("s_waitcnt lgkmcnt(0)":::"memory");
  float rli[16];
  #pragma unroll
  for(int r=0;r<16;++r)rli[r]=__builtin_amdgcn_rcpf(wsf[32+crow(r,hi)]);
  bf16*Ow=Ou+(long)(wid*QBLK)*OP;
  { bf16*stg=(bf16*)(shm+LDS_OST)+wid*2048;
    #pragma unroll
    for(int r=0;r<16;++r){const int orow=crow(r,hi);
      #pragma unroll
      for(int d0=0;d0<2;++d0)stg[orow*64+d0*32+r32]=__float2bfloat16(o[d0][r]*rli[r]);}
    asm volatile("s_waitcnt lgkmcnt(0)":::"memory");
    #pragma unroll
    for(int i=0;i<4;++i){const int row=i*8+(lane>>3),ch=lane&7; const u32x4 v=*(const u32x4*)(stg+row*64+ch*8); ATTN_STORE16(Ow+(long)row*OP+ch*8,v);} }
  asm volatile("s_waitcnt lgkmcnt(0)\n\ts_barrier":::"memory");
  #undef DMA_K
  #undef DMA_V
  #undef CMASK
  #undef START
  #undef RESC
  #undef ROT
}
constexpr int ATTN_LDS_BYTES=LDS_BYTES;
#undef SBAR
#undef WAIT_BAR
}
#include <hip/hip_cooperative_groups.h>
namespace cg = cooperative_groups;
#define GAS __attribute__((address_space(1)))
#define LAS __attribute__((address_space(3)))
typedef unsigned short bf16;
typedef unsigned v4u __attribute__((ext_vector_type(4)));
typedef unsigned v2u __attribute__((ext_vector_type(2)));
typedef float f32x4 __attribute__((ext_vector_type(4)));
typedef short bf16x8 __attribute__((ext_vector_type(8)));

#ifndef ONE_LAUNCH
#define ONE_LAUNCH 1
#endif
constexpr int NWAVES = 8, NTHR = 512, NPHASE = 8;
constexpr int NB = 8, SEQ = 8192, NMETA = 16, LT = 8208, DM = 1024, MTOK = NB * LT, MP = 65792, MR = NB * SEQ, NIN = 3072, FF = 4096;
constexpr int LKP = 8320, NCH = 129, DNR = 8256;
constexpr float EPS = 1e-6f;
constexpr size_t MiB = 1u << 20;
constexpr size_t WS_CTL = 0, CTL_ZERO_BYTES = 1 * MiB;
constexpr size_t WS_WIN = 2 * MiB, WS_WOUT = 8 * MiB, WS_WUP = 10 * MiB, WS_WDN = 18 * MiB;
constexpr size_t WS_XN = 32 * MiB;
constexpr size_t WS_QN = WS_XN, WS_KN = WS_XN + (size_t)NB * DNR * 512 * 2;
constexpr size_t WS_DQKV = 162 * MiB;
constexpr size_t WS_CAT = WS_DQKV, WS_OF = WS_DQKV + 128 * MiB;
constexpr size_t WS_DZ = 355 * MiB;
constexpr size_t WS_AQKV = 420 * MiB;
constexpr size_t WS_OB = WS_AQKV;
constexpr size_t WS_BA = 517 * MiB;
constexpr size_t WS_Q = 522 * MiB;
constexpr size_t WS_KB = 586 * MiB, WS_VB = 603 * MiB;
constexpr size_t WS_CH = 620 * MiB;
constexpr size_t CH_BYTES = 41728, CH_W = 16384, CH_QK = 32768, CH_G = 40960;
constexpr size_t WS_MIX = 32 * MiB;
constexpr size_t WS_HID = 484 * MiB;
constexpr size_t WS_END = 996 * MiB;
static_assert(WS_KN + (size_t)NB * DNR * 512 * 2 <= WS_DQKV && WS_DQKV + (size_t)MP * 1536 * 2 <= WS_DZ && WS_DZ + (size_t)MP * 512 * 2 <= WS_AQKV && WS_AQKV + (size_t)MP * 768 * 2 <= WS_BA, "ws map 1");
static_assert(WS_BA + (size_t)MP * 16 * 4 <= WS_Q && WS_Q + (size_t)MR * 512 * 2 <= WS_KB && WS_KB + (size_t)NB * 2 * LKP * 64 * 2 <= WS_VB && WS_VB + (size_t)NB * 2 * LKP * 64 * 2 <= WS_CH, "ws map 2");
static_assert(WS_CH + CH_BYTES * (size_t)(NB * 2 * NCH * 4) <= WS_END && WS_OF + (size_t)MR * 512 * 2 <= WS_DZ && WS_OB + (size_t)MR * 512 * 2 <= WS_HID && WS_HID + (size_t)MR * FF * 2 <= WS_END && WS_MIX + (size_t)MR * DM * 2 <= WS_DQKV, "ws map 3");
constexpr int LDS_BYTES = 155648 + 256;
constexpr int XBST_OFF = 155648;
constexpr int QSLOT_OFF = 90112;
constexpr int P2_KN = 0, P2_QN = 17408, P2_VV = 34816, P2_RB = 52224, P2_KK = P2_RB, P2_QK = P2_RB + 16640, P2_AS = P2_RB + 33280, P2_CW = 118272, P2_SC = 125952;
constexpr int SC_ST = 0, SC_VT = 34816, SC_W = 53248, SC_Q = 70656, SC_KT = 88064, SC_QK = 106496, SC_U = 115712, SC_O = 134144;

typedef float f32x2_c __attribute__((ext_vector_type(2))); typedef __bf16 bf16x2_c __attribute__((ext_vector_type(2)));
__device__ __forceinline__ unsigned pk2(float lo, float hi) { const f32x2_c v = {lo, hi}; return __builtin_bit_cast(unsigned, __builtin_convertvector(v, bf16x2_c)); }
__device__ __forceinline__ unsigned f2bf(float f) { return pk2(f, 0.f) & 0xffffu; }
__device__ __forceinline__ float bf2f(unsigned short u) { return __builtin_bit_cast(float, (unsigned)u << 16); }
__device__ __forceinline__ void unpack8(const v4u v, float* o) {
#pragma unroll
    for (int i = 0; i < 4; ++i) { o[2 * i] = __builtin_bit_cast(float, v[i] << 16); o[2 * i + 1] = __builtin_bit_cast(float, v[i] & 0xffff0000u); }
}
__device__ __forceinline__ v4u pack8(const float* o) { v4u v; v.x = pk2(o[0], o[1]); v.y = pk2(o[2], o[3]); v.z = pk2(o[4], o[5]); v.w = pk2(o[6], o[7]); return v; }
__device__ __forceinline__ unsigned xcc_id() { return (unsigned)__builtin_amdgcn_s_getreg((3 << 11) | 20) & 0xFu; }
__device__ __forceinline__ float wave_sum(float v) {
#pragma unroll
    for (int o = 1; o < 64; o <<= 1) v += __shfl_xor(v, o);
    return v;
}
__device__ __forceinline__ float bperm_f(int srclane, float v) { return __builtin_bit_cast(float, __builtin_amdgcn_ds_bpermute(srclane << 2, __builtin_bit_cast(int, v))); }
template <int CTRL> __device__ __forceinline__ float dpp_mov_f(float v) { return __builtin_bit_cast(float, __builtin_amdgcn_update_dpp(0, __builtin_bit_cast(int, v), CTRL, 0xF, 0xF, true)); }
__device__ __forceinline__ float row16_sum(float v) { v += dpp_mov_f<0xB1>(v); v += dpp_mov_f<0x4E>(v); v += dpp_mov_f<0x141>(v); v += dpp_mov_f<0x140>(v); return v; }
__device__ __forceinline__ float silu_f(float y) { return y * __builtin_amdgcn_rcpf(1.f + __expf(-y)); }

struct Args { const float* in[16]; float* out; unsigned char* ws; int ph_lo, ph_hi; };

template <int MODE> __device__ __forceinline__ void p0_transpose_item(const float* W, int K, int Nsrc, int Ndst, bf16* WT, LAS float* scr, int item, int lane) {
    const int nblk = Ndst / 32, kb = item / nblk, nb = item % nblk, k0 = 64 * kb, n0 = 32 * nb;
    const int c4 = (lane & 7) * 4, nd = n0 + c4;
    const int src = MODE == 0 ? nd : (nd < 2048 ? nd : (nd < 2816 ? nd + 16 : (nd < 2832 ? nd - 2816 + 2048 : -1)));
    const int srcc = src >= 0 ? src : 0;
#pragma unroll
    for (int i = 0; i < 8; ++i) { const int kk = 8 * i + (lane >> 3); f32x4 v = *(const f32x4*)(W + (size_t)(k0 + kk) * Nsrc + srcc); if (src < 0) v = (f32x4){0.f, 0.f, 0.f, 0.f};
        LAS float* d = scr + kk * 33 + c4; d[0] = v[0]; d[1] = v[1]; d[2] = v[2]; d[3] = v[3]; }
    asm volatile("s_waitcnt lgkmcnt(0)" ::: "memory");
    const int c = lane & 7;
#pragma unroll
    for (int j = 0; j < 4; ++j) { const int n = (lane >> 3) + 8 * j; const LAS float* s = scr + (8 * c) * 33 + n;
        v4u o; o.x = pk2(s[0 * 33], s[1 * 33]); o.y = pk2(s[2 * 33], s[3 * 33]); o.z = pk2(s[4 * 33], s[5 * 33]); o.w = pk2(s[6 * 33], s[7 * 33]);
        *(v4u*)(WT + (size_t)(n0 + n) * K + k0 + 8 * c) = o; }
    asm volatile("s_waitcnt lgkmcnt(0)" ::: "memory");
}
__device__ __forceinline__ void rms_row_to_bf16(const float* xrow, const float* w, bf16* orow, int lane) {
    const f32x4* xr = (const f32x4*)xrow + lane; const f32x4* wr = (const f32x4*)w + lane;
    f32x4 v[4]; float s = 0.f;
#pragma unroll
    for (int j = 0; j < 4; ++j) { v[j] = xr[64 * j]; s += (v[j].x * v[j].x + v[j].y * v[j].y) + (v[j].z * v[j].z + v[j].w * v[j].w); }
    const float rs = __builtin_amdgcn_rsqf(wave_sum(s) * (1.f / DM) + EPS);
    v2u* o8 = (v2u*)orow + lane;
#pragma unroll
    for (int j = 0; j < 4; ++j) { const f32x4 ww = wr[64 * j]; v2u o; o.x = pk2(v[j].x * rs * ww.x, v[j].y * rs * ww.y); o.y = pk2(v[j].z * rs * ww.z, v[j].w * rs * ww.w); o8[64 * j] = o; }
}
constexpr int ROPE_OFF = 131072;
__device__ __forceinline__ void attn_prep_row(const v4u qd, const v4u kd, const LAS float* rope, const float* qw, const float* kw, bf16* Q, bf16* KB, bf16* VB, int b, int t, int lane) {
    if (t >= LT) {
        if (lane < 32) { const int l = lane & 15, kvh = l >> 3, sub = l & 7; bf16* dst = (lane < 16 ? KB : VB) + ((size_t)(b * 2 + kvh) * LKP + t) * 64 + sub * 8; *(v4u*)dst = (v4u){0u, 0u, 0u, 0u}; }
        return;
    }
    const bool real = t >= NMETA; const int s = real ? t - NMETA : 0;
    const int sub = lane & 7, axis = sub >> 2, half = (sub >> 1) & 1, f0 = (sub & 1) * 8;
    const int pos = axis == 0 ? (s >> 6) : (s & 63);
    float cs[8], sn[8];
    { const f32x4 c0 = *(const LAS f32x4*)(rope + pos * 16 + f0), c1 = *(const LAS f32x4*)(rope + pos * 16 + f0 + 4), s0 = *(const LAS f32x4*)(rope + 2048 + pos * 16 + f0), s1 = *(const LAS f32x4*)(rope + 2048 + pos * 16 + f0 + 4);
#pragma unroll
      for (int e = 0; e < 4; ++e) { cs[e] = real ? c0[e] : 1.f; cs[4 + e] = real ? c1[e] : 1.f; sn[e] = real ? s0[e] : 0.f; sn[4 + e] = real ? s1[e] : 0.f; } }
    { float q[8]; unpack8(qd, q); float ss = 0.f;
#pragma unroll
      for (int e = 0; e < 8; ++e) ss += q[e] * q[e];
      ss += __shfl_xor(ss, 1); ss += __shfl_xor(ss, 2); ss += __shfl_xor(ss, 4);
      const float rs = __builtin_amdgcn_rsqf(ss * (1.f / 64.f) + EPS); float o[8];
#pragma unroll
      for (int e = 0; e < 8; ++e) q[e] = q[e] * rs * qw[sub * 8 + e];
#pragma unroll
      for (int e = 0; e < 8; ++e) { const float pr = __shfl_xor(q[e], 2); o[e] = (half == 0 ? q[e] * cs[e] - pr * sn[e] : q[e] * cs[e] + pr * sn[e]) * attn_body::C2; }
      if (real) *(v4u*)(Q + ((size_t)(b * SEQ + s)) * 512 + lane * 8) = pack8(o); }
    { const int l = lane & 15, kvh = l >> 3; float k[8]; unpack8(kd, k); float ss = 0.f;
#pragma unroll
      for (int e = 0; e < 8; ++e) ss += k[e] * k[e];
      ss += __shfl_xor(ss, 1); ss += __shfl_xor(ss, 2); ss += __shfl_xor(ss, 4);
      const float rs = __builtin_amdgcn_rsqf(ss * (1.f / 64.f) + EPS); float o[8];
#pragma unroll
      for (int e = 0; e < 8; ++e) k[e] = k[e] * rs * kw[sub * 8 + e];
#pragma unroll
      for (int e = 0; e < 8; ++e) { const float pr = __shfl_xor(k[e], 2); o[e] = half == 0 ? k[e] * cs[e] - pr * sn[e] : k[e] * cs[e] + pr * sn[e]; }
      if (lane < 16) *(v4u*)(KB + ((size_t)(b * 2 + kvh) * LKP + t) * 64 + sub * 8) = pack8(o);
      else if (lane < 32) *(v4u*)(VB + ((size_t)(b * 2 + kvh) * LKP + t) * 64 + sub * 8) = kd; }
}

#define DN_ISSUE(item_, rawv, cwv, pbb, paa, td, ln) do { \
    const int h_ = (item_) & 3, tc_ = ((item_) >> 2) % NCH, b_ = (item_) / (4 * NCH), t0_ = 64 * tc_ - 48; \
    pbb = 0.f; paa = 0.f; \
    if (wave < 2) { const int dir_ = wave; const bool rev_ = dir_ && tc_ > 0; const int j_ = rev_ ? 63 - (ln) : (ln), t_ = t0_ + j_, tq_ = t_ < 0 ? 0 : t_; \
        const float* ba_ = BA + (size_t)(b_ * LT + tq_) * 16; const float vb_ = ba_[dir_ * 4 + h_], va_ = ba_[8 + dir_ * 4 + h_]; pbb = t_ >= 0 ? vb_ : 0.f; paa = t_ >= 0 ? va_ : 0.f; } \
      \
    _Pragma("unroll") for (int e_ = 0; e_ < 4; ++e_) { const int i_ = (td) + NTHR * e_, ic_ = i_ < 5 * 384 ? i_ : 5 * 384 - 1; const int w_ = ic_ / 384, c_ = ic_ % 384, sec_ = c_ >> 7; cwv[e_] = conv_w[w_ * 1536 + sec_ * 512 + h_ * 128 + (c_ & 127)]; } \
    _Pragma("unroll") for (int e_ = 0; e_ < 7; ++e_) { const int i_ = (td) + NTHR * e_, ic_ = i_ < 68 * 48 ? i_ : 68 * 48 - 1, rr_ = ic_ / 48, ck_ = ic_ % 48, sec_ = ck_ >> 4, t_ = t0_ - 2 + rr_; \
        const int tq_ = t_ < 0 ? 0 : (t_ >= LT ? LT - 1 : t_); const v4u v_ = *(const v4u*)(DQKV + (size_t)(b_ * LT + tq_) * 1536 + sec_ * 512 + h_ * 128 + (ck_ & 15) * 8); \
        const bool ok_ = (t_ == tq_); rawv[e_].x = ok_ ? v_.x : 0u; rawv[e_].y = ok_ ? v_.y : 0u; rawv[e_].z = ok_ ? v_.z : 0u; rawv[e_].w = ok_ ? v_.w : 0u; } } while (0)
__device__ __forceinline__ void dn_prep_item(const Args& A, LAS unsigned char* lds, int item, int next_item, v4u (&rawv)[7], float (&cwv)[4], float& pbb, float& paa, int tid, int wave, int lane) {
    unsigned char* ws = A.ws;
    int ln = lane, td = tid; asm volatile("" : "+v"(ln), "+v"(td));
    const bf16* DQKV = (const bf16*)(ws + WS_DQKV); const float* BA = (const float*)(ws + WS_BA);
    bf16* QN = (bf16*)(ws + WS_QN); bf16* KN = (bf16*)(ws + WS_KN);
    const float* conv_w = A.in[3]; const float* a_log = A.in[4]; const float* dt_bias = A.in[5];
    const int h = item & 3, tc = (item >> 2) % NCH, b = item / (4 * NCH);
    const int t0 = 64 * tc - 48;
    LAS bf16* KNs = (LAS bf16*)(lds + P2_KN); LAS bf16* QNs = (LAS bf16*)(lds + P2_QN); LAS bf16* VVs = (LAS bf16*)(lds + P2_VV);
    LAS bf16* raw = (LAS bf16*)(lds + P2_RB); LAS float* cw = (LAS float*)(lds + P2_CW);
    LAS float* KKs = (LAS float*)(lds + P2_KK); LAS float* QKs = (LAS float*)(lds + P2_QK);
    LAS float* gcS = (LAS float*)(lds + P2_SC); LAS float* betaS = gcS + 128; LAS float* egS = gcS + 256;
    DN_ISSUE(item, rawv, cwv, pbb, paa, td, ln);
    const float cbb = pbb, caa = paa;
#pragma unroll
    for (int e = 0; e < 4; ++e) { const int i = td + NTHR * e; if (i < 5 * 384) cw[i] = cwv[e]; }
#pragma unroll
    for (int e = 0; e < 7; ++e) { const int i = td + NTHR * e, rr = i / 48, ck = i % 48; if (i < 68 * 48) *(LAS v4u*)(raw + rr * 392 + ck * 8) = rawv[e]; }
    __syncthreads();
#pragma unroll 1
    for (int e = 0; e < 3; ++e) { const int idx = td + NTHR * e, jp = idx / 48, ck = idx - 48 * jp, sec = ck >> 4, c16 = ck & 15, j0 = 2 * jp;
        f32x4 cv[5][2];
#pragma unroll
        for (int w = 0; w < 5; ++w) { cv[w][0] = *(const LAS f32x4*)(cw + w * 384 + ck * 8); cv[w][1] = *(const LAS f32x4*)(cw + w * 384 + ck * 8 + 4); }
        float y[2][8];
#pragma unroll
        for (int k = 0; k < 8; ++k) { y[0][k] = 0.f; y[1][k] = 0.f; }
#pragma unroll
        for (int r = 0; r < 6; ++r) { float x[8]; unpack8(*(const LAS v4u*)(raw + (j0 + r) * 392 + ck * 8), x);
            if (r <= 4) {
#pragma unroll
                for (int k = 0; k < 4; ++k) { y[0][k] += x[k] * cv[r][0][k]; y[0][4 + k] += x[4 + k] * cv[r][1][k]; } }
            if (r >= 1) {
#pragma unroll
                for (int k = 0; k < 4; ++k) { y[1][k] += x[k] * cv[r - 1][0][k]; y[1][4 + k] += x[4 + k] * cv[r - 1][1][k]; } } }
#pragma unroll
        for (int u = 0; u < 2; ++u) { const int j = j0 + u;
            const float vm = (t0 + j) >= 0 ? 1.f : 0.f; float ss = 0.f;
#pragma unroll
            for (int k = 0; k < 8; ++k) { y[u][k] = y[u][k] * __builtin_amdgcn_rcpf(1.f + __expf(-y[u][k])) * vm; ss += y[u][k] * y[u][k]; }
            ss = row16_sum(ss);
            const float rq = __builtin_amdgcn_rsqf(ss + EPS); const float sc = sec == 2 ? 1.f : (sec == 0 ? 0.08838834764831845f * rq : rq);
#pragma unroll
            for (int k = 0; k < 8; ++k) y[u][k] *= sc;
            const v4u o = pack8(y[u]);
            LAS bf16* dl = (sec == 0 ? QNs : (sec == 1 ? KNs : VVs)) + j * 136 + c16 * 8; *(LAS v4u*)dl = o;
            if (sec < 2) *(v4u*)((sec == 0 ? QN : KN) + ((size_t)b * DNR + 64 * tc + j) * 512 + h * 128 + c16 * 8) = o; } }
    __syncthreads();
    { const int fr = ln & 15, fq = ln >> 4;
#pragma unroll
      for (int q = 0; q < 4; ++q) { const int idx = wave * 4 + q, which = idx >> 4, ti = (idx & 15) >> 2, tj = idx & 3;
          const LAS bf16* Ap = (which ? QNs : KNs) + (ti * 16 + fr) * 136 + fq * 8; const LAS bf16* Bp = KNs + (tj * 16 + fr) * 136 + fq * 8;
          f32x4 acc = (f32x4){0.f, 0.f, 0.f, 0.f};
#pragma unroll
          for (int ks = 0; ks < 4; ++ks) acc = __builtin_amdgcn_mfma_f32_16x16x32_bf16(*(const LAS bf16x8*)(Ap + ks * 32), *(const LAS bf16x8*)(Bp + ks * 32), acc, 0, 0, 0);
          LAS float* dst = which ? QKs : KKs;
#pragma unroll
          for (int r = 0; r < 4; ++r) dst[(ti * 16 + 4 * fq + r) * 65 + tj * 16 + fr] = acc[r]; } }
    if (wave < 2) { const int dir = wave, i = ln; const bool rev = dir && tc > 0; const int j = rev ? 63 - i : i, t = t0 + j;
        float beta = 0.f, g = 0.f;
        if (t >= 0) { const float bb = cbb, aa = caa;
            beta = 1.f / (1.f + expf(-bb)); const float x = aa + dt_bias[dir * 4 + h]; const float sp = x > 20.f ? x : log1pf(expf(x)); g = -expf(a_log[dir * 4 + h]) * sp; }
        float gc = g;
#pragma unroll
        for (int o = 1; o < 64; o <<= 1) { const float v = bperm_f(ln - o, gc); if (ln >= o) gc += v; }
        const float gl = bperm_f(63, gc);
        const float eg_ = __expf(gc);
        gcS[dir * 64 + i] = gc; betaS[dir * 64 + i] = beta; egS[dir * 64 + i] = eg_ * beta;
        float* G = (float*)(ws + WS_CH + CH_BYTES * (size_t)((((b * 2 + dir) * NCH + tc) * 4) + h) + CH_G);
        G[j] = eg_; G[64 + j] = __expf(gl - gc); if (i == 0) G[128] = __expf(gl); }
    __syncthreads();
    const int dir = td >> 8; const bool rev = dir && tc > 0;
    unsigned char* chunk = ws + WS_CH + CH_BYTES * (size_t)((((b * 2 + dir) * NCH + tc) * 4) + h);
    LAS float* As = (LAS float*)(lds + P2_AS) + dir * 4096;
    { LAS bf16* QKo = (LAS bf16*)(lds + P2_QN) + dir * 4096;
#pragma unroll 4
      for (int e = 0; e < 16; ++e) { const int idx = (td & 255) + 256 * e, i = idx >> 6, ip = idx & 63, j = rev ? 63 - i : i, jp = rev ? 63 - ip : ip;
          const float dec = __expf(fminf(gcS[dir * 64 + i] - gcS[dir * 64 + ip], 0.f));
          As[i * 64 + ip] = ip < i ? KKs[j * 65 + jp] * dec * betaS[dir * 64 + i] : 0.f;
          QKo[j * 64 + jp] = (bf16)f2bf(ip <= i ? QKs[j * 65 + jp] * dec : 0.f); } }
    __syncthreads();
    { unsigned char* cb = ws + WS_CH + CH_BYTES * (size_t)((((b * 2) * NCH + tc) * 4) + h);
#pragma unroll
      for (int e = 0; e < 2; ++e) { const int id = td + NTHR * e, d_ = id >> 9, rest = id & 511, row = rest >> 3, c8 = rest & 7;
          *(v4u*)(cb + (size_t)d_ * (CH_BYTES * NCH * 4) + CH_QK + row * 128 + c8 * 16) = *(const LAS v4u*)(lds + P2_QN + d_ * 8192 + row * 128 + c8 * 16); } }
    { typedef float f32x2 __attribute__((ext_vector_type(2)));
      const int col = td & 255; const bool isU = col < 128; const LAS bf16* src = isU ? VVs + col : KNs + (col - 128);
      const int jb = rev ? 63 : 0, js = rev ? -1 : 1;
      f32x2 x2[32];
      { const LAS bf16* sp = src + jb * 136; const int sstep = js * 136; const LAS float* scp = (isU ? betaS : egS) + dir * 64; asm volatile("" : "+v"(scp));
#pragma unroll
      for (int i = 0; i < 64; ++i) { x2[i >> 1][i & 1] = bf2f(*sp) * scp[i]; sp += sstep; asm volatile("" : "+v"(sp)); if ((i & 7) == 7) { asm volatile("" : "+v"(x2[i >> 1]) :: "memory"); __builtin_amdgcn_sched_barrier(0); } } }
      __syncthreads();
#pragma unroll
      for (int i = 1; i < 64; ++i) {
          f32x2 a01 = (f32x2){0.f, 0.f}, a23 = (f32x2){0.f, 0.f};
#pragma unroll
          for (int q = 0; 4 * q < i; ++q) { const f32x4 a = *(const LAS f32x4*)(As + i * 64 + 4 * q);
              a01 += (f32x2){a[0], a[1]} * x2[2 * q]; a23 += (f32x2){a[2], a[3]} * x2[2 * q + 1]; }
          const f32x2 t = a01 + a23; x2[i >> 1][i & 1] -= (t.x + t.y); asm volatile("" : "+v"(x2[i >> 1])); }
      { LAS bf16* xp = (LAS bf16*)lds + dir * 16384 + jb * 256 + col; const int xstep = js * 256;
#pragma unroll
      for (int i = 0; i < 64; ++i) { *xp = (bf16)f2bf(x2[i >> 1][i & 1]); xp += xstep; asm volatile("" : "+v"(xp)); } } }
    __syncthreads();
    { unsigned char* cb = ws + WS_CH + CH_BYTES * (size_t)((((b * 2) * NCH + tc) * 4) + h); int tl = td; asm volatile("" : "+v"(tl));
#pragma unroll
      for (int e = 0; e < 8; ++e) { const int id = tl + NTHR * e, d_ = id >> 11, rest = id & 2047, row = rest >> 5, c = rest & 31;
          *(v4u*)(cb + (size_t)d_ * (CH_BYTES * NCH * 4) + (c < 16 ? 0 : CH_W) + row * 256 + (c & 15) * 16) = *(const LAS v4u*)(lds + d_ * 32768 + row * 512 + c * 16); } }
    __syncthreads();
}

__device__ __forceinline__ void dn_scan(const Args& A, LAS unsigned char* lds, int chain, int tid, int wave, int lane) {
    unsigned char* ws = A.ws;
    const int b = chain >> 3, dir = (chain >> 2) & 1, h = chain & 3;
    const bf16* QN = (const bf16*)(ws + WS_QN); const bf16* KN = (const bf16*)(ws + WS_KN);
    bf16* Od = (bf16*)(ws + (dir ? WS_OB : WS_OF));
    LAS bf16* St = (LAS bf16*)(lds + SC_ST); LAS bf16* VT = (LAS bf16*)(lds + SC_VT); LAS bf16* Ws = (LAS bf16*)(lds + SC_W); LAS bf16* Qs = (LAS bf16*)(lds + SC_Q);
    LAS bf16* KT = (LAS bf16*)(lds + SC_KT); LAS bf16* QKs = (LAS bf16*)(lds + SC_QK); LAS bf16* Us = (LAS bf16*)(lds + SC_U); LAS bf16* Os = (LAS bf16*)(lds + SC_O);
    const int fr = lane & 15, fq = lane >> 4, vrow = 16 * wave + fr;
    f32x4 S[8];
#pragma unroll
    for (int m = 0; m < 8; ++m) S[m] = (f32x4){0.f, 0.f, 0.f, 0.f};
#pragma unroll
    for (int q = 0; q < 4; ++q) *(LAS v4u*)(St + vrow * 136 + fq * 32 + q * 8) = (v4u){0u, 0u, 0u, 0u};
    v4u rU0[2], rW0[2], rQ0[2], rK0[2], rQK0; float g10[2], g20[2], glp0;
    v4u rU1[2], rW1[2], rQ1[2], rK1[2], rQK1; float g11[2], g21[2], glp1;
#define SC_PREFETCH(s_, X) do { const int tc_ = (dir == 0 || (s_) == 0) ? (s_) : NCH - (s_); \
        const unsigned char* ck_ = ws + WS_CH + CH_BYTES * (size_t)((((b * 2 + dir) * NCH + tc_) * 4) + h); const float* G_ = (const float*)(ck_ + CH_G); \
        _Pragma("unroll") for (int i_ = 0; i_ < 2; ++i_) { const int id_ = tid + NTHR * i_, row_ = id_ >> 4, c16_ = id_ & 15; \
            rU##X[i_] = *(const v4u*)(ck_ + row_ * 256 + c16_ * 16); rW##X[i_] = *(const v4u*)(ck_ + CH_W + row_ * 256 + c16_ * 16); \
            const size_t qo_ = ((size_t)b * DNR + 64 * tc_ + row_) * 512 + h * 128 + c16_ * 8; rQ##X[i_] = *(const v4u*)(QN + qo_); rK##X[i_] = *(const v4u*)(KN + qo_); \
            g1##X[i_] = G_[row_]; g2##X[i_] = G_[64 + row_]; } \
        rQK##X = *(const v4u*)(ck_ + CH_QK + tid * 16); glp##X = G_[128]; } while (0)
    SC_PREFETCH(0, 0); SC_PREFETCH(1, 1);
#pragma unroll 1
    for (int s2 = 0; s2 < NCH; s2 += 2) {
      { const int s = s2;
        const int tc = (dir == 0 || s == 0) ? s : NCH - s;
        __syncthreads();
        const float gl = glp0;
        if (s > 0) { const int tcp = (dir == 0 || s == 1) ? s - 1 : NCH - (s - 1);
            if (tcp >= 1) {
#pragma unroll
                for (int i = 0; i < 2; ++i) { const int id = tid + NTHR * i, row = id >> 4, c16 = id & 15;
                    *(v4u*)(Od + ((size_t)b * SEQ + 64 * (tcp - 1) + row) * 512 + h * 128 + c16 * 8) = *(const LAS v4u*)(Os + row * 136 + c16 * 8); } } }
#pragma unroll
        for (int i = 0; i < 2; ++i) { const int id = tid + NTHR * i, row = id >> 4, c16 = id & 15;
            *(LAS v4u*)(Us + row * 136 + c16 * 8) = rU0[i]; *(LAS v4u*)(Ws + row * 136 + c16 * 8) = rW0[i];
            float q[8]; unpack8(rQ0[i], q);
#pragma unroll
            for (int e = 0; e < 8; ++e) q[e] *= g10[i];
            *(LAS v4u*)(Qs + row * 136 + c16 * 8) = pack8(q);
            float k[8]; unpack8(rK0[i], k);
#pragma unroll
            for (int e = 0; e < 8; ++e) KT[(c16 * 8 + e) * 72 + ((((row >> 3) ^ (c16 & 7)) << 3) | (row & 7))] = (bf16)f2bf(k[e] * g20[i]); }
        *(LAS v4u*)(QKs + (tid >> 3) * 72 + (tid & 7) * 8) = rQK0;
        __syncthreads();
        { const int sn_ = s + 2 < NCH ? s + 2 : NCH - 1; SC_PREFETCH(sn_, 0); }
        bf16x8 bS[4];
#pragma unroll
        for (int ks = 0; ks < 4; ++ks) bS[ks] = *(const LAS bf16x8*)(St + vrow * 136 + ks * 32 + fq * 8);
#pragma unroll
        for (int mt = 0; mt < 4; ++mt) { f32x4 acc = (f32x4){0.f, 0.f, 0.f, 0.f};
#pragma unroll
            for (int ks = 0; ks < 4; ++ks) acc = __builtin_amdgcn_mfma_f32_16x16x32_bf16(*(const LAS bf16x8*)(Ws + (16 * mt + fr) * 136 + ks * 32 + fq * 8), bS[ks], acc, 0, 0, 0);
            float vn[4];
#pragma unroll
            for (int r = 0; r < 4; ++r) vn[r] = bf2f(Us[(16 * mt + 4 * fq + r) * 136 + vrow]) - acc[r];
            v2u o; o.x = pk2(vn[0], vn[1]); o.y = pk2(vn[2], vn[3]); *(LAS v2u*)(VT + vrow * 72 + 16 * mt + 4 * fq) = o; }
        asm volatile("s_waitcnt lgkmcnt(0)" ::: "memory");
        bf16x8 bV[2];
#pragma unroll
        for (int ks = 0; ks < 2; ++ks) bV[ks] = *(const LAS bf16x8*)(VT + vrow * 72 + ks * 32 + fq * 8);
#pragma unroll
        for (int mt = 0; mt < 4; ++mt) { f32x4 acc = (f32x4){0.f, 0.f, 0.f, 0.f};
#pragma unroll
            for (int ks = 0; ks < 4; ++ks) acc = __builtin_amdgcn_mfma_f32_16x16x32_bf16(*(const LAS bf16x8*)(Qs + (16 * mt + fr) * 136 + ks * 32 + fq * 8), bS[ks], acc, 0, 0, 0);
#pragma unroll
            for (int ks = 0; ks < 2; ++ks) acc = __builtin_amdgcn_mfma_f32_16x16x32_bf16(*(const LAS bf16x8*)(QKs + (16 * mt + fr) * 72 + ks * 32 + fq * 8), bV[ks], acc, 0, 0, 0);
            if (tc >= 1) {
#pragma unroll
                for (int r = 0; r < 4; ++r) Os[(16 * mt + 4 * fq + r) * 136 + vrow] = (bf16)f2bf(acc[r]); } }
#pragma unroll
        for (int mt = 0; mt < 8; ++mt) { f32x4 acc = S[mt] * gl;
#pragma unroll
            for (int ks = 0; ks < 2; ++ks) acc = __builtin_amdgcn_mfma_f32_16x16x32_bf16(*(const LAS bf16x8*)(KT + (16 * mt + fr) * 72 + (((4 * ks + fq) ^ ((2 * mt + (fr >> 3)) & 7)) << 3)), bV[ks], acc, 0, 0, 0);
            S[mt] = acc; v2u o; o.x = pk2(acc[0], acc[1]); o.y = pk2(acc[2], acc[3]); *(LAS v2u*)(St + vrow * 136 + 16 * mt + 4 * fq) = o; }
        asm volatile("s_waitcnt lgkmcnt(0)" ::: "memory");
      }
      if (s2 + 1 < NCH) { const int s = s2 + 1;
        const int tc = (dir == 0 || s == 0) ? s : NCH - s;
        __syncthreads();
        const float gl = glp1;
        if (s > 0) { const int tcp = (dir == 0 || s == 1) ? s - 1 : NCH - (s - 1);
            if (tcp >= 1) {
#pragma unroll
                for (int i = 0; i < 2; ++i) { const int id = tid + NTHR * i, row = id >> 4, c16 = id & 15;
                    *(v4u*)(Od + ((size_t)b * SEQ + 64 * (tcp - 1) + row) * 512 + h * 128 + c16 * 8) = *(const LAS v4u*)(Os + row * 136 + c16 * 8); } } }
#pragma unroll
        for (int i = 0; i < 2; ++i) { const int id = tid + NTHR * i, row = id >> 4, c16 = id & 15;
            *(LAS v4u*)(Us + row * 136 + c16 * 8) = rU1[i]; *(LAS v4u*)(Ws + row * 136 + c16 * 8) = rW1[i];
            float q[8]; unpack8(rQ1[i], q);
#pragma unroll
            for (int e = 0; e < 8; ++e) q[e] *= g11[i];
            *(LAS v4u*)(Qs + row * 136 + c16 * 8) = pack8(q);
            float k[8]; unpack8(rK1[i], k);
#pragma unroll
            for (int e = 0; e < 8; ++e) KT[(c16 * 8 + e) * 72 + ((((row >> 3) ^ (c16 & 7)) << 3) | (row & 7))] = (bf16)f2bf(k[e] * g21[i]); }
        *(LAS v4u*)(QKs + (tid >> 3) * 72 + (tid & 7) * 8) = rQK1;
        __syncthreads();
        { const int sn_ = s + 2 < NCH ? s + 2 : NCH - 1; SC_PREFETCH(sn_, 1); }
        bf16x8 bS[4];
#pragma unroll
        for (int ks = 0; ks < 4; ++ks) bS[ks] = *(const LAS bf16x8*)(St + vrow * 136 + ks * 32 + fq * 8);
#pragma unroll
        for (int mt = 0; mt < 4; ++mt) { f32x4 acc = (f32x4){0.f, 0.f, 0.f, 0.f};
#pragma unroll
            for (int ks = 0; ks < 4; ++ks) acc = __builtin_amdgcn_mfma_f32_16x16x32_bf16(*(const LAS bf16x8*)(Ws + (16 * mt + fr) * 136 + ks * 32 + fq * 8), bS[ks], acc, 0, 0, 0);
            float vn[4];
#pragma unroll
            for (int r = 0; r < 4; ++r) vn[r] = bf2f(Us[(16 * mt + 4 * fq + r) * 136 + vrow]) - acc[r];
            v2u o; o.x = pk2(vn[0], vn[1]); o.y = pk2(vn[2], vn[3]); *(LAS v2u*)(VT + vrow * 72 + 16 * mt + 4 * fq) = o; }
        asm volatile("s_waitcnt lgkmcnt(0)" ::: "memory");
        bf16x8 bV[2];
#pragma unroll
        for (int ks = 0; ks < 2; ++ks) bV[ks] = *(const LAS bf16x8*)(VT + vrow * 72 + ks * 32 + fq * 8);
#pragma unroll
        for (int mt = 0; mt < 4; ++mt) { f32x4 acc = (f32x4){0.f, 0.f, 0.f, 0.f};
#pragma unroll
            for (int ks = 0; ks < 4; ++ks) acc = __builtin_amdgcn_mfma_f32_16x16x32_bf16(*(const LAS bf16x8*)(Qs + (16 * mt + fr) * 136 + ks * 32 + fq * 8), bS[ks], acc, 0, 0, 0);
#pragma unroll
            for (int ks = 0; ks < 2; ++ks) acc = __builtin_amdgcn_mfma_f32_16x16x32_bf16(*(const LAS bf16x8*)(QKs + (16 * mt + fr) * 72 + ks * 32 + fq * 8), bV[ks], acc, 0, 0, 0);
            if (tc >= 1) {
#pragma unroll
                for (int r = 0; r < 4; ++r) Os[(16 * mt + 4 * fq + r) * 136 + vrow] = (bf16)f2bf(acc[r]); } }
#pragma unroll
        for (int mt = 0; mt < 8; ++mt) { f32x4 acc = S[mt] * gl;
#pragma unroll
            for (int ks = 0; ks < 2; ++ks) acc = __builtin_amdgcn_mfma_f32_16x16x32_bf16(*(const LAS bf16x8*)(KT + (16 * mt + fr) * 72 + (((4 * ks + fq) ^ ((2 * mt + (fr >> 3)) & 7)) << 3)), bV[ks], acc, 0, 0, 0);
            S[mt] = acc; v2u o; o.x = pk2(acc[0], acc[1]); o.y = pk2(acc[2], acc[3]); *(LAS v2u*)(St + vrow * 136 + 16 * mt + 4 * fq) = o; }
        asm volatile("s_waitcnt lgkmcnt(0)" ::: "memory");
      }
    }
#undef SC_PREFETCH
    __syncthreads();
    { const int tcp = (dir == 0) ? NCH - 1 : 1;
#pragma unroll
      for (int i = 0; i < 2; ++i) { const int id = tid + NTHR * i, row = id >> 4, c16 = id & 15;
          *(v4u*)(Od + ((size_t)b * SEQ + 64 * (tcp - 1) + row) * 512 + h * 128 + c16 * 8) = *(const LAS v4u*)(Os + row * 136 + c16 * 8); } }
    __syncthreads();
}
#define XB_TMO      128
#define XB_XCNT(j)  (256  + 64 * (j))
#define XB_XSUB(j)  (1280 + 64 * (j))
#define XB_XGEN(j)  (2304 + 64 * (j))
#define XB_TOP      3328
#define XB_TOPGEN   3392
#define XCD_BAR_WORDS 3456
#define XB_SPIN_CAP (1u << 18)

__device__ __forceinline__ unsigned xb_ld(unsigned* p)              { return __hip_atomic_load(p, __ATOMIC_RELAXED, __HIP_MEMORY_SCOPE_AGENT); }
__device__ __forceinline__ unsigned xb_add(unsigned* p, unsigned v) { return __hip_atomic_fetch_add(p, v, __ATOMIC_RELAXED, __HIP_MEMORY_SCOPE_AGENT); }
__device__ __forceinline__ unsigned xb_xcc_id() { return (unsigned)__builtin_amdgcn_s_getreg((3 << 11) | 20) & 0xFu; }
#define XB_SPIN(cond, bar) do { unsigned _sp = 0; while (cond) { __builtin_amdgcn_s_sleep(1); \
    if ((++_sp & 255u) == 0u) { if (xb_ld(&(bar)[XB_TMO])) break; if (_sp > XB_SPIN_CAP) { atomicAdd(&(bar)[XB_TMO], 1u); break; } } } } while (0)

struct XcdBarrier {
    unsigned* bar; unsigned x;
    volatile LAS unsigned* st;
};

__device__ __forceinline__ XcdBarrier xcd_barrier_post(unsigned* bar, volatile LAS unsigned* st) {
    XcdBarrier b; b.bar = bar; b.x = xb_xcc_id(); b.st = st;
    if (threadIdx.x == 0) (void)xb_add(&bar[XB_XCNT(b.x)], 1u);
    return b;
}
__device__ __forceinline__ void xcd_barrier_complete(unsigned* bar, unsigned x, unsigned& nloc, unsigned& nx) {
    const unsigned G = gridDim.x * gridDim.y * gridDim.z;
    unsigned sum, cnt, mine, sp = 0u;
    for (;;) {
        sum = 0u; cnt = 0u; mine = 0u;
#pragma unroll
        for (unsigned j = 0; j < 16; ++j) { const unsigned c = xb_ld(&bar[XB_XCNT(j)]); sum += c; cnt += (c > 0u) ? 1u : 0u; mine = (j == x) ? c : mine; }
        if (sum == G) break;
        __builtin_amdgcn_s_sleep(1);
        if ((++sp & 255u) == 0u) { if (xb_ld(&bar[XB_TMO])) break; if (sp > XB_SPIN_CAP) { atomicAdd(&bar[XB_TMO], 1u); break; } }
    }
    nloc = mine > 0u ? mine : 1u; nx = cnt > 0u ? cnt : 1u;
}

__device__ __forceinline__ void xcd_barrier(const XcdBarrier& b) {
    asm volatile("s_waitcnt vmcnt(0)" ::: "memory");
    __syncthreads();
    if (threadIdx.x == 0) {
        unsigned* bar = b.bar;
        __builtin_amdgcn_s_waitcnt(0);
        unsigned nloc = b.st[0], nx = b.st[1];
        if (nloc == 0u) { xcd_barrier_complete(bar, b.x, nloc, nx); b.st[0] = nloc; b.st[1] = nx; }
        const unsigned old = xb_add(&bar[XB_XSUB(b.x)], 1u);
        const unsigned gen = old / nloc;
        if (old + 1u == (gen + 1u) * nloc) {
            __builtin_amdgcn_fence(__ATOMIC_RELEASE, "agent");
            asm volatile("s_waitcnt vmcnt(0)" ::: "memory");
            const unsigned og = xb_add(&bar[XB_TOP], 1u);
            const unsigned tg = og / nx;
            if (og + 1u == (tg + 1u) * nx) xb_add(&bar[XB_TOPGEN], 1u);
            else XB_SPIN(xb_ld(&bar[XB_TOPGEN]) == tg, bar);
            __builtin_amdgcn_fence(__ATOMIC_ACQUIRE, "agent");
            xb_add(&bar[XB_XGEN(b.x)], 1u);
            asm volatile("s_waitcnt vmcnt(0)" ::: "memory");
        } else {
            XB_SPIN(xb_ld(&bar[XB_XGEN(b.x)]) == gen, bar);
            __builtin_amdgcn_fence(__ATOMIC_ACQUIRE, "agent");
            asm volatile("s_waitcnt vmcnt(0)" ::: "memory");
        }
    }
    __syncthreads();
}

__device__ __forceinline__ void dn_combine_panel(const Args& args, int pm, int wave, int lane) {
    unsigned char* ws = args.ws;
    const bf16* OF = (const bf16*)(ws + WS_OF); const bf16* OB = (const bf16*)(ws + WS_OB); const bf16* DZ = (const bf16*)(ws + WS_DZ); bf16* CAT = (bf16*)(ws + WS_CAT);
    const float* onw = args.in[6]; const int r0 = pm * 256;
            { int ln_ = lane; asm volatile("" : "+v"(ln_));
              float onv[8];
#pragma unroll
              for (int e = 0; e < 8; ++e) onv[e] = onw[(ln_ & 15) * 8 + e];
#pragma unroll 1
              for (int rb = wave * 32; rb < wave * 32 + 32; rb += 4) { v4u va[4], vc[4], vz[4];
#pragma unroll
                  for (int u = 0; u < 4; ++u) { const int r = r0 + rb + u, b = r >> 13, s = r & (SEQ - 1);
                      va[u] = *(const v4u*)(OF + (size_t)r * 512 + ln_ * 8); vc[u] = *(const v4u*)(OB + (size_t)r * 512 + ln_ * 8); vz[u] = *(const v4u*)(DZ + ((size_t)b * LT + NMETA + s) * 512 + ln_ * 8); }
#pragma unroll
                  for (int u = 0; u < 4; ++u) { const int r = r0 + rb + u; float a[8], c[8], z[8]; unpack8(va[u], a); unpack8(vc[u], c); unpack8(vz[u], z);
                      float ss = 0.f;
#pragma unroll
                      for (int e = 0; e < 8; ++e) { a[e] += c[e]; ss += a[e] * a[e]; }
                      ss += __shfl_xor(ss, 1); ss += __shfl_xor(ss, 2); ss += __shfl_xor(ss, 4); ss += __shfl_xor(ss, 8);
                      const float rs = __builtin_amdgcn_rsqf(ss * (1.f / 128.f) + EPS);
#pragma unroll
                      for (int e = 0; e < 8; ++e) a[e] = a[e] * rs * onv[e] * silu_f(z[e]);
                      *(v4u*)(CAT + (size_t)r * 1024 + ln_ * 8) = pack8(a); } } }
}

__global__ void __launch_bounds__(NWAVES * 64, 2) hymba_fwd(Args args) {
    extern __shared__ __attribute__((aligned(16))) unsigned char lds_raw[];
    LAS unsigned char* lds = (LAS unsigned char*)lds_raw;
    cg::grid_group grid = cg::this_grid();
    const int tid = threadIdx.x, lane = tid & 63, wave = __builtin_amdgcn_readfirstlane(tid >> 6);
    const int G = gridDim.x, bx = blockIdx.x;
    const int vcu = (G % 8 == 0) ? (bx % 8) * (G / 8) + bx / 8 : bx;
    const int gw = vcu * NWAVES + wave, NGW = G * NWAVES;
    unsigned char* ws = args.ws;
    const int lo = args.ph_lo, hi = args.ph_hi;
#define IN(k) (lo <= (k) && (k) < hi)
#define SEAM(k) do { if (IN(k) && IN((k) + 1)) { if ((k) == 0) grid.sync(); else xcd_barrier(xbar); } } while (0)
    volatile LAS unsigned* xbst = (volatile LAS unsigned*)(lds + XBST_OFF);
    if (tid < 16) xbst[tid] = 0u;
    __syncthreads();
    const XcdBarrier xbar = xcd_barrier_post((unsigned*)(ws + WS_CTL) + 4096, xbst);
    bf16* Win_t = (bf16*)(ws + WS_WIN); bf16* Wout_t = (bf16*)(ws + WS_WOUT); bf16* Wup_t = (bf16*)(ws + WS_WUP); bf16* Wdn_t = (bf16*)(ws + WS_WDN);

    if (IN(0)) {
        LAS float* scr = (LAS float*)(lds + wave * 16384);
        constexpr int I_IN = (DM / 64) * (NIN / 32), I_OUT = (DM / 64) * (DM / 32), I_UP = (DM / 64) * (FF / 32), I_DN = (FF / 64) * (DM / 32);
        for (int it = gw; it < I_IN + I_OUT + I_UP + I_DN; it += NGW) {
            int r = it;
            if (r < I_IN) { p0_transpose_item<1>(args.in[2], DM, 2832, NIN, Win_t, scr, r, lane); continue; } r -= I_IN;
            if (r < I_OUT) { p0_transpose_item<0>(args.in[9], DM, DM, DM, Wout_t, scr, r, lane); continue; } r -= I_OUT;
            if (r < I_UP) { p0_transpose_item<0>(args.in[12], DM, FF, FF, Wup_t, scr, r, lane); continue; } r -= I_UP;
            p0_transpose_item<0>(args.in[13], FF, DM, DM, Wdn_t, scr, r, lane);
        }
        bf16* XN = (bf16*)(ws + WS_XN);
        { f32x4 wv[4];
#pragma unroll
          for (int j = 0; j < 4; ++j) wv[j] = ((const f32x4*)args.in[10] + lane)[64 * j];
          if (gw < NMETA) rms_row_to_bf16(args.in[1] + (size_t)gw * DM, args.in[10], XN + (size_t)(MR + gw) * DM, lane);
#pragma unroll 1
          for (int mb = gw; mb < MR; mb += 4 * NGW) { f32x4 xv[4][4];
#pragma unroll
              for (int u = 0; u < 4; ++u) { const f32x4* src = (const f32x4*)(args.in[0] + (size_t)(mb + u * NGW) * DM) + lane;
#pragma unroll
                  for (int j = 0; j < 4; ++j) xv[u][j] = src[64 * j]; }
#pragma unroll
              for (int u = 0; u < 4; ++u) { const int m = mb + u * NGW; float s = 0.f;
#pragma unroll
                  for (int j = 0; j < 4; ++j) s += (xv[u][j].x * xv[u][j].x + xv[u][j].y * xv[u][j].y) + (xv[u][j].z * xv[u][j].z + xv[u][j].w * xv[u][j].w);
                  const float rs = __builtin_amdgcn_rsqf(wave_sum(s) * (1.f / DM) + EPS);
                  v2u* o8 = (v2u*)(XN + (size_t)m * DM) + lane;
#pragma unroll
                  for (int j = 0; j < 4; ++j) { const f32x4 v = xv[u][j], ww = wv[j]; v2u o; o.x = pk2(v.x * rs * ww.x, v.y * rs * ww.y); o.y = pk2(v.z * rs * ww.z, v.w * rs * ww.w); o8[64 * j] = o; } } } }
    }
    SEAM(0);
    if (IN(1)) {
        if (gw < NIN / 16) {
            const int fr = lane & 15, fq = lane >> 4, nt = gw;
            const bf16* Ap = (const bf16*)(ws + WS_XN) + (size_t)(MR + fr) * DM + fq * 8; const bf16* Bp = Win_t + (size_t)(16 * nt + fr) * DM + fq * 8;
            f32x4 acc = (f32x4){0.f, 0.f, 0.f, 0.f};
#pragma unroll 8
            for (int ks = 0; ks < DM / 32; ++ks) acc = __builtin_amdgcn_mfma_f32_16x16x32_bf16(*(const bf16x8*)(Ap + ks * 32), *(const bf16x8*)(Bp + ks * 32), acc, 0, 0, 0);
            const int c = 16 * nt + fr;
            for (int b = 0; b < NB; ++b) {
#pragma unroll
                for (int r = 0; r < 4; ++r) { const size_t m = (size_t)b * LT + 4 * fq + r; const float v = acc[r];
                    if (c < 1536) ((bf16*)(ws + WS_DQKV))[m * 1536 + c] = (bf16)f2bf(v);
                    else if (c < 2048) ((bf16*)(ws + WS_DZ))[m * 512 + (c - 1536)] = (bf16)f2bf(v);
                    else if (c < 2816) ((bf16*)(ws + WS_AQKV))[m * 768 + (c - 2048)] = (bf16)f2bf(v);
                    else if (c < 2832) ((float*)(ws + WS_BA))[m * 16 + (c - 2816)] = v; } }
        }
        pg8::Gemm g{(const bf16*)(ws + WS_XN), Win_t, MR, NIN, DM}; pg8::StaticOrder S; S.init(MR, NIN, G, bx);
        pg8::EpiProj E{(bf16*)(ws + WS_DQKV), (bf16*)(ws + WS_DZ), (bf16*)(ws + WS_AQKV), (float*)(ws + WS_BA)};
        pg8::gemm_phase<pg8::EpiProj, pg8::StaticOrder, true, true>(lds, g, S, E);
    }
    SEAM(1);
    if (IN(2)) {
        { LAS float* rope = (LAS float*)(lds + ROPE_OFF);
#pragma unroll 1
          for (int e = 0; e < 4; ++e) { const int idx = tid + NTHR * e, pos = idx >> 4, f = idx & 15; float sv, cv; sincosf((float)pos * exp2f(-(float)f * (13.287712379549449f / 16.f)), &sv, &cv); rope[idx] = cv; rope[2048 + idx] = sv; }
          __syncthreads(); }
        { v4u rawv[7]; float cwv[4]; float pbb = 0.f, paa = 0.f;
          const bf16* DQKV = (const bf16*)(ws + WS_DQKV); const float* BA = (const float*)(ws + WS_BA); const float* conv_w = args.in[3];
          for (int item = bx; item < NB * NCH * 4; item += G) dn_prep_item(args, lds, item, item + G, rawv, cwv, pbb, paa, tid, wave, lane); }
        { const bf16* AQ = (const bf16*)(ws + WS_AQKV); const LAS float* rope = (const LAS float*)(lds + ROPE_OFF);
          constexpr int NGRP = NB * LKP / 4, HEAVY_G = 18; const int extra = (NB * NCH * 4) % G;
          int gs, ge;
          if (bx < extra) { gs = bx * HEAVY_G; ge = gs + HEAVY_G; }
          else { const long rem = NGRP - (long)extra * HEAVY_G; const int nl = G - extra; gs = extra * HEAVY_G + (int)(((long)(bx - extra) * rem) / nl); ge = extra * HEAVY_G + (int)(((long)(bx - extra + 1) * rem) / nl); }
#pragma unroll 1
          for (int g = gs + wave; g < ge; g += NWAVES) { v4u qd[4], kd[4];
#pragma unroll
              for (int u = 0; u < 4; ++u) { const int i_ = 4 * g + u, b = i_ / LKP, t = i_ % LKP, tq = t < LT ? t : LT - 1;
                  const bf16* row = AQ + (size_t)(b * LT + tq) * 768; qd[u] = *(const v4u*)(row + lane * 8); kd[u] = *(const v4u*)(row + 512 + (lane & 31) * 8); }
#pragma unroll
              for (int u = 0; u < 4; ++u) { const int i_ = 4 * g + u;
                  attn_prep_row(qd[u], kd[u], rope, args.in[7], args.in[8], (bf16*)(ws + WS_Q), (bf16*)(ws + WS_KB), (bf16*)(ws + WS_VB), i_ / LKP, i_ % LKP, lane); } } }
    }
    SEAM(2);
    if (IN(3)) {
        unsigned* ctl = (unsigned*)(ws + WS_CTL);
        for (int chain = bx; chain < NB * 8; chain += G) { dn_scan(args, lds, chain, tid, wave, lane);
            asm volatile("s_waitcnt vmcnt(0)" ::: "memory"); __syncthreads();
            if (tid == 0) { __builtin_amdgcn_fence(__ATOMIC_RELEASE, "agent"); asm volatile("s_waitcnt vmcnt(0)" ::: "memory"); __hip_atomic_fetch_add(ctl + 64 * 12, 1u, __ATOMIC_RELAXED, __HIP_MEMORY_SCOPE_AGENT); } }
        volatile LAS int* slot = (volatile LAS int*)(lds + QSLOT_OFF);
        const unsigned xcc = xcc_id() & 7u;
        for (;;) {
            if (tid == 0) { int u = -1;
                for (unsigned k = 0; k < 8; ++k) { const unsigned q = (xcc + k) & 7u; const unsigned idx = __hip_atomic_fetch_add(ctl + 64 * (1 + q), 1u, __ATOMIC_RELAXED, __HIP_MEMORY_SCOPE_AGENT); if (idx < 256u) { u = (int)(q * 512u + idx); break; } }
                if (u < 0) { const unsigned p = __hip_atomic_fetch_add(ctl + 64 * 13, 1u, __ATOMIC_RELAXED, __HIP_MEMORY_SCOPE_AGENT); if (p < 256u) u = (int)((p >> 5) * 512u + 256u + (p & 31u)); }
                if (u >= 0 && (u & 511) >= 256) {
                    unsigned sp = 0; while (__hip_atomic_load(ctl + 64 * 12, __ATOMIC_RELAXED, __HIP_MEMORY_SCOPE_AGENT) < (unsigned)(NB * 8) && ++sp < (1u << 22)) __builtin_amdgcn_s_sleep(2);
                    __builtin_amdgcn_fence(__ATOMIC_ACQUIRE, "agent"); asm volatile("s_waitcnt vmcnt(0)" ::: "memory"); }
                *slot = u; }
            __syncthreads();
            const int u = *slot;
            __syncthreads();
            if (u < 0) break;
            if ((u & 511) >= 256) { dn_combine_panel(args, (u >> 9) * 32 + ((u & 511) - 256), wave, lane); continue; }
            const int q = u >> 9, idx = u & 255, pair = q * 2 + (idx >> 7), gh = (idx >> 5) & 3, qb = idx & 31, b = pair >> 1, kvh = pair & 1, h = kvh * 4 + gh;
            const attn_body::bf16* Qu = (const attn_body::bf16*)(ws + WS_Q) + ((size_t)(b * SEQ + qb * 256)) * 512 + h * 64;
            const attn_body::bf16* Kh = (const attn_body::bf16*)(ws + WS_KB) + ((size_t)(b * 2 + kvh) * LKP) * 64;
            const attn_body::bf16* Vh = (const attn_body::bf16*)(ws + WS_VB) + ((size_t)(b * 2 + kvh) * LKP) * 64;
            attn_body::bf16* Ou = (attn_body::bf16*)(ws + WS_CAT) + ((size_t)(b * SEQ + qb * 256)) * 1024 + 512 + h * 64;
            attn_body::attn_unit<8>(Qu, Kh, Vh, Ou, (char*)lds_raw);
        }
    }
    SEAM(3);
    if (IN(4)) {
#define CU_LOCAL_SYNC() do { asm volatile("s_waitcnt vmcnt(0)" ::: "memory"); __syncthreads(); __builtin_amdgcn_fence(__ATOMIC_ACQUIRE, "agent"); asm volatile("s_waitcnt vmcnt(0)" ::: "memory"); } while (0)
        const bf16* OF = (const bf16*)(ws + WS_OF); const bf16* OB = (const bf16*)(ws + WS_OB); const bf16* DZ = (const bf16*)(ws + WS_DZ); bf16* CAT = (bf16*)(ws + WS_CAT);
        bf16* MIXB = (bf16*)(ws + WS_MIX); bf16* XN2 = (bf16*)(ws + WS_CAT);
        const float* onw = args.in[6];
        if (bx < MR / 256) { const int pm = bx;
            const int r0 = pm * 256;
            { pg8::Gemm g{(const bf16*)CAT, Wout_t, MR, DM, DM}; pg8::PanelOrder S{pm, DM / 256};
              pg8::EpiBf16<0> E{MIXB, DM, nullptr, 0, 0, 1.f};
              pg8::gemm_phase<pg8::EpiBf16<0>, pg8::PanelOrder, true, true>(lds, g, S, E); }
            CU_LOCAL_SYNC();
            { int ln_ = lane; asm volatile("" : "+v"(ln_));
              f32x4 w1v[4], w2v[4];
#pragma unroll
              for (int j = 0; j < 4; ++j) { w1v[j] = ((const f32x4*)args.in[11] + ln_)[64 * j]; w2v[j] = ((const f32x4*)args.in[14] + ln_)[64 * j]; }
#pragma unroll 1
              for (int rb = wave * 32; rb < wave * 32 + 32; rb += 4) { v2u mv[4][4]; f32x4 xv[4][4];
#pragma unroll
                  for (int u = 0; u < 4; ++u) { const int r = r0 + rb + u; const v2u* mr = (const v2u*)(MIXB + (size_t)r * DM) + ln_; const f32x4* xr = (const f32x4*)(args.in[0] + (size_t)r * DM) + ln_;
#pragma unroll
                      for (int j = 0; j < 4; ++j) { mv[u][j] = mr[64 * j]; xv[u][j] = xr[64 * j]; } }
#pragma unroll
                  for (int u = 0; u < 4; ++u) { const int r = r0 + rb + u; f32x4 v[4]; float s = 0.f;
#pragma unroll
                      for (int j = 0; j < 4; ++j) { const v2u m = mv[u][j]; v[j] = (f32x4){__builtin_bit_cast(float, m.x << 16), __builtin_bit_cast(float, m.x & 0xffff0000u), __builtin_bit_cast(float, m.y << 16), __builtin_bit_cast(float, m.y & 0xffff0000u)};
                          s += (v[j].x * v[j].x + v[j].y * v[j].y) + (v[j].z * v[j].z + v[j].w * v[j].w); }
                      const float rs = __builtin_amdgcn_rsqf(wave_sum(s) * (1.f / DM) + EPS); float s2 = 0.f;
                      f32x4* orow = (f32x4*)(args.out + (size_t)r * DM) + ln_;
#pragma unroll
                      for (int j = 0; j < 4; ++j) { v[j] = xv[u][j] + v[j] * rs * w1v[j]; orow[64 * j] = v[j]; s2 += (v[j].x * v[j].x + v[j].y * v[j].y) + (v[j].z * v[j].z + v[j].w * v[j].w); }
                      const float rs2 = __builtin_amdgcn_rsqf(wave_sum(s2) * (1.f / DM) + EPS);
                      v2u* o8 = (v2u*)(XN2 + (size_t)r * DM) + ln_;
#pragma unroll
                      for (int j = 0; j < 4; ++j) { const f32x4 ww = w2v[j]; v2u o; o.x = pk2(v[j].x * rs2 * ww.x, v[j].y * rs2 * ww.y); o.y = pk2(v[j].z * rs2 * ww.z, v[j].w * rs2 * ww.w); o8[64 * j] = o; } } } }
            CU_LOCAL_SYNC();
        }
#undef CU_LOCAL_SYNC
    }
    SEAM(4);
    if (IN(5)) {
        pg8::Gemm g{(const bf16*)(ws + WS_CAT), Wup_t, MR, FF, DM}; pg8::StaticOrder S; S.init(MR, FF, G, bx);
        pg8::EpiRelu2 E{(bf16*)(ws + WS_HID), FF};
        pg8::gemm_phase<pg8::EpiRelu2, pg8::StaticOrder, true, true>(lds, g, S, E);
    }
    SEAM(5);
    if (IN(6)) {
        pg8::Gemm g{(const bf16*)(ws + WS_HID), Wdn_t, MR, DM, FF}; pg8::StaticOrder S; S.init(MR, DM, G, bx);
        pg8::EpiBf16<0> E{(bf16*)(ws + WS_MIX), DM, nullptr, 0, 0, 1.f};
        pg8::gemm_phase<pg8::EpiBf16<0>, pg8::StaticOrder, true, true>(lds, g, S, E);
    }
    SEAM(6);
    if (IN(7)) {
        const bf16* MIXB = (const bf16*)(ws + WS_MIX);
        f32x4 w1v[4];
#pragma unroll
        for (int j = 0; j < 4; ++j) w1v[j] = ((const f32x4*)args.in[15] + lane)[64 * j];
#pragma unroll 1
        for (int rb = gw; rb < MR; rb += 4 * NGW) { v2u mv[4][4]; f32x4 hv[4][4];
#pragma unroll
            for (int u = 0; u < 4; ++u) { const int r = rb + u * NGW; const v2u* mr = (const v2u*)(MIXB + (size_t)r * DM) + lane; const f32x4* hr = (const f32x4*)(args.out + (size_t)r * DM) + lane;
#pragma unroll
                for (int j = 0; j < 4; ++j) { mv[u][j] = mr[64 * j]; hv[u][j] = hr[64 * j]; } }
#pragma unroll
            for (int u = 0; u < 4; ++u) { const int r = rb + u * NGW; f32x4 v[4]; float s = 0.f;
#pragma unroll
                for (int j = 0; j < 4; ++j) { const v2u m = mv[u][j]; v[j] = (f32x4){__builtin_bit_cast(float, m.x << 16), __builtin_bit_cast(float, m.x & 0xffff0000u), __builtin_bit_cast(float, m.y << 16), __builtin_bit_cast(float, m.y & 0xffff0000u)};
                    s += (v[j].x * v[j].x + v[j].y * v[j].y) + (v[j].z * v[j].z + v[j].w * v[j].w); }
                const float rs = __builtin_amdgcn_rsqf(wave_sum(s) * (1.f / DM) + EPS);
                f32x4* orow = (f32x4*)(args.out + (size_t)r * DM) + lane;
#pragma unroll
                for (int j = 0; j < 4; ++j) orow[64 * j] = hv[u][j] + v[j] * rs * w1v[j]; } }
    }
#undef IN
#undef SEAM
}

extern "C" void kernel_launch(void* const* d_in, const int* in_sizes, int n_in, void* d_out, int out_size, void* d_ws, size_t ws_size, hipStream_t stream) {
    static int grid = 0;
    if (grid == 0) {
        if (n_in != 16 || in_sizes[0] != MR * DM || out_size != MR * DM || ws_size < WS_END) { fprintf(stderr, "kernel_launch: unexpected shapes / workspace (n_in %d, in0 %d, out %d, ws %zu)\n", n_in, n_in > 0 ? in_sizes[0] : -1, out_size, ws_size); grid = -1; return; }
        int dev = 0, cus = 0, per_cu = 0;
        if (hipGetDevice(&dev) != hipSuccess || hipDeviceGetAttribute(&cus, hipDeviceAttributeMultiprocessorCount, dev) != hipSuccess) { grid = -1; return; }
        if (hipFuncSetAttribute((const void*)hymba_fwd, hipFuncAttributeMaxDynamicSharedMemorySize, LDS_BYTES) != hipSuccess) { fprintf(stderr, "kernel_launch: hipFuncSetAttribute failed\n"); grid = -1; return; }
        if (hipOccupancyMaxActiveBlocksPerMultiprocessor(&per_cu, (const void*)hymba_fwd, NWAVES * 64, LDS_BYTES) != hipSuccess || per_cu < 1) { fprintf(stderr, "kernel_launch: occupancy query says %d\n", per_cu); per_cu = 1; }
        (void)hipGetLastError();
        grid = cus >= 256 ? 256 : cus;
        if (grid != 256) fprintf(stderr, "kernel_launch: %d CUs: this build needs 256 workgroups\n", cus);
    }
    if (grid < 0) return;
    (void)hipMemsetAsync((char*)d_ws + WS_CTL, 0, CTL_ZERO_BYTES, stream);
    Args a{};
    for (int i = 0; i < 16; ++i) a.in[i] = (const float*)d_in[i];
    a.out = (float*)d_out; a.ws = (unsigned char*)d_ws;
#if ONE_LAUNCH
    a.ph_lo = 0; a.ph_hi = NPHASE;
    void* kargs[] = {&a};
    hipError_t e = hipLaunchCooperativeKernel((const void*)hymba_fwd, dim3(grid), dim3(NWAVES * 64), kargs, LDS_BYTES, stream);
    if (e != hipSuccess) fprintf(stderr, "kernel_launch: cooperative launch failed: %s (grid %d)\n", hipGetErrorString(e), grid);
#else
    for (int p = 0; p < NPHASE; ++p) { a.ph_lo = p; a.ph_hi = p + 1; hipLaunchKernelGGL(hymba_fwd, dim3(grid), dim3(NWAVES * 64), LDS_BYTES, stream, a); }
#endif
}
```

```cpp
#include <hip/hip_runtime.h>
#include <cstdio>
#include <cstdint>
namespace pg8 {
#define PG8_LAS __attribute__((address_space(3)))
typedef unsigned short bf16_t;
typedef short bf16x8 __attribute__((ext_vector_type(8)));
typedef float f32x4 __attribute__((ext_vector_type(4)));
typedef unsigned u32x4 __attribute__((ext_vector_type(4)));
constexpr int BM = 256, BK = 64, HALF = 128, HTB = HALF * BK * 2  , STAGE_BYTES = 8 * HTB, NXCD = 8, WGM = 8;

__host__ __device__ __forceinline__ int lds_byte(int r, int c) { const int st = (r >> 4) * 2 + (c >> 5), rr = r & 15, cc = c & 31, ob = rr * 64 + cc * 2; return st * 1024 + (ob ^ (((ob >> 9) & 1) << 5)); }
__host__ __device__ __forceinline__ void stage_rc(int b, int& R, int& C) { const int st = b / 1024, sb = b % 1024, swz = sb ^ (((sb >> 9) & 1) << 5); R = (st >> 1) * 16 + swz / 64; C = (st & 1) * 32 + (swz % 64) / 2; }
__host__ __device__ __forceinline__ int perm32(int rho) { const int n = rho >> 4, i = rho & 15; return 8 * (i >> 2) + 4 * n + (i & 3); }

struct Unit { int pm, pn; };
struct Gemm { const bf16_t* A; const bf16_t* Bt; int M, N, K; };

struct StaticOrder {
    int nM, nN, nwg, G, c;
    __host__ __device__ void init(int M, int N, int G_, int c_) { nM = M / BM; nN = N / BM; nwg = nM * nN; G = G_; c = c_; }
    __host__ __device__ bool next(int i, Unit& u) const {
        const long L = (long)i * G + c; if (L >= nwg) return false;
        int wgid = (int)L; { const int q = nwg / NXCD, r = nwg % NXCD, xcd = wgid % NXCD, off = wgid / NXCD; wgid = (xcd < r ? xcd * (q + 1) : r * (q + 1) + (xcd - r) * q) + off; }
        const int nig = WGM * nN, gid = wgid / nig, fm = gid * WGM, gsz = (nM - fm) < WGM ? (nM - fm) : WGM;
        u.pm = fm + ((wgid % nig) % gsz); u.pn = (wgid % nig) / gsz; return true;
    }
    __device__ __forceinline__ void a_ready(const Unit&) const {}
    __device__ __forceinline__ void done(const Unit&) const {}
};

__device__ __forceinline__ unsigned cvt_pk_bf16(float lo, float hi) { unsigned r; asm volatile("v_cvt_pk_bf16_f32 %0, %1, %2" : "=v"(r) : "v"(lo), "v"(hi)); return r; }
typedef float f32x2 __attribute__((ext_vector_type(2)));
__device__ __forceinline__ f32x2 gelu_pk(f32x2 v) {
    const f32x2 av = __builtin_elementwise_abs(v), d = av * 0.2316418882f + 1.0f;
    f32x2 t; t.x = __builtin_amdgcn_rcpf(d.x); t.y = __builtin_amdgcn_rcpf(d.y);
    f32x2 q = t * 0.5307027145f + (-0.7265760135f); q = q * t + 0.7107068705f; q = q * t + (-0.142248368f); q = q * t + 0.127414796f; q = q * t;
    const f32x2 s = (v * v) * (-0.72134752044f);
    f32x2 e; e.x = __builtin_amdgcn_exp2f(s.x); e.y = __builtin_amdgcn_exp2f(s.y);
    const f32x2 m = v * (q * e), r = v - m;
    f32x2 o; o.x = v.x < 0.f ? m.x : r.x; o.y = v.y < 0.f ? m.y : r.y; return o;
}

template <int ACT  > struct EpiBf16 {
    static constexpr bool PERM = true, AFTER_DRAIN = false; static_assert(ACT == 0 || ACT == 1, "EpiBf16: ACT is 0 (none) or 1 (gelu_pk)");
    bf16_t* O; int ldc; const float* bias; int split_cols; size_t split_stride; float scale0;
    __device__ __forceinline__ void operator()(const f32x4 (&acc)[2][2][4][2], const Unit& u, int wr, int wc, int fr, int fq) const {
        const int row0 = u.pm * BM + wr * 64 + fr; int colt = u.pn * BM; bf16_t* base = O;
        float sc = 1.f; if (split_cols) { const int t = colt / split_cols; base += (size_t)t * split_stride; colt -= t * split_cols; if (t == 0) sc = scale0; }
        const int col0 = colt + wc * 32 + 8 * fq, bcol0 = u.pn * BM + wc * 32 + 8 * fq;
        f32x4 bv[2][2];
#pragma unroll
        for (int bj = 0; bj < 2; ++bj)
#pragma unroll
            for (int n = 0; n < 2; ++n) bv[bj][n] = bias ? *(const f32x4*)(bias + bcol0 + bj * HALF + 4 * n) : (f32x4){0.f, 0.f, 0.f, 0.f};
#pragma unroll
        for (int ai = 0; ai < 2; ++ai)
#pragma unroll
            for (int m = 0; m < 4; ++m) { bf16_t* rowp = base + (size_t)(row0 + ai * HALF + m * 16) * ldc + col0;
#pragma unroll
                for (int bj = 0; bj < 2; ++bj) { f32x4 v0 = acc[ai][bj][m][0] + bv[bj][0], v1 = acc[ai][bj][m][1] + bv[bj][1];
                    if (ACT == 1) { f32x2 a = gelu_pk((f32x2){v0[0], v0[1]}), b = gelu_pk((f32x2){v0[2], v0[3]}), c = gelu_pk((f32x2){v1[0], v1[1]}), d = gelu_pk((f32x2){v1[2], v1[3]});
                        v0 = (f32x4){a.x, a.y, b.x, b.y}; v1 = (f32x4){c.x, c.y, d.x, d.y}; }
                    v0 = v0 * sc; v1 = v1 * sc; u32x4 w; w.x = cvt_pk_bf16(v0[0], v0[1]); w.y = cvt_pk_bf16(v0[2], v0[3]); w.z = cvt_pk_bf16(v1[0], v1[1]); w.w = cvt_pk_bf16(v1[2], v1[3]);
                    *(u32x4*)(rowp + bj * HALF) = w; } }
    }
};
struct PanelOrder {
    int pm, nN;
    __device__ __forceinline__ bool next(int i, Unit& u) const { if (i >= nN) return false; int p = i; asm volatile("" : "+s"(p)); u.pm = pm; u.pn = p; return true; }
    __device__ __forceinline__ void a_ready(const Unit&) const {}
    __device__ __forceinline__ void done(const Unit&) const {}
};
struct EpiProj {
    static constexpr bool PERM = true, AFTER_DRAIN = false;
    bf16_t* dqkv; bf16_t* dz; bf16_t* aqkv; float* ba;
    __device__ __forceinline__ void operator()(const f32x4 (&acc)[2][2][4][2], const Unit& u, int wr, int wc, int fr, int fq) const {
        const int row0 = u.pm * BM + 16 * ((u.pm >> 5) + 1) + wr * 64 + fr; const int pn = u.pn;
        if (pn == 11) {
            if (wc == 0 && fq < 2) {
#pragma unroll
                for (int ai = 0; ai < 2; ++ai)
#pragma unroll
                    for (int m = 0; m < 4; ++m) { float* p = ba + (size_t)(row0 + ai * HALF + m * 16) * 16 + 8 * fq; *(f32x4*)p = acc[ai][0][m][0]; *(f32x4*)(p + 4) = acc[ai][0][m][1]; }
            }
            return;
        }
        bf16_t* base; int ldc, colt;
        if (pn < 6) { base = dqkv; ldc = 1536; colt = pn * 256; } else if (pn < 8) { base = dz; ldc = 512; colt = (pn - 6) * 256; } else { base = aqkv; ldc = 768; colt = (pn - 8) * 256; }
        const int col0 = colt + wc * 32 + 8 * fq;
#pragma unroll
        for (int ai = 0; ai < 2; ++ai)
#pragma unroll
            for (int m = 0; m < 4; ++m) { bf16_t* rowp = base + (size_t)(row0 + ai * HALF + m * 16) * ldc + col0;
#pragma unroll
                for (int bj = 0; bj < 2; ++bj) { const f32x4 v0 = acc[ai][bj][m][0], v1 = acc[ai][bj][m][1];
                    u32x4 w; w.x = cvt_pk_bf16(v0[0], v0[1]); w.y = cvt_pk_bf16(v0[2], v0[3]); w.z = cvt_pk_bf16(v1[0], v1[1]); w.w = cvt_pk_bf16(v1[2], v1[3]);
                    *(u32x4*)(rowp + bj * HALF) = w; } }
    }
};
struct EpiRelu2 {
    static constexpr bool PERM = true, AFTER_DRAIN = false;
    bf16_t* O; int ldc;
    __device__ __forceinline__ void operator()(const f32x4 (&acc)[2][2][4][2], const Unit& u, int wr, int wc, int fr, int fq) const {
        const int row0 = u.pm * BM + wr * 64 + fr; const int col0 = u.pn * BM + wc * 32 + 8 * fq;
#pragma unroll
        for (int ai = 0; ai < 2; ++ai)
#pragma unroll
            for (int m = 0; m < 4; ++m) { bf16_t* rowp = O + (size_t)(row0 + ai * HALF + m * 16) * ldc + col0;
#pragma unroll
                for (int bj = 0; bj < 2; ++bj) { f32x4 v0 = acc[ai][bj][m][0], v1 = acc[ai][bj][m][1];
#pragma unroll
                    for (int e = 0; e < 4; ++e) { const float a = fmaxf(v0[e], 0.f), b = fmaxf(v1[e], 0.f); v0[e] = a * a; v1[e] = b * b; }
                    u32x4 w; w.x = cvt_pk_bf16(v0[0], v0[1]); w.y = cvt_pk_bf16(v0[2], v0[3]); w.z = cvt_pk_bf16(v1[0], v1[1]); w.w = cvt_pk_bf16(v1[2], v1[3]);
                    *(u32x4*)(rowp + bj * HALF) = w; } }
    }
};
struct EpiF32 {
    static constexpr bool PERM = false, AFTER_DRAIN = false;
    float* O; int ldc;
    __device__ __forceinline__ void operator()(const f32x4 (&acc)[2][2][4][2], const Unit& u, int wr, int wc, int fr, int fq) const {
        const int row0 = u.pm * BM + wr * 64 + fr; const int col0 = u.pn * BM + wc * 32 + 4 * fq;
#pragma unroll
        for (int ai = 0; ai < 2; ++ai)
#pragma unroll
            for (int m = 0; m < 4; ++m) { float* rowp = O + (size_t)(row0 + ai * HALF + m * 16) * ldc + col0;
#pragma unroll
                for (int bj = 0; bj < 2; ++bj)
#pragma unroll
                    for (int n = 0; n < 2; ++n) *(f32x4*)(rowp + bj * HALF + n * 16) = acc[ai][bj][m][n]; }
    }
};
template <class Epi, class Sched, bool ALIGN_EPI = false, bool SP2 = false>
__device__ __forceinline__ void gemm_phase(PG8_LAS unsigned char* lds, const Gemm g, const Sched& S, const Epi& E) {
    const int tid = threadIdx.x, wid = __builtin_amdgcn_readfirstlane(tid >> 6), lane = tid & 63, wr = wid >> 2, wc = wid & 3, fr = lane & 15, fq = lane >> 4;
    const int K = g.K, nt = K / BK;
    unsigned voffA[2], voffB[2];
#pragma unroll
    for (int i = 0; i < 2; ++i) { int R, C; stage_rc(tid * 16 + i * 8192, R, C); const int Rb = Epi::PERM ? ((R & ~31) + perm32(R & 31)) : R;
        voffA[i] = (unsigned)(R * K + C) * 2u; voffB[i] = (unsigned)(Rb * K + C) * 2u; }
    const size_t kstep = (size_t)(BK * 2);
    const size_t hstep = (size_t)HALF * K * 2;
    const size_t tstep = 2 * hstep;
    const unsigned ldsw = (unsigned)wid * 1024u;
    const int aoff = lds_byte(wr * 64 + fr, fq * 8), boff = lds_byte(wc * 32 + fr, fq * 8);
#define PG8_SA(b, h) (((b) * 2 + (h)) * HTB)
#define PG8_SB(b, h) ((4 + (b) * 2 + (h)) * HTB)
#define PG8_STAGE(bufoff, gbase, voff) do { _Pragma("unroll") for (int _i = 0; _i < 2; ++_i) \
        __builtin_amdgcn_global_load_lds((const unsigned*)((const char*)(gbase) + (voff)[_i]), (PG8_LAS unsigned*)(lds + (bufoff) + ldsw + _i * 8192), 16, 0, 0); } while (0)
#define PG8_LDA(dst, b, h) do { _Pragma("unroll") for (int m = 0; m < 4; ++m) _Pragma("unroll") for (int k = 0; k < 2; ++k) dst[m][k] = *(const PG8_LAS bf16x8*)(lds + PG8_SA(b, h) + aoff + m * 2048 + k * 1024); } while (0)
#define PG8_LDB(dst, b, h) do { _Pragma("unroll") for (int n = 0; n < 2; ++n) _Pragma("unroll") for (int k = 0; k < 2; ++k) dst[n][k] = *(const PG8_LAS bf16x8*)(lds + PG8_SB(b, h) + boff + n * 2048 + k * 1024); } while (0)
#define PG8_MMA(ai, bj, At, Bt) do { __builtin_amdgcn_s_setprio(1); _Pragma("unroll") for (int m = 0; m < 4; ++m) _Pragma("unroll") for (int n = 0; n < 2; ++n) _Pragma("unroll") for (int k = 0; k < 2; ++k) \
        acc[ai][bj][m][n] = __builtin_amdgcn_mfma_f32_16x16x32_bf16(Bt[n][k], At[m][k], acc[ai][bj][m][n], 0, 0, 0); __builtin_amdgcn_s_setprio(0); } while (0)
#define PG8_WAIT_V(n) asm volatile("s_waitcnt vmcnt(" #n ")" ::: "memory")
#define PG8_WAIT_L(n) asm volatile("s_waitcnt lgkmcnt(" #n ")" ::: "memory")
#define PG8_BAR __builtin_amdgcn_s_barrier()
#define PG8_SCHED __builtin_amdgcn_sched_barrier(0)
    Unit cur, nxt; int ui = 0;
    if (!S.next(0, cur)) return;
    f32x4 acc[2][2][4][2];
#pragma unroll
    for (int a = 0; a < 2; ++a)
#pragma unroll
        for (int b = 0; b < 2; ++b)
#pragma unroll
            for (int m = 0; m < 4; ++m)
#pragma unroll
                for (int n = 0; n < 2; ++n) acc[a][b][m][n] = (f32x4){0.f, 0.f, 0.f, 0.f};
    bf16x8 At[4][2], B0[2][2], B1[2][2];
    const char* cA = (const char*)g.A + (size_t)cur.pm * tstep; const char* cB = (const char*)g.Bt + (size_t)cur.pn * tstep;
    S.a_ready(cur);
    if constexpr (SP2) {
        PG8_STAGE(PG8_SB(0, 0), cB, voffB); PG8_STAGE(PG8_SB(0, 1), cB + hstep, voffB); PG8_STAGE(PG8_SA(0, 0), cA, voffA); PG8_STAGE(PG8_SA(0, 1), cA + hstep, voffA);
        if (wr == 1) PG8_BAR;
        PG8_WAIT_V(2); PG8_BAR;
        PG8_STAGE(PG8_SB(1, 0), cB + kstep, voffB); PG8_STAGE(PG8_SA(1, 0), cA + kstep, voffA); PG8_STAGE(PG8_SB(1, 1), cB + hstep + kstep, voffB);
        PG8_WAIT_V(6); PG8_BAR;
    } else {
        PG8_STAGE(PG8_SB(0, 0), cB, voffB); PG8_STAGE(PG8_SA(0, 0), cA, voffA); PG8_STAGE(PG8_SB(0, 1), cB + hstep, voffB); PG8_STAGE(PG8_SA(0, 1), cA + hstep, voffA);
        if (wr == 1) PG8_BAR;
        PG8_WAIT_V(4); PG8_BAR;
        PG8_STAGE(PG8_SB(1, 0), cB + kstep, voffB); PG8_STAGE(PG8_SA(1, 0), cA + kstep, voffA); PG8_STAGE(PG8_SB(1, 1), cB + hstep + kstep, voffB);
        PG8_WAIT_V(6); PG8_BAR;
    }
    for (;;) {
        const bool has_next = S.next(ui + 1, nxt);
        const char* nA = has_next ? (const char*)g.A + (size_t)nxt.pm * tstep : cA; const char* nB = has_next ? (const char*)g.Bt + (size_t)nxt.pn * tstep : cB;
        for (int t = 0; t < nt; t += 2) {
            const bool last = (t == nt - 2);
            const char* a1 = cA + (size_t)(t + 1) * kstep;
            const char* a2 = last ? nA : cA + (size_t)(t + 2) * kstep; const char* b2 = last ? nB : cB + (size_t)(t + 2) * kstep;
            const char* a3 = a2 + kstep; const char* b3 = b2 + kstep;
            if (last && has_next) S.a_ready(nxt);
            if constexpr (SP2) {
            PG8_LDB(B0, 0, 0); PG8_LDB(B1, 0, 1); PG8_SCHED; PG8_LDA(At, 0, 0); PG8_STAGE(PG8_SA(1, 1), a1 + hstep, voffA);
            PG8_WAIT_V(8); PG8_WAIT_L(0); PG8_BAR; PG8_MMA(0, 0, At, B0); PG8_MMA(0, 1, At, B1); PG8_BAR; PG8_SCHED;
            PG8_LDA(At, 0, 1); PG8_STAGE(PG8_SB(0, 0), b2, voffB); PG8_STAGE(PG8_SB(0, 1), b2 + hstep, voffB); PG8_STAGE(PG8_SA(0, 0), a2, voffA);
            PG8_WAIT_V(8); PG8_WAIT_L(0); PG8_BAR; PG8_MMA(1, 0, At, B0); PG8_MMA(1, 1, At, B1); PG8_BAR; PG8_SCHED;
            PG8_LDB(B0, 1, 0); PG8_LDB(B1, 1, 1); PG8_SCHED; PG8_LDA(At, 1, 0); PG8_STAGE(PG8_SA(0, 1), a2 + hstep, voffA);
            PG8_WAIT_V(8); PG8_WAIT_L(0); PG8_BAR; PG8_MMA(0, 0, At, B0); PG8_MMA(0, 1, At, B1); PG8_BAR; PG8_SCHED;
            PG8_LDA(At, 1, 1); PG8_STAGE(PG8_SB(1, 0), b3, voffB); PG8_STAGE(PG8_SB(1, 1), b3 + hstep, voffB); PG8_STAGE(PG8_SA(1, 0), a3, voffA);
            PG8_WAIT_V(8); PG8_WAIT_L(0); PG8_BAR; PG8_MMA(1, 0, At, B0); PG8_MMA(1, 1, At, B1); PG8_BAR; PG8_SCHED;
            } else {
            PG8_LDB(B0, 0, 0); PG8_SCHED; PG8_LDA(At, 0, 0); PG8_STAGE(PG8_SA(1, 1), a1 + hstep, voffA);
            PG8_WAIT_L(8); PG8_BAR; PG8_WAIT_L(0); PG8_MMA(0, 0, At, B0); PG8_BAR; PG8_SCHED;
            PG8_LDB(B1, 0, 1); PG8_STAGE(PG8_SB(0, 0), b2, voffB);
            PG8_BAR; PG8_WAIT_L(0); PG8_MMA(0, 1, At, B1); PG8_BAR;
            PG8_LDA(At, 0, 1); PG8_STAGE(PG8_SA(0, 0), a2, voffA);
            PG8_BAR; PG8_WAIT_L(0); PG8_MMA(1, 0, At, B0); PG8_BAR; PG8_SCHED;
            PG8_STAGE(PG8_SB(0, 1), b2 + hstep, voffB);
            PG8_WAIT_V(6); PG8_BAR; PG8_MMA(1, 1, At, B1); PG8_BAR;
            PG8_LDB(B0, 1, 0); PG8_SCHED; PG8_LDA(At, 1, 0); PG8_STAGE(PG8_SA(0, 1), a2 + hstep, voffA);
            PG8_WAIT_L(8); PG8_BAR; PG8_WAIT_L(0); PG8_MMA(0, 0, At, B0); PG8_BAR; PG8_SCHED;
            PG8_LDB(B1, 1, 1); PG8_STAGE(PG8_SB(1, 0), b3, voffB);
            PG8_BAR; PG8_WAIT_L(0); PG8_MMA(0, 1, At, B1); PG8_BAR;
            PG8_LDA(At, 1, 1); PG8_STAGE(PG8_SA(1, 0), a3, voffA);
            PG8_BAR; PG8_WAIT_L(0); PG8_MMA(1, 0, At, B0); PG8_BAR; PG8_SCHED;
            PG8_STAGE(PG8_SB(1, 1), b3 + hstep, voffB);
            PG8_WAIT_V(6); PG8_BAR; PG8_MMA(1, 1, At, B1); PG8_BAR;
            }
        }
        if constexpr (ALIGN_EPI) { if (wr == 0) PG8_BAR; }
        if constexpr (!Epi::AFTER_DRAIN) { E(acc, cur, wr, wc, fr, fq); S.done(cur); }
        if (!has_next) break;
#pragma unroll
        for (int a = 0; a < 2; ++a)
#pragma unroll
            for (int b = 0; b < 2; ++b)
#pragma unroll
                for (int m = 0; m < 4; ++m)
#pragma unroll
                    for (int n = 0; n < 2; ++n) acc[a][b][m][n] = (f32x4){0.f, 0.f, 0.f, 0.f};
        cur = nxt; cA = nA; cB = nB; ++ui;
        if constexpr (ALIGN_EPI) { if (wr == 1) PG8_BAR; }
    }
    PG8_WAIT_V(0);
    if constexpr (!ALIGN_EPI) { if (wr == 0) PG8_BAR; }
    PG8_BAR;
    if constexpr (Epi::AFTER_DRAIN) { E.fused(acc, cur, wr, wc, fr, fq, lds, wid, lane); S.done(cur); }
#undef PG8_SA
#undef PG8_SB
#undef PG8_STAGE
#undef PG8_LDA
#undef PG8_LDB
#undef PG8_MMA
#undef PG8_WAIT_V
#undef PG8_WAIT_L
#undef PG8_BAR
#undef PG8_SCHED
}
}

#ifndef PG8_SP2
#define PG8_SP2 true
#endif
#ifndef PG8_ALIGN
#define PG8_ALIGN true
#endif
#include <hip/hip_bf16.h>
#include <cmath>
namespace attn_body {
using bf16=__hip_bfloat16;
using bf16x8=__attribute__((ext_vector_type(8)))short;
using s16x4=__attribute__((ext_vector_type(4)))short;
using f32x16=__attribute__((ext_vector_type(16)))float;
using u32x4=__attribute__((ext_vector_type(4)))unsigned;
constexpr int D=64,QP=512,OP=1024,KP=64,NKT=130,NKEYS=8208;
constexpr int NW=8,QBLK=32,QB=QBLK*NW,KVBLK=64;
constexpr int ATTN_UNIT_ROWS=QB;
__device__ __forceinline__ int crow(int r,int hi){return (r&3)+8*(r>>2)+4*hi;}
#define SBAR() __builtin_amdgcn_sched_barrier(0)
__device__ __forceinline__ void kmask(f32x16&p0,f32x16&p1,int t,int hi){
  const float NEG=-INFINITY; int kb=64*t+4*hi;
  #pragma unroll
  for(int r=0;r<16;++r){int kv=kb+(r&3)+8*(r>>2); if(kv>=NKEYS)p0[r]=NEG; if(kv+32>=NKEYS)p1[r]=NEG;}
}

constexpr int NSLOT=3, SLOTB=8192;
constexpr int LDS_K=0, LDS_V=NSLOT*SLOTB, LDS_WS=2*NSLOT*SLOTB, LDS_OST=LDS_WS+NW*64*4, LDS_BYTES=LDS_OST+NW*4096;
constexpr float C2=0.125f*1.4426950408889634f;
__device__ __forceinline__ void glds16(const void*gsrc,unsigned lds_dst){unsigned keep;
  asm volatile("s_mov_b32 %0, m0\n\ts_mov_b32 m0, %2\n\ts_nop 0\n\tglobal_load_lds_dwordx4 %1, off\n\ts_mov_b32 m0, %0":"=&s"(keep):"v"(gsrc),"s"(lds_dst):"memory");}
__device__ __forceinline__ float max3f(float a,float b,float c){float r;asm("v_max3_f32 %0, %1, %2, %3":"=v"(r):"v"(a),"v"(b),"v"(c));return r;}
__device__ __forceinline__ float max2f(float a,float b){float r;asm("v_max_f32_e32 %0, %1, %2":"=v"(r):"v"(a),"v"(b));return r;}
__device__ __forceinline__ float fadd_s(float a,float b){float r;asm("v_add_f32_e32 %0, %1, %2":"=v"(r):"v"(a),"v"(b));return r;}
__device__ __forceinline__ float fsub_s(float a,float b){float r;asm("v_sub_f32_e32 %0, %1, %2":"=v"(r):"v"(a),"v"(b));return r;}
typedef float f32x2_t __attribute__((ext_vector_type(2))); typedef __bf16 bf16x2_t __attribute__((ext_vector_type(2)));
__device__ __forceinline__ unsigned cvtpk_s(float lo,float hi){f32x2_t v={lo,hi};bf16x2_t b=__builtin_convertvector(v,bf16x2_t);return __builtin_bit_cast(unsigned,b);}
#define WAIT_BAR(N) asm volatile("s_waitcnt vmcnt(" #N ") lgkmcnt(0)\n\ts_barrier":::"memory")

__device__ __forceinline__ void qkt(f32x16&p0,f32x16&p1,const char*Kslot,const bf16x8*qr,const f32x16&negm,int r32,int hi){
  const char*kb=Kslot+hi*1024+r32*16;
  #pragma unroll
  for(int d0=0;d0<4;++d0){
    const bf16x8 b0=*reinterpret_cast<const bf16x8*>(kb+d0*2048);
    const bf16x8 b1=*reinterpret_cast<const bf16x8*>(kb+d0*2048+512);
    if(d0==0){p0=__builtin_amdgcn_mfma_f32_32x32x16_bf16(b0,qr[0],negm,0,0,0);p1=__builtin_amdgcn_mfma_f32_32x32x16_bf16(b1,qr[0],negm,0,0,0);}
    else{p0=__builtin_amdgcn_mfma_f32_32x32x16_bf16(b0,qr[d0],p0,0,0,0);p1=__builtin_amdgcn_mfma_f32_32x32x16_bf16(b1,qr[d0],p1,0,0,0);}}
}
typedef __attribute__((address_space(3))) const char* lds_cptr;
typedef short v4i16_t __attribute__((ext_vector_type(4)));
__device__ __forceinline__ void kload8(bf16x8*kf,lds_cptr kp){
  kf[0]=*(const __attribute__((address_space(3))) bf16x8*)(kp);      kf[1]=*(const __attribute__((address_space(3))) bf16x8*)(kp+512);
  kf[2]=*(const __attribute__((address_space(3))) bf16x8*)(kp+2048); kf[3]=*(const __attribute__((address_space(3))) bf16x8*)(kp+2560);
  kf[4]=*(const __attribute__((address_space(3))) bf16x8*)(kp+4096); kf[5]=*(const __attribute__((address_space(3))) bf16x8*)(kp+4608);
  kf[6]=*(const __attribute__((address_space(3))) bf16x8*)(kp+6144); kf[7]=*(const __attribute__((address_space(3))) bf16x8*)(kp+6656);
}
__device__ __forceinline__ void kload2(bf16x8*kf,lds_cptr kp,int j){ kf[2*j]=*(const __attribute__((address_space(3))) bf16x8*)(kp+j*2048); kf[2*j+1]=*(const __attribute__((address_space(3))) bf16x8*)(kp+j*2048+512); }
__device__ __forceinline__ s16x4 vtr(lds_cptr p){ return __builtin_bit_cast(s16x4,__builtin_amdgcn_ds_read_tr16_b64_v4i16((__attribute__((address_space(3))) v4i16_t*)p)); }
__device__ __forceinline__ float rowmax(const f32x16&p0,const f32x16&p1){
  float a=max3f(p0[0],p0[1],p1[0]),b=max3f(p0[2],p0[3],p1[1]);a=max3f(a,p1[2],p1[3]);
  #pragma unroll
  for(int r=4;r<16;r+=4){a=max3f(a,p0[r],p0[r+1]);b=max3f(b,p0[r+2],p0[r+3]);a=max3f(a,p1[r],p1[r+1]);b=max3f(b,p1[r+2],p1[r+3]);}
  const float m=max2f(a,b);
  auto rr=__builtin_amdgcn_permlane32_swap(__float_as_uint(m),__float_as_uint(m),false,false);
  return max2f(__uint_as_float(rr[0]),__uint_as_float(rr[1]));
}
__device__ __forceinline__ void pv(f32x16*o,int vb,bf16x8 pa0,bf16x8 pa1,bf16x8 pa2,bf16x8 pa3){
  #pragma unroll
  for(int d0=0;d0<2;++d0){s16x4 lo[4],hi[4];
    #pragma unroll
    for(int ks=0;ks<4;++ks){
      asm volatile("ds_read_b64_tr_b16 %0,%1 offset:%c2":"=&v"(lo[ks]):"v"(vb),"i"(d0*4096+ks*1024):"memory");
      asm volatile("ds_read_b64_tr_b16 %0,%1 offset:%c2":"=&v"(hi[ks]):"v"(vb),"i"(d0*4096+ks*1024+512):"memory");}
    asm volatile("s_waitcnt lgkmcnt(0)":::"memory");SBAR();
    #define PK(k) (bf16x8){lo[k][0],lo[k][1],lo[k][2],lo[k][3],hi[k][0],hi[k][1],hi[k][2],hi[k][3]}
    o[d0]=__builtin_amdgcn_mfma_f32_32x32x16_bf16(pa0,PK(0),o[d0],0,0,0);
    o[d0]=__builtin_amdgcn_mfma_f32_32x32x16_bf16(pa1,PK(1),o[d0],0,0,0);
    o[d0]=__builtin_amdgcn_mfma_f32_32x32x16_bf16(pa2,PK(2),o[d0],0,0,0);
    o[d0]=__builtin_amdgcn_mfma_f32_32x32x16_bf16(pa3,PK(3),o[d0],0,0,0);
    #undef PK
  }
}

#ifndef ATTN_STORE16
#define ATTN_STORE16(p,v) (*(u32x4*)(p)=(v))
#endif
template<int THRL> __device__ __forceinline__ void attn_unit(const bf16*Qu,const bf16*__restrict__ Kh,const bf16*__restrict__ Vh,bf16*Ou,char*shm){
  const int tid=threadIdx.x,lane=tid&63,r32=lane&31,hi=lane>>5; const int wid=__builtin_amdgcn_readfirstlane(tid>>6);
  const bf16*Qw=Qu+(long)(wid*QBLK)*QP;
  const unsigned lds0=(unsigned)(uintptr_t)shm;
  float*wsf=(float*)(shm+LDS_WS)+wid*64;
  const bf16*ksrc=Kh+(long)lane*KP+wid*8;
  const bf16*vsrc=Vh+(long)(16*(wid&3)+(lane>>2))*KP+(wid>>2)*32+(lane&3)*8;
  const unsigned kdst=lds0+LDS_K+wid*1024, vdst=lds0+LDS_V+wid*1024;
  #define DMA_K(t,slot) glds16(ksrc+(long)(t)*KVBLK*KP,(unsigned)__builtin_amdgcn_readfirstlane(kdst+(slot)))
  #define DMA_V(t,slot) glds16(vsrc+(long)(t)*KVBLK*KP,(unsigned)__builtin_amdgcn_readfirstlane(vdst+(slot)))
  const int vb0=(int)(lds0+LDS_V)+((lane>>4)&1)*32+(lane&3)*8+(4*hi+((lane&15)>>2))*64;
  const char*Kbase=shm+LDS_K; bf16x8 kf[8];
  const lds_cptr shm3=(lds_cptr)shm; const lds_cptr kp0=shm3+LDS_K+hi*1024+r32*16; const lds_cptr vp0=shm3+LDS_V+((lane>>4)&1)*32+(lane&3)*8+(4*hi+((lane&15)>>2))*64;
  constexpr int NT=NKT;
  DMA_K(0,0);DMA_V(0,0);DMA_K(1,SLOTB);
  bf16x8 qr[4];
  #pragma unroll
  for(int d0=0;d0<4;++d0)qr[d0]=*reinterpret_cast<const bf16x8*>(&Qw[(long)r32*QP+d0*16+hi*8]);
  float mhat=0.f,l_reg=0.f;f32x16 o[2];o[0]=f32x16{};o[1]=f32x16{};f32x16 negm=f32x16{};asm volatile("":"+v"(negm));
  #define CMASK(P0,P1,t) do{ if((t)>=NT-2) kmask(P0,P1,(t),hi);}while(0)
  bool resc=false;
  #define START(P0,P1) do{ const float rm=rowmax(P0,P1); resc=false; \
    { const float dl=rm; mhat=fadd_s(mhat,dl); \
      _Pragma("unroll") for(int r=0;r<16;++r){P0[r]=fsub_s(P0[r],dl);P1[r]=fsub_s(P1[r],dl);} \
      _Pragma("unroll") for(int r=0;r<16;++r)negm[r]=-mhat; asm volatile("":"+v"(negm)); } \
    _Pragma("unroll") for(int r=0;r<16;++r)P0[r]=__builtin_amdgcn_exp2f(P0[r]); }while(0)
  #define RESC() do{ if(resc){ asm volatile("s_waitcnt lgkmcnt(0)":::"memory"); \
      _Pragma("unroll") for(int d_=0;d_<2;++d_) _Pragma("unroll") for(int r=0;r<16;++r)o[d_][r]*=wsf[crow(r,hi)]; } }while(0)
  f32x16 pA0,pA1,pB0,pB1;
  int sl_prev=0,sl_cur=0,sl_next=SLOTB;
  #define ROT() do{sl_prev=sl_cur;sl_cur=sl_next;sl_next=(sl_next==(NSLOT-1)*SLOTB)?0:sl_next+SLOTB;}while(0)
  DMA_K(2,2*SLOTB);
  WAIT_BAR(3);
  qkt(pA0,pA1,Kbase,qr,negm,r32,hi);asm volatile("s_nop 15\n\ts_nop 7":"+v"(pA0),"+v"(pA1));CMASK(pA0,pA1,0);
  START(pA0,pA1);
  _Pragma("unroll") for(int r=0;r<16;++r)pA1[r]=__builtin_amdgcn_exp2f(pA1[r]);
  WAIT_BAR(0);
  DMA_K(3,0);DMA_V(1,SLOTB);
  ROT();
  kload8(kf,kp0+sl_cur);
  WAIT_BAR(2);
  s16x4 vlo[8],vhi[8]; u32x4 pw0,pw1,pw2,pw3;
  #define PKW(P,B) cvtpk_s(P[B],P[B+1])
  #define PAF(k) __builtin_bit_cast(bf16x8,pw##k)
  #define VFR(i) (bf16x8){vlo[i][0],vlo[i][1],vlo[i][2],vlo[i][3],vhi[i][0],vhi[i][1],vhi[i][2],vhi[i][3]}
  #define PIN(x) asm volatile("":"+v"(x))
  #define MX3(a,b,c) __builtin_fmaxf(__builtin_fmaxf((a),(b)),(c))
  #define GAPA(MF,A0,A1,A2,A3,W0,W1,PW) do{ MF; sacc+=A0; sacc+=A1; sacc+=A2; sacc+=A3; PIN(sacc); W0; W1; PIN(PW); SBAR(); }while(0)
  #define EX(v) __builtin_amdgcn_exp2f(v)
  #define GAPB(MF,X,B) do{ MF; X[B]=EX(X[B]); X[B+1]=EX(X[B+1]); X[B+2]=EX(X[B+2]); X[B+3]=EX(X[B+3]); PIN(X); SBAR(); }while(0)
  #define VRD(i) do{ vlo[i]=vtr(vp_+(((i)>>2)*4096+((i)&3)*1024)); vhi[i]=vtr(vp_+(((i)>>2)*4096+((i)&3)*1024+512)); }while(0)
  #define KRD(G,j) do{ if(G){ kload2(kf,kp0+sl_next,j); SBAR(); } }while(0)
  #define STEP(C0,C1,P0,P1,t,GK,GV,GL) do{ SBAR(); \
    const lds_cptr vp_=vp0+sl_prev; \
    VRD(0); SBAR(); float sacc=(P0[0]+P0[1]); \
    GAPA(C0=__builtin_amdgcn_mfma_f32_32x32x16_bf16(kf[0],qr[0],negm,0,0,0), P0[2],P0[3],P0[4],P0[5],     pw0[0]=PKW(P0,0), pw0[1]=PKW(P0,2), pw0); \
    VRD(4); SBAR(); GAPA(C1=__builtin_amdgcn_mfma_f32_32x32x16_bf16(kf[1],qr[0],negm,0,0,0), P0[6],P0[7],P0[8],P0[9],     pw0[2]=PKW(P0,4), pw0[3]=PKW(P0,6), pw0); \
    VRD(1); SBAR(); GAPA(C0=__builtin_amdgcn_mfma_f32_32x32x16_bf16(kf[2],qr[1],C0,0,0,0),   P0[10],P0[11],P0[12],P0[13], pw1[0]=PKW(P0,8), pw1[1]=PKW(P0,10), pw1); \
    VRD(5); SBAR(); GAPA(C1=__builtin_amdgcn_mfma_f32_32x32x16_bf16(kf[3],qr[1],C1,0,0,0),   P0[14],P0[15],P1[0],P1[1],   pw1[2]=PKW(P0,12),pw1[3]=PKW(P0,14), pw1); \
    VRD(2); SBAR(); GAPA(C0=__builtin_amdgcn_mfma_f32_32x32x16_bf16(kf[4],qr[2],C0,0,0,0),   P1[2],P1[3],P1[4],P1[5],     pw2[0]=PKW(P1,0), pw2[1]=PKW(P1,2), pw2); \
    VRD(6); SBAR(); GAPA(C1=__builtin_amdgcn_mfma_f32_32x32x16_bf16(kf[5],qr[2],C1,0,0,0),   P1[6],P1[7],P1[8],P1[9],     pw2[2]=PKW(P1,4), pw2[3]=PKW(P1,6), pw2); \
    VRD(3); SBAR(); GAPA(C0=__builtin_amdgcn_mfma_f32_32x32x16_bf16(kf[6],qr[3],C0,0,0,0),   P1[10],P1[11],P1[12],P1[13], pw3[0]=PKW(P1,8), pw3[1]=PKW(P1,10), pw3); \
    VRD(7); SBAR(); GAPA(C1=__builtin_amdgcn_mfma_f32_32x32x16_bf16(kf[7],qr[3],C1,0,0,0),   P1[14],P1[15],0.f,0.f,       pw3[2]=PKW(P1,12),pw3[3]=PKW(P1,14), pw3); \
    l_reg+=sacc; \
    if(GK){DMA_K((t)+3,sl_cur);} if(GV){DMA_V((t)+1,sl_next);} \
    CMASK(C0,C1,t); \
    { float a=MX3(C0[0],C0[1],C1[0]),b=MX3(C0[2],C0[3],C1[1]); a=MX3(a,C1[2],C1[3]); \
      _Pragma("unroll") for(int r=4;r<16;r+=4){a=MX3(a,C0[r],C0[r+1]);b=MX3(b,C0[r+2],C0[r+3]);a=MX3(a,C1[r],C1[r+1]);b=MX3(b,C1[r+2],C1[r+3]);} \
      float rm=__builtin_fmaxf(a,b); { auto rr=__builtin_amdgcn_permlane32_swap(__float_as_uint(rm),__float_as_uint(rm),false,false); rm=__builtin_fmaxf(__uint_as_float(rr[0]),__uint_as_float(rr[1])); } \
      resc=false; \
      if(__builtin_expect(__any(rm>(float)THRL),0)){ const float dl=__builtin_fmaxf(rm,0.f); mhat+=dl; \
        _Pragma("unroll") for(int r=0;r<16;++r){C0[r]-=dl;C1[r]-=dl;} \
        _Pragma("unroll") for(int r=0;r<16;++r)negm[r]=-mhat; asm volatile("":"+v"(negm)); \
        const float f=__builtin_amdgcn_exp2f(-dl); l_reg*=f; if(hi==0)wsf[r32]=f; resc=true; } } \
    SBAR(); \
    GAPB(o[0]=__builtin_amdgcn_mfma_f32_32x32x16_bf16(PAF(0),VFR(0),o[0],0,0,0), C0,0); \
    GAPB(o[1]=__builtin_amdgcn_mfma_f32_32x32x16_bf16(PAF(0),VFR(4),o[1],0,0,0), C0,4); \
    KRD(GL,0); GAPB(o[0]=__builtin_amdgcn_mfma_f32_32x32x16_bf16(PAF(1),VFR(1),o[0],0,0,0), C0,8); \
    KRD(GL,1); GAPB(o[1]=__builtin_amdgcn_mfma_f32_32x32x16_bf16(PAF(1),VFR(5),o[1],0,0,0), C0,12); \
    KRD(GL,2); GAPB(o[0]=__builtin_amdgcn_mfma_f32_32x32x16_bf16(PAF(2),VFR(2),o[0],0,0,0), C1,0); \
    KRD(GL,3); GAPB(o[1]=__builtin_amdgcn_mfma_f32_32x32x16_bf16(PAF(2),VFR(6),o[1],0,0,0), C1,4); \
    GAPB(o[0]=__builtin_amdgcn_mfma_f32_32x32x16_bf16(PAF(3),VFR(3),o[0],0,0,0), C1,8); \
    GAPB(o[1]=__builtin_amdgcn_mfma_f32_32x32x16_bf16(PAF(3),VFR(7),o[1],0,0,0), C1,12); \
    }while(0)
  int t=1;
  #undef CMASK
  #define CMASK(P0,P1,t) do{}while(0)
  for(;t+5<NT;t+=2){
    STEP(pB0,pB1,pA0,pA1,t,true,true,true);     WAIT_BAR(2); RESC(); ROT();
    STEP(pA0,pA1,pB0,pB1,t+1,true,true,true);   WAIT_BAR(2); RESC(); ROT();
  }
  #undef CMASK
  #define CMASK(P0,P1,t) do{ if((t)>=NT-2) kmask(P0,P1,(t),hi);}while(0)
  #define ENDW(tt) do{ if((tt)+3<NT){WAIT_BAR(2);} else if((tt)+2<NT){WAIT_BAR(1);} else {WAIT_BAR(0);} }while(0)
  for(;t+1<NT;t+=2){
    STEP(pB0,pB1,pA0,pA1,t,(t+3<NT),(t+1<NT),(t+1<NT));       ENDW(t);   RESC(); ROT();
    STEP(pA0,pA1,pB0,pB1,t+1,(t+4<NT),(t+2<NT),(t+2<NT));     ENDW(t+1); RESC(); ROT();
  }
  STEP(pB0,pB1,pA0,pA1,NT-1,false,false,false); RESC();
  { float sacc=pB0[0]+pB0[1]; _Pragma("unroll") for(int r=2;r<16;++r)sacc+=pB0[r]; _Pragma("unroll") for(int r=0;r<16;++r)sacc+=pB1[r]; l_reg+=sacc;
    pw0=(u32x4){PKW(pB0,0),PKW(pB0,2),PKW(pB0,4),PKW(pB0,6)};pw1=(u32x4){PKW(pB0,8),PKW(pB0,10),PKW(pB0,12),PKW(pB0,14)};pw2=(u32x4){PKW(pB1,0),PKW(pB1,2),PKW(pB1,4),PKW(pB1,6)};pw3=(u32x4){PKW(pB1,8),PKW(pB1,10),PKW(pB1,12),PKW(pB1,14)};
    SBAR(); pv(o,vb0+sl_cur,PAF(0),PAF(1),PAF(2),PAF(3)); }
  #undef PKW
  #undef PAF
  #undef VFR
  #undef PIN
  #undef MX3
  #undef GAPA
  #undef GAPB
  #undef EX
  #undef VRD
  #undef KRD
  #undef STEP
  #undef ENDW
  {auto rr=__builtin_amdgcn_permlane32_swap(__float_as_uint(l_reg),__float_as_uint(l_reg),false,false);l_reg=__uint_as_float(rr[0])+__uint_as_float(rr[1]);}
  if(hi==0)wsf[32+r32]=l_reg;asm volatile("s_waitcnt lgkmcnt(0)":::"memory");
  float rli[16];
  #pragma unroll
  for(int r=0;r<16;++r)rli[r]=__builtin_amdgcn_rcpf(wsf[32+crow(r,hi)]);
  bf16*Ow=Ou+(long)(wid*QBLK)*OP;
  { bf16*stg=(bf16*)(shm+LDS_OST)+wid*2048;
    #pragma unroll
    for(int r=0;r<16;++r){const int orow=crow(r,hi);
      #pragma unroll
      for(int d0=0;d0<2;++d0)stg[orow*64+d0*32+r32]=__float2bfloat16(o[d0][r]*rli[r]);}
    asm volatile("s_waitcnt lgkmcnt(0)":::"memory");
    #pragma unroll
    for(int i=0;i<4;++i){const int row=i*8+(lane>>3),ch=lane&7; const u32x4 v=*(const u32x4*)(stg+row*64+ch*8); ATTN_STORE16(Ow+(long)row*OP+ch*8,v);} }
  asm volatile("s_waitcnt lgkmcnt(0)\n\ts_barrier":::"memory");
  #undef DMA_K
  #undef DMA_V
  #undef CMASK
  #undef START
  #undef RESC
  #undef ROT
}
constexpr int ATTN_LDS_BYTES=LDS_BYTES;
#undef SBAR
#undef WAIT_BAR
}
#include <hip/hip_cooperative_groups.h>
namespace cg = cooperative_groups;
#define GAS __attribute__((address_space(1)))
#define LAS __attribute__((address_space(3)))
typedef unsigned short bf16;
typedef unsigned v4u __attribute__((ext_vector_type(4)));
typedef unsigned v2u __attribute__((ext_vector_type(2)));
typedef float f32x4 __attribute__((ext_vector_type(4)));
typedef short bf16x8 __attribute__((ext_vector_type(8)));

#ifndef ONE_LAUNCH
#define ONE_LAUNCH 1
#endif
constexpr int NWAVES = 8, NTHR = 512, NPHASE = 8;
constexpr int NB = 8, SEQ = 8192, NMETA = 16, LT = 8208, DM = 1024, MTOK = NB * LT, MP = 65792, MR = NB * SEQ, NIN = 3072, FF = 4096;
constexpr int LKP = 8320, NCH = 129, DNR = 8256;
constexpr float EPS = 1e-6f;
constexpr size_t MiB = 1u << 20;
constexpr size_t WS_CTL = 0, CTL_ZERO_BYTES = 1 * MiB;
constexpr size_t WS_WIN = 2 * MiB, WS_WOUT = 8 * MiB, WS_WUP = 10 * MiB, WS_WDN = 18 * MiB;
constexpr size_t WS_XN = 32 * MiB;
constexpr size_t WS_QN = WS_XN, WS_KN = WS_XN + (size_t)NB * DNR * 512 * 2;
constexpr size_t WS_DQKV = 162 * MiB;
constexpr size_t WS_CAT = WS_DQKV, WS_OF = WS_DQKV + 128 * MiB;
constexpr size_t WS_DZ = 355 * MiB;
constexpr size_t WS_AQKV = 420 * MiB;
constexpr size_t WS_OB = WS_AQKV;
constexpr size_t WS_BA = 517 * MiB;
constexpr size_t WS_Q = 522 * MiB;
constexpr size_t WS_KB = 586 * MiB, WS_VB = 603 * MiB;
constexpr size_t WS_CH = 620 * MiB;
constexpr size_t CH_BYTES = 41728, CH_W = 16384, CH_QK = 32768, CH_G = 40960;
constexpr size_t WS_MIX = 32 * MiB;
constexpr size_t WS_HID = 484 * MiB;
constexpr size_t WS_END = 996 * MiB;
static_assert(WS_KN + (size_t)NB * DNR * 512 * 2 <= WS_DQKV && WS_DQKV + (size_t)MP * 1536 * 2 <= WS_DZ && WS_DZ + (size_t)MP * 512 * 2 <= WS_AQKV && WS_AQKV + (size_t)MP * 768 * 2 <= WS_BA, "ws map 1");
static_assert(WS_BA + (size_t)MP * 16 * 4 <= WS_Q && WS_Q + (size_t)MR * 512 * 2 <= WS_KB && WS_KB + (size_t)NB * 2 * LKP * 64 * 2 <= WS_VB && WS_VB + (size_t)NB * 2 * LKP * 64 * 2 <= WS_CH, "ws map 2");
static_assert(WS_CH + CH_BYTES * (size_t)(NB * 2 * NCH * 4) <= WS_END && WS_OF + (size_t)MR * 512 * 2 <= WS_DZ && WS_OB + (size_t)MR * 512 * 2 <= WS_HID && WS_HID + (size_t)MR * FF * 2 <= WS_END && WS_MIX + (size_t)MR * DM * 2 <= WS_DQKV, "ws map 3");
constexpr int LDS_BYTES = 155648 + 256;
constexpr int XBST_OFF = 155648;
constexpr int QSLOT_OFF = 90112;
constexpr int P2_KN = 0, P2_QN = 17408, P2_VV = 34816, P2_RB = 52224, P2_KK = P2_RB, P2_QK = P2_RB + 16640, P2_AS = P2_RB + 33280, P2_CW = 118272, P2_SC = 125952;
constexpr int SC_ST = 0, SC_VT = 34816, SC_W = 53248, SC_Q = 70656, SC_KT = 88064, SC_QK = 106496, SC_U = 115712, SC_O = 134144;

typedef float f32x2_c __attribute__((ext_vector_type(2))); typedef __bf16 bf16x2_c __attribute__((ext_vector_type(2)));
__device__ __forceinline__ unsigned pk2(float lo, float hi) { const f32x2_c v = {lo, hi}; return __builtin_bit_cast(unsigned, __builtin_convertvector(v, bf16x2_c)); }
__device__ __forceinline__ unsigned f2bf(float f) { return pk2(f, 0.f) & 0xffffu; }
__device__ __forceinline__ float bf2f(unsigned short u) { return __builtin_bit_cast(float, (unsigned)u << 16); }
__device__ __forceinline__ void unpack8(const v4u v, float* o) {
#pragma unroll
    for (int i = 0; i < 4; ++i) { o[2 * i] = __builtin_bit_cast(float, v[i] << 16); o[2 * i + 1] = __builtin_bit_cast(float, v[i] & 0xffff0000u); }
}
__device__ __forceinline__ v4u pack8(const float* o) { v4u v; v.x = pk2(o[0], o[1]); v.y = pk2(o[2], o[3]); v.z = pk2(o[4], o[5]); v.w = pk2(o[6], o[7]); return v; }
__device__ __forceinline__ unsigned xcc_id() { return (unsigned)__builtin_amdgcn_s_getreg((3 << 11) | 20) & 0xFu; }
__device__ __forceinline__ float wave_sum(float v) {
#pragma unroll
    for (int o = 1; o < 64; o <<= 1) v += __shfl_xor(v, o);
    return v;
}
__device__ __forceinline__ float bperm_f(int srclane, float v) { return __builtin_bit_cast(float, __builtin_amdgcn_ds_bpermute(srclane << 2, __builtin_bit_cast(int, v))); }
__device__ __forceinline__ float silu_f(float y) { return y * __builtin_amdgcn_rcpf(1.f + __expf(-y)); }

struct Args { const float* in[16]; float* out; unsigned char* ws; int ph_lo, ph_hi; };

template <int MODE> __device__ __forceinline__ void p0_transpose_item(const float* W, int K, int Nsrc, int Ndst, bf16* WT, LAS float* scr, int item, int lane) {
    const int nblk = Ndst / 32, kb = item / nblk, nb = item % nblk, k0 = 64 * kb, n0 = 32 * nb;
    const int c4 = (lane & 7) * 4, nd = n0 + c4;
    const int src = MODE == 0 ? nd : (nd < 2048 ? nd : (nd < 2816 ? nd + 16 : (nd < 2832 ? nd - 2816 + 2048 : -1)));
    const int srcc = src >= 0 ? src : 0;
#pragma unroll
    for (int i = 0; i < 8; ++i) { const int kk = 8 * i + (lane >> 3); f32x4 v = *(const f32x4*)(W + (size_t)(k0 + kk) * Nsrc + srcc); if (src < 0) v = (f32x4){0.f, 0.f, 0.f, 0.f};
        LAS float* d = scr + kk * 33 + c4; d[0] = v[0]; d[1] = v[1]; d[2] = v[2]; d[3] = v[3]; }
    asm volatile("s_waitcnt lgkmcnt(0)" ::: "memory");
    const int c = lane & 7;
#pragma unroll
    for (int j = 0; j < 4; ++j) { const int n = (lane >> 3) + 8 * j; const LAS float* s = scr + (8 * c) * 33 + n;
        v4u o; o.x = pk2(s[0 * 33], s[1 * 33]); o.y = pk2(s[2 * 33], s[3 * 33]); o.z = pk2(s[4 * 33], s[5 * 33]); o.w = pk2(s[6 * 33], s[7 * 33]);
        *(v4u*)(WT + (size_t)(n0 + n) * K + k0 + 8 * c) = o; }
    asm volatile("s_waitcnt lgkmcnt(0)" ::: "memory");
}
__device__ __forceinline__ void rms_row_to_bf16(const float* xrow, const float* w, bf16* orow, int lane) {
    const f32x4* xr = (const f32x4*)xrow + lane; const f32x4* wr = (const f32x4*)w + lane;
    f32x4 v[4]; float s = 0.f;
#pragma unroll
    for (int j = 0; j < 4; ++j) { v[j] = xr[64 * j]; s += (v[j].x * v[j].x + v[j].y * v[j].y) + (v[j].z * v[j].z + v[j].w * v[j].w); }
    const float rs = __builtin_amdgcn_rsqf(wave_sum(s) * (1.f / DM) + EPS);
    v2u* o8 = (v2u*)orow + lane;
#pragma unroll
    for (int j = 0; j < 4; ++j) { const f32x4 ww = wr[64 * j]; v2u o; o.x = pk2(v[j].x * rs * ww.x, v[j].y * rs * ww.y); o.y = pk2(v[j].z * rs * ww.z, v[j].w * rs * ww.w); o8[64 * j] = o; }
}
constexpr int ROPE_OFF = 131072;
__device__ __forceinline__ void attn_prep_row(const v4u qd, const v4u kd, const LAS float* rope, const float* qw, const float* kw, bf16* Q, bf16* KB, bf16* VB, int b, int t, int lane) {
    if (t >= LT) {
        if (lane < 32) { const int l = lane & 15, kvh = l >> 3, sub = l & 7; bf16* dst = (lane < 16 ? KB : VB) + ((size_t)(b * 2 + kvh) * LKP + t) * 64 + sub * 8; *(v4u*)dst = (v4u){0u, 0u, 0u, 0u}; }
        return;
    }
    const bool real = t >= NMETA; const int s = real ? t - NMETA : 0;
    const int sub = lane & 7, axis = sub >> 2, half = (sub >> 1) & 1, f0 = (sub & 1) * 8;
    const int pos = axis == 0 ? (s >> 6) : (s & 63);
    float cs[8], sn[8];
    { const f32x4 c0 = *(const LAS f32x4*)(rope + pos * 16 + f0), c1 = *(const LAS f32x4*)(rope + pos * 16 + f0 + 4), s0 = *(const LAS f32x4*)(rope + 2048 + pos * 16 + f0), s1 = *(const LAS f32x4*)(rope + 2048 + pos * 16 + f0 + 4);
#pragma unroll
      for (int e = 0; e < 4; ++e) { cs[e] = real ? c0[e] : 1.f; cs[4 + e] = real ? c1[e] : 1.f; sn[e] = real ? s0[e] : 0.f; sn[4 + e] = real ? s1[e] : 0.f; } }
    { float q[8]; unpack8(qd, q); float ss = 0.f;
#pragma unroll
      for (int e = 0; e < 8; ++e) ss += q[e] * q[e];
      ss += __shfl_xor(ss, 1); ss += __shfl_xor(ss, 2); ss += __shfl_xor(ss, 4);
      const float rs = __builtin_amdgcn_rsqf(ss * (1.f / 64.f) + EPS); float o[8];
#pragma unroll
      for (int e = 0; e < 8; ++e) q[e] = q[e] * rs * qw[sub * 8 + e];
#pragma unroll
      for (int e = 0; e < 8; ++e) { const float pr = __shfl_xor(q[e], 2); o[e] = (half == 0 ? q[e] * cs[e] - pr * sn[e] : q[e] * cs[e] + pr * sn[e]) * attn_body::C2; }
      if (real) *(v4u*)(Q + ((size_t)(b * SEQ + s)) * 512 + lane * 8) = pack8(o); }
    { const int l = lane & 15, kvh = l >> 3; float k[8]; unpack8(kd, k); float ss = 0.f;
#pragma unroll
      for (int e = 0; e < 8; ++e) ss += k[e] * k[e];
      ss += __shfl_xor(ss, 1); ss += __shfl_xor(ss, 2); ss += __shfl_xor(ss, 4);
      const float rs = __builtin_amdgcn_rsqf(ss * (1.f / 64.f) + EPS); float o[8];
#pragma unroll
      for (int e = 0; e < 8; ++e) k[e] = k[e] * rs * kw[sub * 8 + e];
#pragma unroll
      for (int e = 0; e < 8; ++e) { const float pr = __shfl_xor(k[e], 2); o[e] = half == 0 ? k[e] * cs[e] - pr * sn[e] : k[e] * cs[e] + pr * sn[e]; }
      if (lane < 16) *(v4u*)(KB + ((size_t)(b * 2 + kvh) * LKP + t) * 64 + sub * 8) = pack8(o);
      else if (lane < 32) *(v4u*)(VB + ((size_t)(b * 2 + kvh) * LKP + t) * 64 + sub * 8) = kd; }
}

#define DN_ISSUE(item_, rawv, cwv, pbb, paa, td, ln) do { \
    const int h_ = (item_) & 3, tc_ = ((item_) >> 2) % NCH, b_ = (item_) / (4 * NCH), t0_ = 64 * tc_ - 48; \
    pbb = 0.f; paa = 0.f; \
    if (wave < 2) { const int dir_ = wave; const bool rev_ = dir_ && tc_ > 0; const int j_ = rev_ ? 63 - (ln) : (ln), t_ = t0_ + j_, tq_ = t_ < 0 ? 0 : t_; \
        const float* ba_ = BA + (size_t)(b_ * LT + tq_) * 16; const float vb_ = ba_[dir_ * 4 + h_], va_ = ba_[8 + dir_ * 4 + h_]; pbb = t_ >= 0 ? vb_ : 0.f; paa = t_ >= 0 ? va_ : 0.f; } \
      \
    _Pragma("unroll") for (int e_ = 0; e_ < 4; ++e_) { const int i_ = (td) + NTHR * e_, ic_ = i_ < 5 * 384 ? i_ : 5 * 384 - 1; const int w_ = ic_ / 384, c_ = ic_ % 384, sec_ = c_ >> 7; cwv[e_] = conv_w[w_ * 1536 + sec_ * 512 + h_ * 128 + (c_ & 127)]; } \
    _Pragma("unroll") for (int e_ = 0; e_ < 7; ++e_) { const int i_ = (td) + NTHR * e_, ic_ = i_ < 68 * 48 ? i_ : 68 * 48 - 1, rr_ = ic_ / 48, ck_ = ic_ % 48, sec_ = ck_ >> 4, t_ = t0_ - 2 + rr_; \
        const int tq_ = t_ < 0 ? 0 : (t_ >= LT ? LT - 1 : t_); const v4u v_ = *(const v4u*)(DQKV + (size_t)(b_ * LT + tq_) * 1536 + sec_ * 512 + h_ * 128 + (ck_ & 15) * 8); \
        const bool ok_ = (t_ == tq_); rawv[e_].x = ok_ ? v_.x : 0u; rawv[e_].y = ok_ ? v_.y : 0u; rawv[e_].z = ok_ ? v_.z : 0u; rawv[e_].w = ok_ ? v_.w : 0u; } } while (0)
__device__ __forceinline__ void dn_prep_item(const Args& A, LAS unsigned char* lds, int item, int next_item, v4u (&rawv)[7], float (&cwv)[4], float& pbb, float& paa, int tid, int wave, int lane) {
    unsigned char* ws = A.ws;
    int ln = lane, td = tid; asm volatile("" : "+v"(ln), "+v"(td));
    const bf16* DQKV = (const bf16*)(ws + WS_DQKV); const float* BA = (const float*)(ws + WS_BA);
    bf16* QN = (bf16*)(ws + WS_QN); bf16* KN = (bf16*)(ws + WS_KN);
    const float* conv_w = A.in[3]; const float* a_log = A.in[4]; const float* dt_bias = A.in[5];
    const int h = item & 3, tc = (item >> 2) % NCH, b = item / (4 * NCH);
    const int t0 = 64 * tc - 48;
    LAS bf16* KNs = (LAS bf16*)(lds + P2_KN); LAS bf16* QNs = (LAS bf16*)(lds + P2_QN); LAS bf16* VVs = (LAS bf16*)(lds + P2_VV);
    LAS bf16* raw = (LAS bf16*)(lds + P2_RB); LAS float* cw = (LAS float*)(lds + P2_CW);
    LAS float* KKs = (LAS float*)(lds + P2_KK); LAS float* QKs = (LAS float*)(lds + P2_QK);
    LAS float* gcS = (LAS float*)(lds + P2_SC); LAS float* betaS = gcS + 128; LAS float* egS = gcS + 256;
    DN_ISSUE(item, rawv, cwv, pbb, paa, td, ln);
    const float cbb = pbb, caa = paa;
#pragma unroll
    for (int e = 0; e < 4; ++e) { const int i = td + NTHR * e; if (i < 5 * 384) cw[i] = cwv[e]; }
#pragma unroll
    for (int e = 0; e < 7; ++e) { const int i = td + NTHR * e, rr = i / 48, ck = i % 48; if (i < 68 * 48) *(LAS v4u*)(raw + rr * 392 + ck * 8) = rawv[e]; }
    __syncthreads();
#pragma unroll 1
    for (int e = 0; e < 3; ++e) { const int idx = td + NTHR * e, jp = idx / 48, ck = idx - 48 * jp, sec = ck >> 4, c16 = ck & 15, j0 = 2 * jp;
        f32x4 cv[5][2];
#pragma unroll
        for (int w = 0; w < 5; ++w) { cv[w][0] = *(const LAS f32x4*)(cw + w * 384 + ck * 8); cv[w][1] = *(const LAS f32x4*)(cw + w * 384 + ck * 8 + 4); }
        float y[2][8];
#pragma unroll
        for (int k = 0; k < 8; ++k) { y[0][k] = 0.f; y[1][k] = 0.f; }
#pragma unroll
        for (int r = 0; r < 6; ++r) { float x[8]; unpack8(*(const LAS v4u*)(raw + (j0 + r) * 392 + ck * 8), x);
            if (r <= 4) {
#pragma unroll
                for (int k = 0; k < 4; ++k) { y[0][k] += x[k] * cv[r][0][k]; y[0][4 + k] += x[4 + k] * cv[r][1][k]; } }
            if (r >= 1) {
#pragma unroll
                for (int k = 0; k < 4; ++k) { y[1][k] += x[k] * cv[r - 1][0][k]; y[1][4 + k] += x[4 + k] * cv[r - 1][1][k]; } } }
#pragma unroll
        for (int u = 0; u < 2; ++u) { const int j = j0 + u;
            const float vm = (t0 + j) >= 0 ? 1.f : 0.f; float ss = 0.f;
#pragma unroll
            for (int k = 0; k < 8; ++k) { y[u][k] = y[u][k] * __builtin_amdgcn_rcpf(1.f + __expf(-y[u][k])) * vm; ss += y[u][k] * y[u][k]; }
            ss += bperm_f(ln ^ 1, ss); ss += bperm_f(ln ^ 2, ss); ss += bperm_f(ln ^ 4, ss); ss += bperm_f(ln ^ 8, ss);
            const float rq = __builtin_amdgcn_rsqf(ss + EPS); const float sc = sec == 2 ? 1.f : (sec == 0 ? 0.08838834764831845f * rq : rq);
#pragma unroll
            for (int k = 0; k < 8; ++k) y[u][k] *= sc;
            const v4u o = pack8(y[u]);
            LAS bf16* dl = (sec == 0 ? QNs : (sec == 1 ? KNs : VVs)) + j * 136 + c16 * 8; *(LAS v4u*)dl = o;
            if (sec < 2) *(v4u*)((sec == 0 ? QN : KN) + ((size_t)b * DNR + 64 * tc + j) * 512 + h * 128 + c16 * 8) = o; } }
    __syncthreads();
    { const int fr = ln & 15, fq = ln >> 4;
#pragma unroll
      for (int q = 0; q < 4; ++q) { const int idx = wave * 4 + q, which = idx >> 4, ti = (idx & 15) >> 2, tj = idx & 3;
          const LAS bf16* Ap = (which ? QNs : KNs) + (ti * 16 + fr) * 136 + fq * 8; const LAS bf16* Bp = KNs + (tj * 16 + fr) * 136 + fq * 8;
          f32x4 acc = (f32x4){0.f, 0.f, 0.f, 0.f};
#pragma unroll
          for (int ks = 0; ks < 4; ++ks) acc = __builtin_amdgcn_mfma_f32_16x16x32_bf16(*(const LAS bf16x8*)(Ap + ks * 32), *(const LAS bf16x8*)(Bp + ks * 32), acc, 0, 0, 0);
          LAS float* dst = which ? QKs : KKs;
#pragma unroll
          for (int r = 0; r < 4; ++r) dst[(ti * 16 + 4 * fq + r) * 65 + tj * 16 + fr] = acc[r]; } }
    if (wave < 2) { const int dir = wave, i = ln; const bool rev = dir && tc > 0; const int j = rev ? 63 - i : i, t = t0 + j;
        float beta = 0.f, g = 0.f;
        if (t >= 0) { const float bb = cbb, aa = caa;
            beta = 1.f / (1.f + expf(-bb)); const float x = aa + dt_bias[dir * 4 + h]; const float sp = x > 20.f ? x : log1pf(expf(x)); g = -expf(a_log[dir * 4 + h]) * sp; }
        float gc = g;
#pragma unroll
        for (int o = 1; o < 64; o <<= 1) { const float v = bperm_f(ln - o, gc); if (ln >= o) gc += v; }
        const float gl = bperm_f(63, gc);
        const float eg_ = __expf(gc);
        gcS[dir * 64 + i] = gc; betaS[dir * 64 + i] = beta; egS[dir * 64 + i] = eg_ * beta;
        float* G = (float*)(ws + WS_CH + CH_BYTES * (size_t)((((b * 2 + dir) * NCH + tc) * 4) + h) + CH_G);
        G[j] = eg_; G[64 + j] = __expf(gl - gc); if (i == 0) G[128] = __expf(gl); }
    __syncthreads();
    const int dir = td >> 8; const bool rev = dir && tc > 0;
    unsigned char* chunk = ws + WS_CH + CH_BYTES * (size_t)((((b * 2 + dir) * NCH + tc) * 4) + h);
    LAS float* As = (LAS float*)(lds + P2_AS) + dir * 4096;
    { LAS bf16* QKo = (LAS bf16*)(lds + P2_QN) + dir * 4096;
      const int ip = td & 63, i0_ = (td & 255) >> 6, jp = rev ? 63 - ip : ip;
      const float gp = gcS[dir * 64 + ip];
      float kkv[16], qkv[16], giv[16], biv[16];
#pragma unroll
      for (int e = 0; e < 16; ++e) { const int i = i0_ + 4 * e, j = rev ? 63 - i : i;
          kkv[e] = KKs[j * 65 + jp]; qkv[e] = QKs[j * 65 + jp]; giv[e] = gcS[dir * 64 + i]; biv[e] = betaS[dir * 64 + i]; }
#pragma unroll
      for (int e = 0; e < 16; ++e) { const int i = i0_ + 4 * e, j = rev ? 63 - i : i;
          const float dec = __expf(fminf(giv[e] - gp, 0.f));
          As[i * 64 + ip] = ip < i ? kkv[e] * dec * biv[e] : 0.f;
          QKo[j * 64 + jp] = (bf16)f2bf(ip <= i ? qkv[e] * dec : 0.f); } }
    __syncthreads();
    { unsigned char* cb = ws + WS_CH + CH_BYTES * (size_t)((((b * 2) * NCH + tc) * 4) + h);
#pragma unroll
      for (int e = 0; e < 2; ++e) { const int id = td + NTHR * e, d_ = id >> 9, rest = id & 511, row = rest >> 3, c8 = rest & 7;
          *(v4u*)(cb + (size_t)d_ * (CH_BYTES * NCH * 4) + CH_QK + row * 128 + c8 * 16) = *(const LAS v4u*)(lds + P2_QN + d_ * 8192 + row * 128 + c8 * 16); } }
    { typedef float f32x2 __attribute__((ext_vector_type(2)));
      const int col = td & 255; const bool isU = col < 128; const LAS bf16* src = isU ? VVs + col : KNs + (col - 128);
      const int jb = rev ? 63 : 0, js = rev ? -1 : 1;
      f32x2 x2[32];
      { const LAS bf16* sp = src + jb * 136; const int sstep = js * 136; const LAS float* scp = (isU ? betaS : egS) + dir * 64; asm volatile("" : "+v"(scp));
#pragma unroll
      for (int i = 0; i < 64; ++i) { x2[i >> 1][i & 1] = bf2f(*sp) * scp[i]; sp += sstep; asm volatile("" : "+v"(sp)); if ((i & 7) == 7) { asm volatile("" : "+v"(x2[i >> 1]) :: "memory"); __builtin_amdgcn_sched_barrier(0); } } }
      __syncthreads();
#pragma unroll
      for (int i = 1; i < 64; ++i) {
          f32x2 a01 = (f32x2){0.f, 0.f}, a23 = (f32x2){0.f, 0.f};
#pragma unroll
          for (int q = 0; 4 * q < i; ++q) { const f32x4 a = *(const LAS f32x4*)(As + i * 64 + 4 * q);
              a01 += (f32x2){a[0], a[1]} * x2[2 * q]; a23 += (f32x2){a[2], a[3]} * x2[2 * q + 1]; }
          const f32x2 t = a01 + a23; x2[i >> 1][i & 1] -= (t.x + t.y); asm volatile("" : "+v"(x2[i >> 1])); }
      { LAS bf16* xp = (LAS bf16*)lds + dir * 16384 + jb * 256 + col; const int xstep = js * 256;
#pragma unroll
      for (int i = 0; i < 64; ++i) { *xp = (bf16)f2bf(x2[i >> 1][i & 1]); xp += xstep; asm volatile("" : "+v"(xp)); } } }
    __syncthreads();
    { unsigned char* cb = ws + WS_CH + CH_BYTES * (size_t)((((b * 2) * NCH + tc) * 4) + h); int tl = td; asm volatile("" : "+v"(tl));
#pragma unroll
      for (int e = 0; e < 8; ++e) { const int id = tl + NTHR * e, d_ = id >> 11, rest = id & 2047, row = rest >> 5, c = rest & 31;
          *(v4u*)(cb + (size_t)d_ * (CH_BYTES * NCH * 4) + (c < 16 ? 0 : CH_W) + row * 256 + (c & 15) * 16) = *(const LAS v4u*)(lds + d_ * 32768 + row * 512 + c * 16); } }
    __syncthreads();
}

__device__ __forceinline__ void dn_scan(const Args& A, LAS unsigned char* lds, int chain, int tid, int wave, int lane) {
    unsigned char* ws = A.ws;
    const int b = chain >> 3, dir = (chain >> 2) & 1, h = chain & 3;
    const bf16* QN = (const bf16*)(ws + WS_QN); const bf16* KN = (const bf16*)(ws + WS_KN);
    bf16* Od = (bf16*)(ws + (dir ? WS_OB : WS_OF));
    LAS bf16* St = (LAS bf16*)(lds + SC_ST); LAS bf16* VT = (LAS bf16*)(lds + SC_VT); LAS bf16* Ws = (LAS bf16*)(lds + SC_W); LAS bf16* Qs = (LAS bf16*)(lds + SC_Q);
    LAS bf16* KT = (LAS bf16*)(lds + SC_KT); LAS bf16* QKs = (LAS bf16*)(lds + SC_QK); LAS bf16* Us = (LAS bf16*)(lds + SC_U); LAS bf16* Os = (LAS bf16*)(lds + SC_O);
    const int fr = lane & 15, fq = lane >> 4, vrow = 16 * wave + fr;
    f32x4 S[8];
#pragma unroll
    for (int m = 0; m < 8; ++m) S[m] = (f32x4){0.f, 0.f, 0.f, 0.f};
#pragma unroll
    for (int q = 0; q < 4; ++q) *(LAS v4u*)(St + vrow * 136 + fq * 32 + q * 8) = (v4u){0u, 0u, 0u, 0u};
    v4u rU0[2], rW0[2], rQ0[2], rK0[2], rQK0; float g10[2], g20[2], glp0;
    v4u rU1[2], rW1[2], rQ1[2], rK1[2], rQK1; float g11[2], g21[2], glp1;
#define SC_PREFETCH(s_, X) do { const int tc_ = (dir == 0 || (s_) == 0) ? (s_) : NCH - (s_); \
        const unsigned char* ck_ = ws + WS_CH + CH_BYTES * (size_t)((((b * 2 + dir) * NCH + tc_) * 4) + h); const float* G_ = (const float*)(ck_ + CH_G); \
        _Pragma("unroll") for (int i_ = 0; i_ < 2; ++i_) { const int id_ = tid + NTHR * i_, row_ = id_ >> 4, c16_ = id_ & 15; \
            rU##X[i_] = *(const v4u*)(ck_ + row_ * 256 + c16_ * 16); rW##X[i_] = *(const v4u*)(ck_ + CH_W + row_ * 256 + c16_ * 16); \
            const size_t qo_ = ((size_t)b * DNR + 64 * tc_ + row_) * 512 + h * 128 + c16_ * 8; rQ##X[i_] = *(const v4u*)(QN + qo_); rK##X[i_] = *(const v4u*)(KN + qo_); \
            g1##X[i_] = G_[row_]; g2##X[i_] = G_[64 + row_]; } \
        rQK##X = *(const v4u*)(ck_ + CH_QK + tid * 16); glp##X = G_[128]; } while (0)
    SC_PREFETCH(0, 0); SC_PREFETCH(1, 1);
#pragma unroll 1
    for (int s2 = 0; s2 < NCH; s2 += 2) {
      { const int s = s2;
        const int tc = (dir == 0 || s == 0) ? s : NCH - s;
        __syncthreads();
        const float gl = glp0;
        if (s > 0) { const int tcp = (dir == 0 || s == 1) ? s - 1 : NCH - (s - 1);
            if (tcp >= 1) {
#pragma unroll
                for (int i = 0; i < 2; ++i) { const int id = tid + NTHR * i, row = id >> 4, c16 = id & 15;
                    *(v4u*)(Od + ((size_t)b * SEQ + 64 * (tcp - 1) + row) * 512 + h * 128 + c16 * 8) = *(const LAS v4u*)(Os + row * 136 + c16 * 8); } } }
#pragma unroll
        for (int i = 0; i < 2; ++i) { const int id = tid + NTHR * i, row = id >> 4, c16 = id & 15;
            *(LAS v4u*)(Us + row * 136 + c16 * 8) = rU0[i]; *(LAS v4u*)(Ws + row * 136 + c16 * 8) = rW0[i];
            float q[8]; unpack8(rQ0[i], q);
#pragma unroll
            for (int e = 0; e < 8; ++e) q[e] *= g10[i];
            *(LAS v4u*)(Qs + row * 136 + c16 * 8) = pack8(q);
            float k[8]; unpack8(rK0[i], k);
#pragma unroll
            for (int e = 0; e < 8; ++e) KT[(c16 * 8 + e) * 72 + ((((row >> 3) ^ (c16 & 7)) << 3) | (row & 7))] = (bf16)f2bf(k[e] * g20[i]); }
        *(LAS v4u*)(QKs + (tid >> 3) * 72 + (tid & 7) * 8) = rQK0;
        __syncthreads();
        { const int sn_ = s + 2 < NCH ? s + 2 : NCH - 1; SC_PREFETCH(sn_, 0); }
        bf16x8 bS[4];
#pragma unroll
        for (int ks = 0; ks < 4; ++ks) bS[ks] = *(const LAS bf16x8*)(St + vrow * 136 + ks * 32 + fq * 8);
#pragma unroll
        for (int mt = 0; mt < 4; ++mt) { f32x4 acc = (f32x4){0.f, 0.f, 0.f, 0.f};
#pragma unroll
            for (int ks = 0; ks < 4; ++ks) acc = __builtin_amdgcn_mfma_f32_16x16x32_bf16(*(const LAS bf16x8*)(Ws + (16 * mt + fr) * 136 + ks * 32 + fq * 8), bS[ks], acc, 0, 0, 0);
            float vn[4];
#pragma unroll
            for (int r = 0; r < 4; ++r) vn[r] = bf2f(Us[(16 * mt + 4 * fq + r) * 136 + vrow]) - acc[r];
            v2u o; o.x = pk2(vn[0], vn[1]); o.y = pk2(vn[2], vn[3]); *(LAS v2u*)(VT + vrow * 72 + 16 * mt + 4 * fq) = o; }
        asm volatile("s_waitcnt lgkmcnt(0)" ::: "memory");
        bf16x8 bV[2];
#pragma unroll
        for (int ks = 0; ks < 2; ++ks) bV[ks] = *(const LAS bf16x8*)(VT + vrow * 72 + ks * 32 + fq * 8);
#pragma unroll
        for (int mt = 0; mt < 4; ++mt) { f32x4 acc = (f32x4){0.f, 0.f, 0.f, 0.f};
#pragma unroll
            for (int ks = 0; ks < 4; ++ks) acc = __builtin_amdgcn_mfma_f32_16x16x32_bf16(*(const LAS bf16x8*)(Qs + (16 * mt + fr) * 136 + ks * 32 + fq * 8), bS[ks], acc, 0, 0, 0);
#pragma unroll
            for (int ks = 0; ks < 2; ++ks) acc = __builtin_amdgcn_mfma_f32_16x16x32_bf16(*(const LAS bf16x8*)(QKs + (16 * mt + fr) * 72 + ks * 32 + fq * 8), bV[ks], acc, 0, 0, 0);
            if (tc >= 1) {
#pragma unroll
                for (int r = 0; r < 4; ++r) Os[(16 * mt + 4 * fq + r) * 136 + vrow] = (bf16)f2bf(acc[r]); } }
#pragma unroll
        for (int mt = 0; mt < 8; ++mt) { f32x4 acc = S[mt] * gl;
#pragma unroll
            for (int ks = 0; ks < 2; ++ks) acc = __builtin_amdgcn_mfma_f32_16x16x32_bf16(*(const LAS bf16x8*)(KT + (16 * mt + fr) * 72 + (((4 * ks + fq) ^ ((2 * mt + (fr >> 3)) & 7)) << 3)), bV[ks], acc, 0, 0, 0);
            S[mt] = acc; v2u o; o.x = pk2(acc[0], acc[1]); o.y = pk2(acc[2], acc[3]); *(LAS v2u*)(St + vrow * 136 + 16 * mt + 4 * fq) = o; }
        asm volatile("s_waitcnt lgkmcnt(0)" ::: "memory");
      }
      if (s2 + 1 < NCH) { const int s = s2 + 1;
        const int tc = (dir == 0 || s == 0) ? s : NCH - s;
        __syncthreads();
        const float gl = glp1;
        if (s > 0) { const int tcp = (dir == 0 || s == 1) ? s - 1 : NCH - (s - 1);
            if (tcp >= 1) {
#pragma unroll
                for (int i = 0; i < 2; ++i) { const int id = tid + NTHR * i, row = id >> 4, c16 = id & 15;
                    *(v4u*)(Od + ((size_t)b * SEQ + 64 * (tcp - 1) + row) * 512 + h * 128 + c16 * 8) = *(const LAS v4u*)(Os + row * 136 + c16 * 8); } } }
#pragma unroll
        for (int i = 0; i < 2; ++i) { const int id = tid + NTHR * i, row = id >> 4, c16 = id & 15;
            *(LAS v4u*)(Us + row * 136 + c16 * 8) = rU1[i]; *(LAS v4u*)(Ws + row * 136 + c16 * 8) = rW1[i];
            float q[8]; unpack8(rQ1[i], q);
#pragma unroll
            for (int e = 0; e < 8; ++e) q[e] *= g11[i];
            *(LAS v4u*)(Qs + row * 136 + c16 * 8) = pack8(q);
            float k[8]; unpack8(rK1[i], k);
#pragma unroll
            for (int e = 0; e < 8; ++e) KT[(c16 * 8 + e) * 72 + ((((row >> 3) ^ (c16 & 7)) << 3) | (row & 7))] = (bf16)f2bf(k[e] * g21[i]); }
        *(LAS v4u*)(QKs + (tid >> 3) * 72 + (tid & 7) * 8) = rQK1;
        __syncthreads();
        { const int sn_ = s + 2 < NCH ? s + 2 : NCH - 1; SC_PREFETCH(sn_, 1); }
        bf16x8 bS[4];
#pragma unroll
        for (int ks = 0; ks < 4; ++ks) bS[ks] = *(const LAS bf16x8*)(St + vrow * 136 + ks * 32 + fq * 8);
#pragma unroll
        for (int mt = 0; mt < 4; ++mt) { f32x4 acc = (f32x4){0.f, 0.f, 0.f, 0.f};
#pragma unroll
            for (int ks = 0; ks < 4; ++ks) acc = __builtin_amdgcn_mfma_f32_16x16x32_bf16(*(const LAS bf16x8*)(Ws + (16 * mt + fr) * 136 + ks * 32 + fq * 8), bS[ks], acc, 0, 0, 0);
            float vn[4];
#pragma unroll
            for (int r = 0; r < 4; ++r) vn[r] = bf2f(Us[(16 * mt + 4 * fq + r) * 136 + vrow]) - acc[r];
            v2u o; o.x = pk2(vn[0], vn[1]); o.y = pk2(vn[2], vn[3]); *(LAS v2u*)(VT + vrow * 72 + 16 * mt + 4 * fq) = o; }
        asm volatile("s_waitcnt lgkmcnt(0)" ::: "memory");
        bf16x8 bV[2];
#pragma unroll
        for (int ks = 0; ks < 2; ++ks) bV[ks] = *(const LAS bf16x8*)(VT + vrow * 72 + ks * 32 + fq * 8);
#pragma unroll
        for (int mt = 0; mt < 4; ++mt) { f32x4 acc = (f32x4){0.f, 0.f, 0.f, 0.f};
#pragma unroll
            for (int ks = 0; ks < 4; ++ks) acc = __builtin_amdgcn_mfma_f32_16x16x32_bf16(*(const LAS bf16x8*)(Qs + (16 * mt + fr) * 136 + ks * 32 + fq * 8), bS[ks], acc, 0, 0, 0);
#pragma unroll
            for (int ks = 0; ks < 2; ++ks) acc = __builtin_amdgcn_mfma_f32_16x16x32_bf16(*(const LAS bf16x8*)(QKs + (16 * mt + fr) * 72 + ks * 32 + fq * 8), bV[ks], acc, 0, 0, 0);
            if (tc >= 1) {
#pragma unroll
                for (int r = 0; r < 4; ++r) Os[(16 * mt + 4 * fq + r) * 136 + vrow] = (bf16)f2bf(acc[r]); } }
#pragma unroll
        for (int mt = 0; mt < 8; ++mt) { f32x4 acc = S[mt] * gl;
#pragma unroll
            for (int ks = 0; ks < 2; ++ks) acc = __builtin_amdgcn_mfma_f32_16x16x32_bf16(*(const LAS bf16x8*)(KT + (16 * mt + fr) * 72 + (((4 * ks + fq) ^ ((2 * mt + (fr >> 3)) & 7)) << 3)), bV[ks], acc, 0, 0, 0);
            S[mt] = acc; v2u o; o.x = pk2(acc[0], acc[1]); o.y = pk2(acc[2], acc[3]); *(LAS v2u*)(St + vrow * 136 + 16 * mt + 4 * fq) = o; }
        asm volatile("s_waitcnt lgkmcnt(0)" ::: "memory");
      }
    }
#undef SC_PREFETCH
    __syncthreads();
    { const int tcp = (dir == 0) ? NCH - 1 : 1;
#pragma unroll
      for (int i = 0; i < 2; ++i) { const int id = tid + NTHR * i, row = id >> 4, c16 = id & 15;
          *(v4u*)(Od + ((size_t)b * SEQ + 64 * (tcp - 1) + row) * 512 + h * 128 + c16 * 8) = *(const LAS v4u*)(Os + row * 136 + c16 * 8); } }
    __syncthreads();
}
#define XB_TMO      128
#define XB_XCNT(j)  (256  + 64 * (j))
#define XB_XSUB(j)  (1280 + 64 * (j))
#define XB_XGEN(j)  (2304 + 64 * (j))
#define XB_TOP      3328
#define XB_TOPGEN   3392
#define XCD_BAR_WORDS 3456
#define XB_SPIN_CAP (1u << 18)

__device__ __forceinline__ unsigned xb_ld(unsigned* p)              { return __hip_atomic_load(p, __ATOMIC_RELAXED, __HIP_MEMORY_SCOPE_AGENT); }
__device__ __forceinline__ unsigned xb_add(unsigned* p, unsigned v) { return __hip_atomic_fetch_add(p, v, __ATOMIC_RELAXED, __HIP_MEMORY_SCOPE_AGENT); }
__device__ __forceinline__ unsigned xb_xcc_id() { return (unsigned)__builtin_amdgcn_s_getreg((3 << 11) | 20) & 0xFu; }
#define XB_SPIN(cond, bar) do { unsigned _sp = 0; while (cond) { __builtin_amdgcn_s_sleep(1); \
    if ((++_sp & 255u) == 0u) { if (xb_ld(&(bar)[XB_TMO])) break; if (_sp > XB_SPIN_CAP) { atomicAdd(&(bar)[XB_TMO], 1u); break; } } } } while (0)

struct XcdBarrier {
    unsigned* bar; unsigned x;
    volatile LAS unsigned* st;
};

__device__ __forceinline__ XcdBarrier xcd_barrier_post(unsigned* bar, volatile LAS unsigned* st) {
    XcdBarrier b; b.bar = bar; b.x = xb_xcc_id(); b.st = st;
    if (threadIdx.x == 0) (void)xb_add(&bar[XB_XCNT(b.x)], 1u);
    return b;
}
__device__ __forceinline__ void xcd_barrier_complete(unsigned* bar, unsigned x, unsigned& nloc, unsigned& nx) {
    const unsigned G = gridDim.x * gridDim.y * gridDim.z;
    unsigned sum, cnt, mine, sp = 0u;
    for (;;) {
        sum = 0u; cnt = 0u; mine = 0u;
#pragma unroll
        for (unsigned j = 0; j < 16; ++j) { const unsigned c = xb_ld(&bar[XB_XCNT(j)]); sum += c; cnt += (c > 0u) ? 1u : 0u; mine = (j == x) ? c : mine; }
        if (sum == G) break;
        __builtin_amdgcn_s_sleep(1);
        if ((++sp & 255u) == 0u) { if (xb_ld(&bar[XB_TMO])) break; if (sp > XB_SPIN_CAP) { atomicAdd(&bar[XB_TMO], 1u); break; } }
    }
    nloc = mine > 0u ? mine : 1u; nx = cnt > 0u ? cnt : 1u;
}

__device__ __forceinline__ void xcd_barrier(const XcdBarrier& b) {
    asm volatile("s_waitcnt vmcnt(0)" ::: "memory");
    __syncthreads();
    if (threadIdx.x == 0) {
        unsigned* bar = b.bar;
        __builtin_amdgcn_s_waitcnt(0);
        unsigned nloc = b.st[0], nx = b.st[1];
        if (nloc == 0u) { xcd_barrier_complete(bar, b.x, nloc, nx); b.st[0] = nloc; b.st[1] = nx; }
        const unsigned old = xb_add(&bar[XB_XSUB(b.x)], 1u);
        const unsigned gen = old / nloc;
        if (old + 1u == (gen + 1u) * nloc) {
            __builtin_amdgcn_fence(__ATOMIC_RELEASE, "agent");
            asm volatile("s_waitcnt vmcnt(0)" ::: "memory");
            const unsigned og = xb_add(&bar[XB_TOP], 1u);
            const unsigned tg = og / nx;
            if (og + 1u == (tg + 1u) * nx) xb_add(&bar[XB_TOPGEN], 1u);
            else XB_SPIN(xb_ld(&bar[XB_TOPGEN]) == tg, bar);
            __builtin_amdgcn_fence(__ATOMIC_ACQUIRE, "agent");
            xb_add(&bar[XB_XGEN(b.x)], 1u);
            asm volatile("s_waitcnt vmcnt(0)" ::: "memory");
        } else {
            XB_SPIN(xb_ld(&bar[XB_XGEN(b.x)]) == gen, bar);
            __builtin_amdgcn_fence(__ATOMIC_ACQUIRE, "agent");
            asm volatile("s_waitcnt vmcnt(0)" ::: "memory");
        }
    }
    __syncthreads();
}

__device__ __forceinline__ void dn_combine_panel(const Args& args, int pm, int wave, int lane) {
    unsigned char* ws = args.ws;
    const bf16* OF = (const bf16*)(ws + WS_OF); const bf16* OB = (const bf16*)(ws + WS_OB); const bf16* DZ = (const bf16*)(ws + WS_DZ); bf16* CAT = (bf16*)(ws + WS_CAT);
    const float* onw = args.in[6]; const int r0 = pm * 256;
            { int ln_ = lane; asm volatile("" : "+v"(ln_));
              float onv[8];
#pragma unroll
              for (int e = 0; e < 8; ++e) onv[e] = onw[(ln_ & 15) * 8 + e];
#pragma unroll 1
              for (int rb = wave * 32; rb < wave * 32 + 32; rb += 4) { v4u va[4], vc[4], vz[4];
#pragma unroll
                  for (int u = 0; u < 4; ++u) { const int r = r0 + rb + u, b = r >> 13, s = r & (SEQ - 1);
                      va[u] = *(const v4u*)(OF + (size_t)r * 512 + ln_ * 8); vc[u] = *(const v4u*)(OB + (size_t)r * 512 + ln_ * 8); vz[u] = *(const v4u*)(DZ + ((size_t)b * LT + NMETA + s) * 512 + ln_ * 8); }
#pragma unroll
                  for (int u = 0; u < 4; ++u) { const int r = r0 + rb + u; float a[8], c[8], z[8]; unpack8(va[u], a); unpack8(vc[u], c); unpack8(vz[u], z);
                      float ss = 0.f;
#pragma unroll
                      for (int e = 0; e < 8; ++e) { a[e] += c[e]; ss += a[e] * a[e]; }
                      ss += __shfl_xor(ss, 1); ss += __shfl_xor(ss, 2); ss += __shfl_xor(ss, 4); ss += __shfl_xor(ss, 8);
                      const float rs = __builtin_amdgcn_rsqf(ss * (1.f / 128.f) + EPS);
#pragma unroll
                      for (int e = 0; e < 8; ++e) a[e] = a[e] * rs * onv[e] * silu_f(z[e]);
                      *(v4u*)(CAT + (size_t)r * 1024 + ln_ * 8) = pack8(a); } } }
}

__global__ void __launch_bounds__(NWAVES * 64, 2) hymba_fwd(Args args) {
    extern __shared__ __attribute__((aligned(16))) unsigned char lds_raw[];
    LAS unsigned char* lds = (LAS unsigned char*)lds_raw;
    cg::grid_group grid = cg::this_grid();
    const int tid = threadIdx.x, lane = tid & 63, wave = __builtin_amdgcn_readfirstlane(tid >> 6);
    const int G = gridDim.x, bx = blockIdx.x;
    const int vcu = (G % 8 == 0) ? (bx % 8) * (G / 8) + bx / 8 : bx;
    const int gw = vcu * NWAVES + wave, NGW = G * NWAVES;
    unsigned char* ws = args.ws;
    const int lo = args.ph_lo, hi = args.ph_hi;
#define IN(k) (lo <= (k) && (k) < hi)
#define SEAM(k) do { if (IN(k) && IN((k) + 1)) { if ((k) == 0) grid.sync(); else xcd_barrier(xbar); } } while (0)
    volatile LAS unsigned* xbst = (volatile LAS unsigned*)(lds + XBST_OFF);
    if (tid < 16) xbst[tid] = 0u;
    __syncthreads();
    const XcdBarrier xbar = xcd_barrier_post((unsigned*)(ws + WS_CTL) + 4096, xbst);
    bf16* Win_t = (bf16*)(ws + WS_WIN); bf16* Wout_t = (bf16*)(ws + WS_WOUT); bf16* Wup_t = (bf16*)(ws + WS_WUP); bf16* Wdn_t = (bf16*)(ws + WS_WDN);

    if (IN(0)) {
        LAS float* scr = (LAS float*)(lds + wave * 16384);
        constexpr int I_IN = (DM / 64) * (NIN / 32), I_OUT = (DM / 64) * (DM / 32), I_UP = (DM / 64) * (FF / 32), I_DN = (FF / 64) * (DM / 32);
        for (int it = gw; it < I_IN + I_OUT + I_UP + I_DN; it += NGW) {
            int r = it;
            if (r < I_IN) { p0_transpose_item<1>(args.in[2], DM, 2832, NIN, Win_t, scr, r, lane); continue; } r -= I_IN;
            if (r < I_OUT) { p0_transpose_item<0>(args.in[9], DM, DM, DM, Wout_t, scr, r, lane); continue; } r -= I_OUT;
            if (r < I_UP) { p0_transpose_item<0>(args.in[12], DM, FF, FF, Wup_t, scr, r, lane); continue; } r -= I_UP;
            p0_transpose_item<0>(args.in[13], FF, DM, DM, Wdn_t, scr, r, lane);
        }
        bf16* XN = (bf16*)(ws + WS_XN);
        { f32x4 wv[4];
#pragma unroll
          for (int j = 0; j < 4; ++j) wv[j] = ((const f32x4*)args.in[10] + lane)[64 * j];
          if (gw < NMETA) rms_row_to_bf16(args.in[1] + (size_t)gw * DM, args.in[10], XN + (size_t)(MR + gw) * DM, lane);
#pragma unroll 1
          for (int mb = gw; mb < MR; mb += 4 * NGW) { f32x4 xv[4][4];
#pragma unroll
              for (int u = 0; u < 4; ++u) { const f32x4* src = (const f32x4*)(args.in[0] + (size_t)(mb + u * NGW) * DM) + lane;
#pragma unroll
                  for (int j = 0; j < 4; ++j) xv[u][j] = src[64 * j]; }
#pragma unroll
              for (int u = 0; u < 4; ++u) { const int m = mb + u * NGW; float s = 0.f;
#pragma unroll
                  for (int j = 0; j < 4; ++j) s += (xv[u][j].x * xv[u][j].x + xv[u][j].y * xv[u][j].y) + (xv[u][j].z * xv[u][j].z + xv[u][j].w * xv[u][j].w);
                  const float rs = __builtin_amdgcn_rsqf(wave_sum(s) * (1.f / DM) + EPS);
                  v2u* o8 = (v2u*)(XN + (size_t)m * DM) + lane;
#pragma unroll
                  for (int j = 0; j < 4; ++j) { const f32x4 v = xv[u][j], ww = wv[j]; v2u o; o.x = pk2(v.x * rs * ww.x, v.y * rs * ww.y); o.y = pk2(v.z * rs * ww.z, v.w * rs * ww.w); o8[64 * j] = o; } } } }
    }
    SEAM(0);
    if (IN(1)) {
        if (gw < NIN / 16) {
            const int fr = lane & 15, fq = lane >> 4, nt = gw;
            const bf16* Ap = (const bf16*)(ws + WS_XN) + (size_t)(MR + fr) * DM + fq * 8; const bf16* Bp = Win_t + (size_t)(16 * nt + fr) * DM + fq * 8;
            f32x4 acc = (f32x4){0.f, 0.f, 0.f, 0.f};
#pragma unroll 8
            for (int ks = 0; ks < DM / 32; ++ks) acc = __builtin_amdgcn_mfma_f32_16x16x32_bf16(*(const bf16x8*)(Ap + ks * 32), *(const bf16x8*)(Bp + ks * 32), acc, 0, 0, 0);
            const int c = 16 * nt + fr;
            for (int b = 0; b < NB; ++b) {
#pragma unroll
                for (int r = 0; r < 4; ++r) { const size_t m = (size_t)b * LT + 4 * fq + r; const float v = acc[r];
                    if (c < 1536) ((bf16*)(ws + WS_DQKV))[m * 1536 + c] = (bf16)f2bf(v);
                    else if (c < 2048) ((bf16*)(ws + WS_DZ))[m * 512 + (c - 1536)] = (bf16)f2bf(v);
                    else if (c < 2816) ((bf16*)(ws + WS_AQKV))[m * 768 + (c - 2048)] = (bf16)f2bf(v);
                    else if (c < 2832) ((float*)(ws + WS_BA))[m * 16 + (c - 2816)] = v; } }
        }
        pg8::Gemm g{(const bf16*)(ws + WS_XN), Win_t, MR, NIN, DM}; pg8::StaticOrder S; S.init(MR, NIN, G, bx);
        pg8::EpiProj E{(bf16*)(ws + WS_DQKV), (bf16*)(ws + WS_DZ), (bf16*)(ws + WS_AQKV), (float*)(ws + WS_BA)};
        pg8::gemm_phase<pg8::EpiProj, pg8::StaticOrder, true, true>(lds, g, S, E);
    }
    SEAM(1);
    if (IN(2)) {
        { LAS float* rope = (LAS float*)(lds + ROPE_OFF);
#pragma unroll 1
          for (int e = 0; e < 4; ++e) { const int idx = tid + NTHR * e, pos = idx >> 4, f = idx & 15; float sv, cv; sincosf((float)pos * exp2f(-(float)f * (13.287712379549449f / 16.f)), &sv, &cv); rope[idx] = cv; rope[2048 + idx] = sv; }
          __syncthreads(); }
        { v4u rawv[7]; float cwv[4]; float pbb = 0.f, paa = 0.f;
          const bf16* DQKV = (const bf16*)(ws + WS_DQKV); const float* BA = (const float*)(ws + WS_BA); const float* conv_w = args.in[3];
          for (int item = bx; item < NB * NCH * 4; item += G) dn_prep_item(args, lds, item, item + G, rawv, cwv, pbb, paa, tid, wave, lane); }
        { const bf16* AQ = (const bf16*)(ws + WS_AQKV); const LAS float* rope = (const LAS float*)(lds + ROPE_OFF);
          constexpr int NGRP = NB * LKP / 4, HEAVY_G = 18; const int extra = (NB * NCH * 4) % G;
          int gs, ge;
          if (bx < extra) { gs = bx * HEAVY_G; ge = gs + HEAVY_G; }
          else { const long rem = NGRP - (long)extra * HEAVY_G; const int nl = G - extra; gs = extra * HEAVY_G + (int)(((long)(bx - extra) * rem) / nl); ge = extra * HEAVY_G + (int)(((long)(bx - extra + 1) * rem) / nl); }
#pragma unroll 1
          for (int g = gs + wave; g < ge; g += NWAVES) { v4u qd[4], kd[4];
#pragma unroll
              for (int u = 0; u < 4; ++u) { const int i_ = 4 * g + u, b = i_ / LKP, t = i_ % LKP, tq = t < LT ? t : LT - 1;
                  const bf16* row = AQ + (size_t)(b * LT + tq) * 768; qd[u] = *(const v4u*)(row + lane * 8); kd[u] = *(const v4u*)(row + 512 + (lane & 31) * 8); }
#pragma unroll
              for (int u = 0; u < 4; ++u) { const int i_ = 4 * g + u;
                  attn_prep_row(qd[u], kd[u], rope, args.in[7], args.in[8], (bf16*)(ws + WS_Q), (bf16*)(ws + WS_KB), (bf16*)(ws + WS_VB), i_ / LKP, i_ % LKP, lane); } } }
    }
    SEAM(2);
    if (IN(3)) {
        unsigned* ctl = (unsigned*)(ws + WS_CTL);
        for (int chain = bx; chain < NB * 8; chain += G) { dn_scan(args, lds, chain, tid, wave, lane);
            asm volatile("s_waitcnt vmcnt(0)" ::: "memory"); __syncthreads();
            if (tid == 0) { __builtin_amdgcn_fence(__ATOMIC_RELEASE, "agent"); asm volatile("s_waitcnt vmcnt(0)" ::: "memory"); __hip_atomic_fetch_add(ctl + 64 * 12, 1u, __ATOMIC_RELAXED, __HIP_MEMORY_SCOPE_AGENT); } }
        volatile LAS int* slot = (volatile LAS int*)(lds + QSLOT_OFF);
        const unsigned xcc = xcc_id() & 7u;
        for (;;) {
            if (tid == 0) { int u = -1;
                for (unsigned k = 0; k < 8; ++k) { const unsigned q = (xcc + k) & 7u; const unsigned idx = __hip_atomic_fetch_add(ctl + 64 * (1 + q), 1u, __ATOMIC_RELAXED, __HIP_MEMORY_SCOPE_AGENT); if (idx < 256u) { u = (int)(q * 512u + idx); break; } }
                if (u < 0) { const unsigned p = __hip_atomic_fetch_add(ctl + 64 * 13, 1u, __ATOMIC_RELAXED, __HIP_MEMORY_SCOPE_AGENT); if (p < 256u) u = (int)((p >> 5) * 512u + 256u + (p & 31u)); }
                if (u >= 0 && (u & 511) >= 256) {
                    unsigned sp = 0; while (__hip_atomic_load(ctl + 64 * 12, __ATOMIC_RELAXED, __HIP_MEMORY_SCOPE_AGENT) < (unsigned)(NB * 8) && ++sp < (1u << 22)) __builtin_amdgcn_s_sleep(2);
                    __builtin_amdgcn_fence(__ATOMIC_ACQUIRE, "agent"); asm volatile("s_waitcnt vmcnt(0)" ::: "memory"); }
                *slot = u; }
            __syncthreads();
            const int u = *slot;
            __syncthreads();
            if (u < 0) break;
            if ((u & 511) >= 256) { dn_combine_panel(args, (u >> 9) * 32 + ((u & 511) - 256), wave, lane); continue; }
            const int q = u >> 9, idx = u & 255, pair = q * 2 + (idx >> 7), gh = (idx >> 5) & 3, qb = idx & 31, b = pair >> 1, kvh = pair & 1, h = kvh * 4 + gh;
            const attn_body::bf16* Qu = (const attn_body::bf16*)(ws + WS_Q) + ((size_t)(b * SEQ + qb * 256)) * 512 + h * 64;
            const attn_body::bf16* Kh = (const attn_body::bf16*)(ws + WS_KB) + ((size_t)(b * 2 + kvh) * LKP) * 64;
            const attn_body::bf16* Vh = (const attn_body::bf16*)(ws + WS_VB) + ((size_t)(b * 2 + kvh) * LKP) * 64;
            attn_body::bf16* Ou = (attn_body::bf16*)(ws + WS_CAT) + ((size_t)(b * SEQ + qb * 256)) * 1024 + 512 + h * 64;
            attn_body::attn_unit<8>(Qu, Kh, Vh, Ou, (char*)lds_raw);
        }
    }
    SEAM(3);
    if (IN(4)) {
#define CU_LOCAL_SYNC() do { asm volatile("s_waitcnt vmcnt(0)" ::: "memory"); __syncthreads(); __builtin_amdgcn_fence(__ATOMIC_ACQUIRE, "agent"); asm volatile("s_waitcnt vmcnt(0)" ::: "memory"); } while (0)
        const bf16* OF = (const bf16*)(ws + WS_OF); const bf16* OB = (const bf16*)(ws + WS_OB); const bf16* DZ = (const bf16*)(ws + WS_DZ); bf16* CAT = (bf16*)(ws + WS_CAT);
        bf16* MIXB = (bf16*)(ws + WS_MIX); bf16* XN2 = (bf16*)(ws + WS_CAT);
        const float* onw = args.in[6];
        if (bx < MR / 256) { const int pm = bx;
            const int r0 = pm * 256;
            { pg8::Gemm g{(const bf16*)CAT, Wout_t, MR, DM, DM}; pg8::PanelOrder S{pm, DM / 256};
              pg8::EpiBf16<0> E{MIXB, DM, nullptr, 0, 0, 1.f};
              pg8::gemm_phase<pg8::EpiBf16<0>, pg8::PanelOrder, true, true>(lds, g, S, E); }
            CU_LOCAL_SYNC();
            { int ln_ = lane; asm volatile("" : "+v"(ln_));
              f32x4 w1v[4], w2v[4];
#pragma unroll
              for (int j = 0; j < 4; ++j) { w1v[j] = ((const f32x4*)args.in[11] + ln_)[64 * j]; w2v[j] = ((const f32x4*)args.in[14] + ln_)[64 * j]; }
#pragma unroll 1
              for (int rb = wave * 32; rb < wave * 32 + 32; rb += 4) { v2u mv[4][4]; f32x4 xv[4][4];
#pragma unroll
                  for (int u = 0; u < 4; ++u) { const int r = r0 + rb + u; const v2u* mr = (const v2u*)(MIXB + (size_t)r * DM) + ln_; const f32x4* xr = (const f32x4*)(args.in[0] + (size_t)r * DM) + ln_;
#pragma unroll
                      for (int j = 0; j < 4; ++j) { mv[u][j] = mr[64 * j]; xv[u][j] = xr[64 * j]; } }
#pragma unroll
                  for (int u = 0; u < 4; ++u) { const int r = r0 + rb + u; f32x4 v[4]; float s = 0.f;
#pragma unroll
                      for (int j = 0; j < 4; ++j) { const v2u m = mv[u][j]; v[j] = (f32x4){__builtin_bit_cast(float, m.x << 16), __builtin_bit_cast(float, m.x & 0xffff0000u), __builtin_bit_cast(float, m.y << 16), __builtin_bit_cast(float, m.y & 0xffff0000u)};
                          s += (v[j].x * v[j].x + v[j].y * v[j].y) + (v[j].z * v[j].z + v[j].w * v[j].w); }
                      const float rs = __builtin_amdgcn_rsqf(wave_sum(s) * (1.f / DM) + EPS); float s2 = 0.f;
                      f32x4* orow = (f32x4*)(args.out + (size_t)r * DM) + ln_;
#pragma unroll
                      for (int j = 0; j < 4; ++j) { v[j] = xv[u][j] + v[j] * rs * w1v[j]; orow[64 * j] = v[j]; s2 += (v[j].x * v[j].x + v[j].y * v[j].y) + (v[j].z * v[j].z + v[j].w * v[j].w); }
                      const float rs2 = __builtin_amdgcn_rsqf(wave_sum(s2) * (1.f / DM) + EPS);
                      v2u* o8 = (v2u*)(XN2 + (size_t)r * DM) + ln_;
#pragma unroll
                      for (int j = 0; j < 4; ++j) { const f32x4 ww = w2v[j]; v2u o; o.x = pk2(v[j].x * rs2 * ww.x, v[j].y * rs2 * ww.y); o.y = pk2(v[j].z * rs2 * ww.z, v[j].w * rs2 * ww.w); o8[64 * j] = o; } } } }
            CU_LOCAL_SYNC();
        }
#undef CU_LOCAL_SYNC
    }
    SEAM(4);
    if (IN(5)) {
        pg8::Gemm g{(const bf16*)(ws + WS_CAT), Wup_t, MR, FF, DM}; pg8::StaticOrder S; S.init(MR, FF, G, bx);
        pg8::EpiRelu2 E{(bf16*)(ws + WS_HID), FF};
        pg8::gemm_phase<pg8::EpiRelu2, pg8::StaticOrder, true, true>(lds, g, S, E);
    }
    SEAM(5);
    if (IN(6)) {
        pg8::Gemm g{(const bf16*)(ws + WS_HID), Wdn_t, MR, DM, FF}; pg8::StaticOrder S; S.init(MR, DM, G, bx);
        pg8::EpiBf16<0> E{(bf16*)(ws + WS_MIX), DM, nullptr, 0, 0, 1.f};
        pg8::gemm_phase<pg8::EpiBf16<0>, pg8::StaticOrder, true, true>(lds, g, S, E);
    }
    SEAM(6);
    if (IN(7)) {
        const bf16* MIXB = (const bf16*)(ws + WS_MIX);
        f32x4 w1v[4];
#pragma unroll
        for (int j = 0; j < 4; ++j) w1v[j] = ((const f32x4*)args.in[15] + lane)[64 * j];
#pragma unroll 1
        for (int rb = gw; rb < MR; rb += 4 * NGW) { v2u mv[4][4]; f32x4 hv[4][4];
#pragma unroll
            for (int u = 0; u < 4; ++u) { const int r = rb + u * NGW; const v2u* mr = (const v2u*)(MIXB + (size_t)r * DM) + lane; const f32x4* hr = (const f32x4*)(args.out + (size_t)r * DM) + lane;
#pragma unroll
                for (int j = 0; j < 4; ++j) { mv[u][j] = mr[64 * j]; hv[u][j] = hr[64 * j]; } }
#pragma unroll
            for (int u = 0; u < 4; ++u) { const int r = rb + u * NGW; f32x4 v[4]; float s = 0.f;
#pragma unroll
                for (int j = 0; j < 4; ++j) { const v2u m = mv[u][j]; v[j] = (f32x4){__builtin_bit_cast(float, m.x << 16), __builtin_bit_cast(float, m.x & 0xffff0000u), __builtin_bit_cast(float, m.y << 16), __builtin_bit_cast(float, m.y & 0xffff0000u)};
                    s += (v[j].x * v[j].x + v[j].y * v[j].y) + (v[j].z * v[j].z + v[j].w * v[j].w); }
                const float rs = __builtin_amdgcn_rsqf(wave_sum(s) * (1.f / DM) + EPS);
                f32x4* orow = (f32x4*)(args.out + (size_t)r * DM) + lane;
#pragma unroll
                for (int j = 0; j < 4; ++j) orow[64 * j] = hv[u][j] + v[j] * rs * w1v[j]; } }
    }
#undef IN
#undef SEAM
}

extern "C" void kernel_launch(void* const* d_in, const int* in_sizes, int n_in, void* d_out, int out_size, void* d_ws, size_t ws_size, hipStream_t stream) {
    static int grid = 0;
    if (grid == 0) {
        if (n_in != 16 || in_sizes[0] != MR * DM || out_size != MR * DM || ws_size < WS_END) { fprintf(stderr, "kernel_launch: unexpected shapes / workspace (n_in %d, in0 %d, out %d, ws %zu)\n", n_in, n_in > 0 ? in_sizes[0] : -1, out_size, ws_size); grid = -1; return; }
        int dev = 0, cus = 0, per_cu = 0;
        if (hipGetDevice(&dev) != hipSuccess || hipDeviceGetAttribute(&cus, hipDeviceAttributeMultiprocessorCount, dev) != hipSuccess) { grid = -1; return; }
        if (hipFuncSetAttribute((const void*)hymba_fwd, hipFuncAttributeMaxDynamicSharedMemorySize, LDS_BYTES) != hipSuccess) { fprintf(stderr, "kernel_launch: hipFuncSetAttribute failed\n"); grid = -1; return; }
        if (hipOccupancyMaxActiveBlocksPerMultiprocessor(&per_cu, (const void*)hymba_fwd, NWAVES * 64, LDS_BYTES) != hipSuccess || per_cu < 1) { fprintf(stderr, "kernel_launch: occupancy query says %d\n", per_cu); per_cu = 1; }
        (void)hipGetLastError();
        grid = cus >= 256 ? 256 : cus;
        if (grid != 256) fprintf(stderr, "kernel_launch: %d CUs: this build needs 256 workgroups\n", cus);
    }
    if (grid < 0) return;
    (void)hipMemsetAsync((char*)d_ws + WS_CTL, 0, CTL_ZERO_BYTES, stream);
    Args a{};
    for (int i = 0; i < 16; ++i) a.in[i] = (const float*)d_in[i];
    a.out = (float*)d_out; a.ws = (unsigned char*)d_ws;
#if ONE_LAUNCH
    a.ph_lo = 0; a.ph_hi = NPHASE;
    void* kargs[] = {&a};
    hipError_t e = hipLaunchCooperativeKernel((const void*)hymba_fwd, dim3(grid), dim3(NWAVES * 64), kargs, LDS_BYTES, stream);
    if (e != hipSuccess) fprintf(stderr, "kernel_launch: cooperative launch failed: %s (grid %d)\n", hipGetErrorString(e), grid);
#else
    for (int p = 0; p < NPHASE; ++p) { a.ph_lo = p; a.ph_hi = p + 1; hipLaunchKernelGGL(hymba_fwd, dim3(grid), dim3(NWAVES * 64), LDS_BYTES, stream, a); }
#endif
}
```

```cpp
#include <hip/hip_runtime.h>
#include <cstdio>
#include <cstdint>
namespace pg8 {
#define PG8_LAS __attribute__((address_space(3)))
typedef unsigned short bf16_t;
typedef short bf16x8 __attribute__((ext_vector_type(8)));
typedef float f32x4 __attribute__((ext_vector_type(4)));
typedef unsigned u32x4 __attribute__((ext_vector_type(4)));
constexpr int BM = 256, BK = 64, HALF = 128, HTB = HALF * BK * 2  , STAGE_BYTES = 8 * HTB, NXCD = 8, WGM = 8;

__host__ __device__ __forceinline__ int lds_byte(int r, int c) { const int st = (r >> 4) * 2 + (c >> 5), rr = r & 15, cc = c & 31, ob = rr * 64 + cc * 2; return st * 1024 + (ob ^ (((ob >> 9) & 1) << 5)); }
__host__ __device__ __forceinline__ void stage_rc(int b, int& R, int& C) { const int st = b / 1024, sb = b % 1024, swz = sb ^ (((sb >> 9) & 1) << 5); R = (st >> 1) * 16 + swz / 64; C = (st & 1) * 32 + (swz % 64) / 2; }
__host__ __device__ __forceinline__ int perm32(int rho) { const int n = rho >> 4, i = rho & 15; return 8 * (i >> 2) + 4 * n + (i & 3); }

struct Unit { int pm, pn; };
struct Gemm { const bf16_t* A; const bf16_t* Bt; int M, N, K; };

struct StaticOrder {
    int nM, nN, nwg, G, c;
    __host__ __device__ void init(int M, int N, int G_, int c_) { nM = M / BM; nN = N / BM; nwg = nM * nN; G = G_; c = c_; }
    __host__ __device__ bool next(int i, Unit& u) const {
        const long L = (long)i * G + c; if (L >= nwg) return false;
        int wgid = (int)L; { const int q = nwg / NXCD, r = nwg % NXCD, xcd = wgid % NXCD, off = wgid / NXCD; wgid = (xcd < r ? xcd * (q + 1) : r * (q + 1) + (xcd - r) * q) + off; }
        const int nig = WGM * nN, gid = wgid / nig, fm = gid * WGM, gsz = (nM - fm) < WGM ? (nM - fm) : WGM;
        u.pm = fm + ((wgid % nig) % gsz); u.pn = (wgid % nig) / gsz; return true;
    }
    __device__ __forceinline__ void a_ready(const Unit&) const {}
    __device__ __forceinline__ void done(const Unit&) const {}
};

__device__ __forceinline__ unsigned cvt_pk_bf16(float lo, float hi) { unsigned r; asm volatile("v_cvt_pk_bf16_f32 %0, %1, %2" : "=v"(r) : "v"(lo), "v"(hi)); return r; }
typedef float f32x2 __attribute__((ext_vector_type(2)));
__device__ __forceinline__ f32x2 gelu_pk(f32x2 v) {
    const f32x2 av = __builtin_elementwise_abs(v), d = av * 0.2316418882f + 1.0f;
    f32x2 t; t.x = __builtin_amdgcn_rcpf(d.x); t.y = __builtin_amdgcn_rcpf(d.y);
    f32x2 q = t * 0.5307027145f + (-0.7265760135f); q = q * t + 0.7107068705f; q = q * t + (-0.142248368f); q = q * t + 0.127414796f; q = q * t;
    const f32x2 s = (v * v) * (-0.72134752044f);
    f32x2 e; e.x = __builtin_amdgcn_exp2f(s.x); e.y = __builtin_amdgcn_exp2f(s.y);
    const f32x2 m = v * (q * e), r = v - m;
    f32x2 o; o.x = v.x < 0.f ? m.x : r.x; o.y = v.y < 0.f ? m.y : r.y; return o;
}

template <int ACT  > struct EpiBf16 {
    static constexpr bool PERM = true, AFTER_DRAIN = false; static_assert(ACT == 0 || ACT == 1, "EpiBf16: ACT is 0 (none) or 1 (gelu_pk)");
    bf16_t* O; int ldc; const float* bias; int split_cols; size_t split_stride; float scale0;
    __device__ __forceinline__ void operator()(const f32x4 (&acc)[2][2][4][2], const Unit& u, int wr, int wc, int fr, int fq) const {
        const int row0 = u.pm * BM + wr * 64 + fr; int colt = u.pn * BM; bf16_t* base = O;
        float sc = 1.f; if (split_cols) { const int t = colt / split_cols; base += (size_t)t * split_stride; colt -= t * split_cols; if (t == 0) sc = scale0; }
        const int col0 = colt + wc * 32 + 8 * fq, bcol0 = u.pn * BM + wc * 32 + 8 * fq;
        f32x4 bv[2][2];
#pragma unroll
        for (int bj = 0; bj < 2; ++bj)
#pragma unroll
            for (int n = 0; n < 2; ++n) bv[bj][n] = bias ? *(const f32x4*)(bias + bcol0 + bj * HALF + 4 * n) : (f32x4){0.f, 0.f, 0.f, 0.f};
#pragma unroll
        for (int ai = 0; ai < 2; ++ai)
#pragma unroll
            for (int m = 0; m < 4; ++m) { bf16_t* rowp = base + (size_t)(row0 + ai * HALF + m * 16) * ldc + col0;
#pragma unroll
                for (int bj = 0; bj < 2; ++bj) { f32x4 v0 = acc[ai][bj][m][0] + bv[bj][0], v1 = acc[ai][bj][m][1] + bv[bj][1];
                    if (ACT == 1) { f32x2 a = gelu_pk((f32x2){v0[0], v0[1]}), b = gelu_pk((f32x2){v0[2], v0[3]}), c = gelu_pk((f32x2){v1[0], v1[1]}), d = gelu_pk((f32x2){v1[2], v1[3]});
                        v0 = (f32x4){a.x, a.y, b.x, b.y}; v1 = (f32x4){c.x, c.y, d.x, d.y}; }
                    v0 = v0 * sc; v1 = v1 * sc; u32x4 w; w.x = cvt_pk_bf16(v0[0], v0[1]); w.y = cvt_pk_bf16(v0[2], v0[3]); w.z = cvt_pk_bf16(v1[0], v1[1]); w.w = cvt_pk_bf16(v1[2], v1[3]);
                    *(u32x4*)(rowp + bj * HALF) = w; } }
    }
};
struct PanelOrder {
    int pm, nN;
    __device__ __forceinline__ bool next(int i, Unit& u) const { if (i >= nN) return false; int p = i; asm volatile("" : "+s"(p)); u.pm = pm; u.pn = p; return true; }
    __device__ __forceinline__ void a_ready(const Unit&) const {}
    __device__ __forceinline__ void done(const Unit&) const {}
};
struct EpiProj {
    static constexpr bool PERM = true, AFTER_DRAIN = false;
    bf16_t* dqkv; bf16_t* dz; bf16_t* aqkv; float* ba;
    __device__ __forceinline__ void operator()(const f32x4 (&acc)[2][2][4][2], const Unit& u, int wr, int wc, int fr, int fq) const {
        const int row0 = u.pm * BM + 16 * ((u.pm >> 5) + 1) + wr * 64 + fr; const int pn = u.pn;
        if (pn == 11) {
            if (wc == 0 && fq < 2) {
#pragma unroll
                for (int ai = 0; ai < 2; ++ai)
#pragma unroll
                    for (int m = 0; m < 4; ++m) { float* p = ba + (size_t)(row0 + ai * HALF + m * 16) * 16 + 8 * fq; *(f32x4*)p = acc[ai][0][m][0]; *(f32x4*)(p + 4) = acc[ai][0][m][1]; }
            }
            return;
        }
        bf16_t* base; int ldc, colt;
        if (pn < 6) { base = dqkv; ldc = 1536; colt = pn * 256; } else if (pn < 8) { base = dz; ldc = 512; colt = (pn - 6) * 256; } else { base = aqkv; ldc = 768; colt = (pn - 8) * 256; }
        const int col0 = colt + wc * 32 + 8 * fq;
#pragma unroll
        for (int ai = 0; ai < 2; ++ai)
#pragma unroll
            for (int m = 0; m < 4; ++m) { bf16_t* rowp = base + (size_t)(row0 + ai * HALF + m * 16) * ldc + col0;
#pragma unroll
                for (int bj = 0; bj < 2; ++bj) { const f32x4 v0 = acc[ai][bj][m][0], v1 = acc[ai][bj][m][1];
                    u32x4 w; w.x = cvt_pk_bf16(v0[0], v0[1]); w.y = cvt_pk_bf16(v0[2], v0[3]); w.z = cvt_pk_bf16(v1[0], v1[1]); w.w = cvt_pk_bf16(v1[2], v1[3]);
                    *(u32x4*)(rowp + bj * HALF) = w; } }
    }
};
struct EpiRelu2 {
    static constexpr bool PERM = true, AFTER_DRAIN = false;
    bf16_t* O; int ldc;
    __device__ __forceinline__ void operator()(const f32x4 (&acc)[2][2][4][2], const Unit& u, int wr, int wc, int fr, int fq) const {
        const int row0 = u.pm * BM + wr * 64 + fr; const int col0 = u.pn * BM + wc * 32 + 8 * fq;
#pragma unroll
        for (int ai = 0; ai < 2; ++ai)
#pragma unroll
            for (int m = 0; m < 4; ++m) { bf16_t* rowp = O + (size_t)(row0 + ai * HALF + m * 16) * ldc + col0;
#pragma unroll
                for (int bj = 0; bj < 2; ++bj) { f32x4 v0 = acc[ai][bj][m][0], v1 = acc[ai][bj][m][1];
#pragma unroll
                    for (int e = 0; e < 4; ++e) { const float a = fmaxf(v0[e], 0.f), b = fmaxf(v1[e], 0.f); v0[e] = a * a; v1[e] = b * b; }
                    u32x4 w; w.x = cvt_pk_bf16(v0[0], v0[1]); w.y = cvt_pk_bf16(v0[2], v0[3]); w.z = cvt_pk_bf16(v1[0], v1[1]); w.w = cvt_pk_bf16(v1[2], v1[3]);
                    *(u32x4*)(rowp + bj * HALF) = w; } }
    }
};
struct EpiF32 {
    static constexpr bool PERM = false, AFTER_DRAIN = false;
    float* O; int ldc;
    __device__ __forceinline__ void operator()(const f32x4 (&acc)[2][2][4][2], const Unit& u, int wr, int wc, int fr, int fq) const {
        const int row0 = u.pm * BM + wr * 64 + fr; const int col0 = u.pn * BM + wc * 32 + 4 * fq;
#pragma unroll
        for (int ai = 0; ai < 2; ++ai)
#pragma unroll
            for (int m = 0; m < 4; ++m) { float* rowp = O + (size_t)(row0 + ai * HALF + m * 16) * ldc + col0;
#pragma unroll
                for (int bj = 0; bj < 2; ++bj)
#pragma unroll
                    for (int n = 0; n < 2; ++n) *(f32x4*)(rowp + bj * HALF + n * 16) = acc[ai][bj][m][n]; }
    }
};
template <class Epi, class Sched, bool ALIGN_EPI = false, bool SP2 = false>
__device__ __forceinline__ void gemm_phase(PG8_LAS unsigned char* lds, const Gemm g, const Sched& S, const Epi& E) {
    const int tid = threadIdx.x, wid = __builtin_amdgcn_readfirstlane(tid >> 6), lane = tid & 63, wr = wid >> 2, wc = wid & 3, fr = lane & 15, fq = lane >> 4;
    const int K = g.K, nt = K / BK;
    unsigned voffA[2], voffB[2];
#pragma unroll
    for (int i = 0; i < 2; ++i) { int R, C; stage_rc(tid * 16 + i * 8192, R, C); const int Rb = Epi::PERM ? ((R & ~31) + perm32(R & 31)) : R;
        voffA[i] = (unsigned)(R * K + C) * 2u; voffB[i] = (unsigned)(Rb * K + C) * 2u; }
    const size_t kstep = (size_t)(BK * 2);
    const size_t hstep = (size_t)HALF * K * 2;
    const size_t tstep = 2 * hstep;
    const unsigned ldsw = (unsigned)wid * 1024u;
    const int aoff = lds_byte(wr * 64 + fr, fq * 8), boff = lds_byte(wc * 32 + fr, fq * 8);
#define PG8_SA(b, h) (((b) * 2 + (h)) * HTB)
#define PG8_SB(b, h) ((4 + (b) * 2 + (h)) * HTB)
#define PG8_STAGE(bufoff, gbase, voff) do { _Pragma("unroll") for (int _i = 0; _i < 2; ++_i) \
        __builtin_amdgcn_global_load_lds((const unsigned*)((const char*)(gbase) + (voff)[_i]), (PG8_LAS unsigned*)(lds + (bufoff) + ldsw + _i * 8192), 16, 0, 0); } while (0)
#define PG8_LDA(dst, b, h) do { _Pragma("unroll") for (int m = 0; m < 4; ++m) _Pragma("unroll") for (int k = 0; k < 2; ++k) dst[m][k] = *(const PG8_LAS bf16x8*)(lds + PG8_SA(b, h) + aoff + m * 2048 + k * 1024); } while (0)
#define PG8_LDB(dst, b, h) do { _Pragma("unroll") for (int n = 0; n < 2; ++n) _Pragma("unroll") for (int k = 0; k < 2; ++k) dst[n][k] = *(const PG8_LAS bf16x8*)(lds + PG8_SB(b, h) + boff + n * 2048 + k * 1024); } while (0)
#define PG8_MMA(ai, bj, At, Bt) do { __builtin_amdgcn_s_setprio(1); _Pragma("unroll") for (int m = 0; m < 4; ++m) _Pragma("unroll") for (int n = 0; n < 2; ++n) _Pragma("unroll") for (int k = 0; k < 2; ++k) \
        acc[ai][bj][m][n] = __builtin_amdgcn_mfma_f32_16x16x32_bf16(Bt[n][k], At[m][k], acc[ai][bj][m][n], 0, 0, 0); __builtin_amdgcn_s_setprio(0); } while (0)
#define PG8_WAIT_V(n) asm volatile("s_waitcnt vmcnt(" #n ")" ::: "memory")
#define PG8_WAIT_L(n) asm volatile("s_waitcnt lgkmcnt(" #n ")" ::: "memory")
#define PG8_BAR __builtin_amdgcn_s_barrier()
#define PG8_SCHED __builtin_amdgcn_sched_barrier(0)
    Unit cur, nxt; int ui = 0;
    if (!S.next(0, cur)) return;
    f32x4 acc[2][2][4][2];
#pragma unroll
    for (int a = 0; a < 2; ++a)
#pragma unroll
        for (int b = 0; b < 2; ++b)
#pragma unroll
            for (int m = 0; m < 4; ++m)
#pragma unroll
                for (int n = 0; n < 2; ++n) acc[a][b][m][n] = (f32x4){0.f, 0.f, 0.f, 0.f};
    bf16x8 At[4][2], B0[2][2], B1[2][2];
    const char* cA = (const char*)g.A + (size_t)cur.pm * tstep; const char* cB = (const char*)g.Bt + (size_t)cur.pn * tstep;
    S.a_ready(cur);
    if constexpr (SP2) {
        PG8_STAGE(PG8_SB(0, 0), cB, voffB); PG8_STAGE(PG8_SB(0, 1), cB + hstep, voffB); PG8_STAGE(PG8_SA(0, 0), cA, voffA); PG8_STAGE(PG8_SA(0, 1), cA + hstep, voffA);
        if (wr == 1) PG8_BAR;
        PG8_WAIT_V(2); PG8_BAR;
        PG8_STAGE(PG8_SB(1, 0), cB + kstep, voffB); PG8_STAGE(PG8_SA(1, 0), cA + kstep, voffA); PG8_STAGE(PG8_SB(1, 1), cB + hstep + kstep, voffB);
        PG8_WAIT_V(6); PG8_BAR;
    } else {
        PG8_STAGE(PG8_SB(0, 0), cB, voffB); PG8_STAGE(PG8_SA(0, 0), cA, voffA); PG8_STAGE(PG8_SB(0, 1), cB + hstep, voffB); PG8_STAGE(PG8_SA(0, 1), cA + hstep, voffA);
        if (wr == 1) PG8_BAR;
        PG8_WAIT_V(4); PG8_BAR;
        PG8_STAGE(PG8_SB(1, 0), cB + kstep, voffB); PG8_STAGE(PG8_SA(1, 0), cA + kstep, voffA); PG8_STAGE(PG8_SB(1, 1), cB + hstep + kstep, voffB);
        PG8_WAIT_V(6); PG8_BAR;
    }
    for (;;) {
        const bool has_next = S.next(ui + 1, nxt);
        const char* nA = has_next ? (const char*)g.A + (size_t)nxt.pm * tstep : cA; const char* nB = has_next ? (const char*)g.Bt + (size_t)nxt.pn * tstep : cB;
        for (int t = 0; t < nt; t += 2) {
            const bool last = (t == nt - 2);
            const char* a1 = cA + (size_t)(t + 1) * kstep;
            const char* a2 = last ? nA : cA + (size_t)(t + 2) * kstep; const char* b2 = last ? nB : cB + (size_t)(t + 2) * kstep;
            const char* a3 = a2 + kstep; const char* b3 = b2 + kstep;
            if (last && has_next) S.a_ready(nxt);
            if constexpr (SP2) {
            PG8_LDB(B0, 0, 0); PG8_LDB(B1, 0, 1); PG8_SCHED; PG8_LDA(At, 0, 0); PG8_STAGE(PG8_SA(1, 1), a1 + hstep, voffA);
            PG8_WAIT_V(8); PG8_WAIT_L(0); PG8_BAR; PG8_MMA(0, 0, At, B0); PG8_MMA(0, 1, At, B1); PG8_BAR; PG8_SCHED;
            PG8_LDA(At, 0, 1); PG8_STAGE(PG8_SB(0, 0), b2, voffB); PG8_STAGE(PG8_SB(0, 1), b2 + hstep, voffB); PG8_STAGE(PG8_SA(0, 0), a2, voffA);
            PG8_WAIT_V(8); PG8_WAIT_L(0); PG8_BAR; PG8_MMA(1, 0, At, B0); PG8_MMA(1, 1, At, B1); PG8_BAR; PG8_SCHED;
            PG8_LDB(B0, 1, 0); PG8_LDB(B1, 1, 1); PG8_SCHED; PG8_LDA(At, 1, 0); PG8_STAGE(PG8_SA(0, 1), a2 + hstep, voffA);
            PG8_WAIT_V(8); PG8_WAIT_L(0); PG8_BAR; PG8_MMA(0, 0, At, B0); PG8_MMA(0, 1, At, B1); PG8_BAR; PG8_SCHED;
            PG8_LDA(At, 1, 1); PG8_STAGE(PG8_SB(1, 0), b3, voffB); PG8_STAGE(PG8_SB(1, 1), b3 + hstep, voffB); PG8_STAGE(PG8_SA(1, 0), a3, voffA);
            PG8_WAIT_V(8); PG8_WAIT_L(0); PG8_BAR; PG8_MMA(1, 0, At, B0); PG8_MMA(1, 1, At, B1); PG8_BAR; PG8_SCHED;
            } else {
            PG8_LDB(B0, 0, 0); PG8_SCHED; PG8_LDA(At, 0, 0); PG8_STAGE(PG8_SA(1, 1), a1 + hstep, voffA);
            PG8_WAIT_L(8); PG8_BAR; PG8_WAIT_L(0); PG8_MMA(0, 0, At, B0); PG8_BAR; PG8_SCHED;
            PG8_LDB(B1, 0, 1); PG8_STAGE(PG8_SB(0, 0), b2, voffB);
            PG8_BAR; PG8_WAIT_L(0); PG8_MMA(0, 1, At, B1); PG8_BAR;
            PG8_LDA(At, 0, 1); PG8_STAGE(PG8_SA(0, 0), a2, voffA);
            PG8_BAR; PG8_WAIT_L(0); PG8_MMA(1, 0, At, B0); PG8_BAR; PG8_SCHED;
            PG8_STAGE(PG8_SB(0, 1), b2 + hstep, voffB);
            PG8_WAIT_V(6); PG8_BAR; PG8_MMA(1, 1, At, B1); PG8_BAR;
            PG8_LDB(B0, 1, 0); PG8_SCHED; PG8_LDA(At, 1, 0); PG8_STAGE(PG8_SA(0, 1), a2 + hstep, voffA);
            PG8_WAIT_L(8); PG8_BAR; PG8_WAIT_L(0); PG8_MMA(0, 0, At, B0); PG8_BAR; PG8_SCHED;
            PG8_LDB(B1, 1, 1); PG8_STAGE(PG8_SB(1, 0), b3, voffB);
            PG8_BAR; PG8_WAIT_L(0); PG8_MMA(0, 1, At, B1); PG8_BAR;
            PG8_LDA(At, 1, 1); PG8_STAGE(PG8_SA(1, 0), a3, voffA);
            PG8_BAR; PG8_WAIT_L(0); PG8_MMA(1, 0, At, B0); PG8_BAR; PG8_SCHED;
            PG8_STAGE(PG8_SB(1, 1), b3 + hstep, voffB);
            PG8_WAIT_V(6); PG8_BAR; PG8_MMA(1, 1, At, B1); PG8_BAR;
            }
        }
        if constexpr (ALIGN_EPI) { if (wr == 0) PG8_BAR; }
        if constexpr (!Epi::AFTER_DRAIN) { E(acc, cur, wr, wc, fr, fq); S.done(cur); }
        if (!has_next) break;
#pragma unroll
        for (int a = 0; a < 2; ++a)
#pragma unroll
            for (int b = 0; b < 2; ++b)
#pragma unroll
                for (int m = 0; m < 4; ++m)
#pragma unroll
                    for (int n = 0; n < 2; ++n) acc[a][b][m][n] = (f32x4){0.f, 0.f, 0.f, 0.f};
        cur = nxt; cA = nA; cB = nB; ++ui;
        if constexpr (ALIGN_EPI) { if (wr == 1) PG8_BAR; }
    }
    PG8_WAIT_V(0);
    if constexpr (!ALIGN_EPI) { if (wr == 0) PG8_BAR; }
    PG8_BAR;
    if constexpr (Epi::AFTER_DRAIN) { E.fused(acc, cur, wr, wc, fr, fq, lds, wid, lane); S.done(cur); }
#undef PG8_SA
#undef PG8_SB
#undef PG8_STAGE
#undef PG8_LDA
#undef PG8_LDB
#undef PG8_MMA
#undef PG8_WAIT_V
#undef PG8_WAIT_L
#undef PG8_BAR
#undef PG8_SCHED
}
}

#ifndef PG8_SP2
#define PG8_SP2 true
#endif
#ifndef PG8_ALIGN
#define PG8_ALIGN true
#endif
#include <hip/hip_bf16.h>
#include <cmath>
namespace attn_body {
using bf16=__hip_bfloat16;
using bf16x8=__attribute__((ext_vector_type(8)))short;
using s16x4=__attribute__((ext_vector_type(4)))short;
using f32x16=__attribute__((ext_vector_type(16)))float;
using u32x4=__attribute__((ext_vector_type(4)))unsigned;
constexpr int D=64,QP=512,OP=1024,KP=64,NKT=130,NKEYS=8208;
constexpr int NW=8,QBLK=32,QB=QBLK*NW,KVBLK=64;
constexpr int ATTN_UNIT_ROWS=QB;
__device__ __forceinline__ int crow(int r,int hi){return (r&3)+8*(r>>2)+4*hi;}
#define SBAR() __builtin_amdgcn_sched_barrier(0)
__device__ __forceinline__ void kmask(f32x16&p0,f32x16&p1,int t,int hi){
  const float NEG=-INFINITY; int kb=64*t+4*hi;
  #pragma unroll
  for(int r=0;r<16;++r){int kv=kb+(r&3)+8*(r>>2); if(kv>=NKEYS)p0[r]=NEG; if(kv+32>=NKEYS)p1[r]=NEG;}
}

constexpr int NSLOT=3, SLOTB=8192;
constexpr int LDS_K=0, LDS_V=NSLOT*SLOTB, LDS_WS=2*NSLOT*SLOTB, LDS_OST=LDS_WS+NW*64*4, LDS_BYTES=LDS_OST+NW*4096;
constexpr float C2=0.125f*1.4426950408889634f;
__device__ __forceinline__ void glds16(const void*gsrc,unsigned lds_dst){unsigned keep;
  asm volatile("s_mov_b32 %0, m0\n\ts_mov_b32 m0, %2\n\ts_nop 0\n\tglobal_load_lds_dwordx4 %1, off\n\ts_mov_b32 m0, %0":"=&s"(keep):"v"(gsrc),"s"(lds_dst):"memory");}
__device__ __forceinline__ float max3f(float a,float b,float c){float r;asm("v_max3_f32 %0, %1, %2, %3":"=v"(r):"v"(a),"v"(b),"v"(c));return r;}
__device__ __forceinline__ float max2f(float a,float b){float r;asm("v_max_f32_e32 %0, %1, %2":"=v"(r):"v"(a),"v"(b));return r;}
__device__ __forceinline__ float fadd_s(float a,float b){float r;asm("v_add_f32_e32 %0, %1, %2":"=v"(r):"v"(a),"v"(b));return r;}
__device__ __forceinline__ float fsub_s(float a,float b){float r;asm("v_sub_f32_e32 %0, %1, %2":"=v"(r):"v"(a),"v"(b));return r;}
typedef float f32x2_t __attribute__((ext_vector_type(2))); typedef __bf16 bf16x2_t __attribute__((ext_vector_type(2)));
__device__ __forceinline__ unsigned cvtpk_s(float lo,float hi){f32x2_t v={lo,hi};bf16x2_t b=__builtin_convertvector(v,bf16x2_t);return __builtin_bit_cast(unsigned,b);}
#define WAIT_BAR(N) asm volatile("s_waitcnt vmcnt(" #N ") lgkmcnt(0)\n\ts_barrier":::"memory")

__device__ __forceinline__ void qkt(f32x16&p0,f32x16&p1,const char*Kslot,const bf16x8*qr,const f32x16&negm,int r32,int hi){
  const char*kb=Kslot+hi*1024+r32*16;
  #pragma unroll
  for(int d0=0;d0<4;++d0){
    const bf16x8 b0=*reinterpret_cast<const bf16x8*>(kb+d0*2048);
    const bf16x8 b1=*reinterpret_cast<const bf16x8*>(kb+d0*2048+512);
    if(d0==0){p0=__builtin_amdgcn_mfma_f32_32x32x16_bf16(b0,qr[0],negm,0,0,0);p1=__builtin_amdgcn_mfma_f32_32x32x16_bf16(b1,qr[0],negm,0,0,0);}
    else{p0=__builtin_amdgcn_mfma_f32_32x32x16_bf16(b0,qr[d0],p0,0,0,0);p1=__builtin_amdgcn_mfma_f32_32x32x16_bf16(b1,qr[d0],p1,0,0,0);}}
}
typedef __attribute__((address_space(3))) const char* lds_cptr;
typedef short v4i16_t __attribute__((ext_vector_type(4)));
__device__ __forceinline__ void kload8(bf16x8*kf,lds_cptr kp){
  kf[0]=*(const __attribute__((address_space(3))) bf16x8*)(kp);      kf[1]=*(const __attribute__((address_space(3))) bf16x8*)(kp+512);
  kf[2]=*(const __attribute__((address_space(3))) bf16x8*)(kp+2048); kf[3]=*(const __attribute__((address_space(3))) bf16x8*)(kp+2560);
  kf[4]=*(const __attribute__((address_space(3))) bf16x8*)(kp+4096); kf[5]=*(const __attribute__((address_space(3))) bf16x8*)(kp+4608);
  kf[6]=*(const __attribute__((address_space(3))) bf16x8*)(kp+6144); kf[7]=*(const __attribute__((address_space(3))) bf16x8*)(kp+6656);
}
__device__ __forceinline__ void kload2(bf16x8*kf,lds_cptr kp,int j){ kf[2*j]=*(const __attribute__((address_space(3))) bf16x8*)(kp+j*2048); kf[2*j+1]=*(const __attribute__((address_space(3))) bf16x8*)(kp+j*2048+512); }
__device__ __forceinline__ s16x4 vtr(lds_cptr p){ return __builtin_bit_cast(s16x4,__builtin_amdgcn_ds_read_tr16_b64_v4i16((__attribute__((address_space(3))) v4i16_t*)p)); }
__device__ __forceinline__ float rowmax(const f32x16&p0,const f32x16&p1){
  float a=max3f(p0[0],p0[1],p1[0]),b=max3f(p0[2],p0[3],p1[1]);a=max3f(a,p1[2],p1[3]);
  #pragma unroll
  for(int r=4;r<16;r+=4){a=max3f(a,p0[r],p0[r+1]);b=max3f(b,p0[r+2],p0[r+3]);a=max3f(a,p1[r],p1[r+1]);b=max3f(b,p1[r+2],p1[r+3]);}
  const float m=max2f(a,b);
  auto rr=__builtin_amdgcn_permlane32_swap(__float_as_uint(m),__float_as_uint(m),false,false);
  return max2f(__uint_as_float(rr[0]),__uint_as_float(rr[1]));
}
__device__ __forceinline__ void pv(f32x16*o,int vb,bf16x8 pa0,bf16x8 pa1,bf16x8 pa2,bf16x8 pa3){
  #pragma unroll
  for(int d0=0;d0<2;++d0){s16x4 lo[4],hi[4];
    #pragma unroll
    for(int ks=0;ks<4;++ks){
      asm volatile("ds_read_b64_tr_b16 %0,%1 offset:%c2":"=&v"(lo[ks]):"v"(vb),"i"(d0*4096+ks*1024):"memory");
      asm volatile("ds_read_b64_tr_b16 %0,%1 offset:%c2":"=&v"(hi[ks]):"v"(vb),"i"(d0*4096+ks*1024+512):"memory");}
    asm volatile("s_waitcnt lgkmcnt(0)":::"memory");SBAR();
    #define PK(k) (bf16x8){lo[k][0],lo[k][1],lo[k][2],lo[k][3],hi[k][0],hi[k][1],hi[k][2],hi[k][3]}
    o[d0]=__builtin_amdgcn_mfma_f32_32x32x16_bf16(pa0,PK(0),o[d0],0,0,0);
    o[d0]=__builtin_amdgcn_mfma_f32_32x32x16_bf16(pa1,PK(1),o[d0],0,0,0);
    o[d0]=__builtin_amdgcn_mfma_f32_32x32x16_bf16(pa2,PK(2),o[d0],0,0,0);
    o[d0]=__builtin_amdgcn_mfma_f32_32x32x16_bf16(pa3,PK(3),o[d0],0,0,0);
    #undef PK
  }
}

#ifndef ATTN_STORE16
#define ATTN_STORE16(p,v) (*(u32x4*)(p)=(v))
#endif
template<int THRL> __device__ __forceinline__ void attn_unit(const bf16*Qu,const bf16*__restrict__ Kh,const bf16*__restrict__ Vh,bf16*Ou,char*shm){
  const int tid=threadIdx.x,lane=tid&63,r32=lane&31,hi=lane>>5; const int wid=__builtin_amdgcn_readfirstlane(tid>>6);
  const bf16*Qw=Qu+(long)(wid*QBLK)*QP;
  const unsigned lds0=(unsigned)(uintptr_t)shm;
  float*wsf=(float*)(shm+LDS_WS)+wid*64;
  const bf16*ksrc=Kh+(long)lane*KP+wid*8;
  const bf16*vsrc=Vh+(long)(16*(wid&3)+(lane>>2))*KP+(wid>>2)*32+(lane&3)*8;
  const unsigned kdst=lds0+LDS_K+wid*1024, vdst=lds0+LDS_V+wid*1024;
  #define DMA_K(t,slot) glds16(ksrc+(long)(t)*KVBLK*KP,(unsigned)__builtin_amdgcn_readfirstlane(kdst+(slot)))
  #define DMA_V(t,slot) glds16(vsrc+(long)(t)*KVBLK*KP,(unsigned)__builtin_amdgcn_readfirstlane(vdst+(slot)))
  const int vb0=(int)(lds0+LDS_V)+((lane>>4)&1)*32+(lane&3)*8+(4*hi+((lane&15)>>2))*64;
  const char*Kbase=shm+LDS_K; bf16x8 kf[8];
  const lds_cptr shm3=(lds_cptr)shm; const lds_cptr kp0=shm3+LDS_K+hi*1024+r32*16; const lds_cptr vp0=shm3+LDS_V+((lane>>4)&1)*32+(lane&3)*8+(4*hi+((lane&15)>>2))*64;
  constexpr int NT=NKT;
  DMA_K(0,0);DMA_V(0,0);DMA_K(1,SLOTB);
  bf16x8 qr[4];
  #pragma unroll
  for(int d0=0;d0<4;++d0)qr[d0]=*reinterpret_cast<const bf16x8*>(&Qw[(long)r32*QP+d0*16+hi*8]);
  float mhat=0.f,l_reg=0.f;f32x16 o[2];o[0]=f32x16{};o[1]=f32x16{};f32x16 negm=f32x16{};asm volatile("":"+v"(negm));
  #define CMASK(P0,P1,t) do{ if((t)>=NT-2) kmask(P0,P1,(t),hi);}while(0)
  bool resc=false;
  #define START(P0,P1) do{ const float rm=rowmax(P0,P1); resc=false; \
    { const float dl=rm; mhat=fadd_s(mhat,dl); \
      _Pragma("unroll") for(int r=0;r<16;++r){P0[r]=fsub_s(P0[r],dl);P1[r]=fsub_s(P1[r],dl);} \
      _Pragma("unroll") for(int r=0;r<16;++r)negm[r]=-mhat; asm volatile("":"+v"(negm)); } \
    _Pragma("unroll") for(int r=0;r<16;++r)P0[r]=__builtin_amdgcn_exp2f(P0[r]); }while(0)
  #define RESC() do{ if(resc){ asm volatile("s_waitcnt lgkmcnt(0)":::"memory"); \
      _Pragma("unroll") for(int d_=0;d_<2;++d_) _Pragma("unroll") for(int r=0;r<16;++r)o[d_][r]*=wsf[crow(r,hi)]; } }while(0)
  f32x16 pA0,pA1,pB0,pB1;
  int sl_prev=0,sl_cur=0,sl_next=SLOTB;
  #define ROT() do{sl_prev=sl_cur;sl_cur=sl_next;sl_next=(sl_next==(NSLOT-1)*SLOTB)?0:sl_next+SLOTB;}while(0)
  DMA_K(2,2*SLOTB);
  WAIT_BAR(3);
  qkt(pA0,pA1,Kbase,qr,negm,r32,hi);asm volatile("s_nop 15\n\ts_nop 7":"+v"(pA0),"+v"(pA1));CMASK(pA0,pA1,0);
  START(pA0,pA1);
  _Pragma("unroll") for(int r=0;r<16;++r)pA1[r]=__builtin_amdgcn_exp2f(pA1[r]);
  WAIT_BAR(0);
  DMA_K(3,0);DMA_V(1,SLOTB);
  ROT();
  kload8(kf,kp0+sl_cur);
  WAIT_BAR(2);
  s16x4 vlo[8],vhi[8]; u32x4 pw0,pw1,pw2,pw3;
  #define PKW(P,B) cvtpk_s(P[B],P[B+1])
  #define PAF(k) __builtin_bit_cast(bf16x8,pw##k)
  #define VFR(i) (bf16x8){vlo[i][0],vlo[i][1],vlo[i][2],vlo[i][3],vhi[i][0],vhi[i][1],vhi[i][2],vhi[i][3]}
  #define PIN(x) asm volatile("":"+v"(x))
  #define MX3(a,b,c) __builtin_fmaxf(__builtin_fmaxf((a),(b)),(c))
  #define GAPA(MF,A0,A1,A2,A3,W0,W1,PW) do{ MF; sacc+=A0; sacc+=A1; sacc+=A2; sacc+=A3; PIN(sacc); W0; W1; PIN(PW); SBAR(); }while(0)
  #define EX(v) __builtin_amdgcn_exp2f(v)
  #define GAPB(MF,X,B) do{ MF; X[B]=EX(X[B]); X[B+1]=EX(X[B+1]); X[B+2]=EX(X[B+2]); X[B+3]=EX(X[B+3]); PIN(X); SBAR(); }while(0)
  #define VRD(i) do{ vlo[i]=vtr(vp_+(((i)>>2)*4096+((i)&3)*1024)); vhi[i]=vtr(vp_+(((i)>>2)*4096+((i)&3)*1024+512)); }while(0)
  #define KRD(G,j) do{ if(G){ kload2(kf,kp0+sl_next,j); SBAR(); } }while(0)
  #define STEP(C0,C1,P0,P1,t,GK,GV,GL) do{ SBAR(); \
    const lds_cptr vp_=vp0+sl_prev; \
    VRD(0); SBAR(); float sacc=(P0[0]+P0[1]); \
    GAPA(C0=__builtin_amdgcn_mfma_f32_32x32x16_bf16(kf[0],qr[0],negm,0,0,0), P0[2],P0[3],P0[4],P0[5],     pw0[0]=PKW(P0,0), pw0[1]=PKW(P0,2), pw0); \
    VRD(4); SBAR(); GAPA(C1=__builtin_amdgcn_mfma_f32_32x32x16_bf16(kf[1],qr[0],negm,0,0,0), P0[6],P0[7],P0[8],P0[9],     pw0[2]=PKW(P0,4), pw0[3]=PKW(P0,6), pw0); \
    VRD(1); SBAR(); GAPA(C0=__builtin_amdgcn_mfma_f32_32x32x16_bf16(kf[2],qr[1],C0,0,0,0),   P0[10],P0[11],P0[12],P0[13], pw1[0]=PKW(P0,8), pw1[1]=PKW(P0,10), pw1); \
    VRD(5); SBAR(); GAPA(C1=__builtin_amdgcn_mfma_f32_32x32x16_bf16(kf[3],qr[1],C1,0,0,0),   P0[14],P0[15],P1[0],P1[1],   pw1[2]=PKW(P0,12),pw1[3]=PKW(P0,14), pw1); \
    VRD(2); SBAR(); GAPA(C0=__builtin_amdgcn_mfma_f32_32x32x16_bf16(kf[4],qr[2],C0,0,0,0),   P1[2],P1[3],P1[4],P1[5],     pw2[0]=PKW(P1,0), pw2[1]=PKW(P1,2), pw2); \
    VRD(6); SBAR(); GAPA(C1=__builtin_amdgcn_mfma_f32_32x32x16_bf16(kf[5],qr[2],C1,0,0,0),   P1[6],P1[7],P1[8],P1[9],     pw2[2]=PKW(P1,4), pw2[3]=PKW(P1,6), pw2); \
    VRD(3); SBAR(); GAPA(C0=__builtin_amdgcn_mfma_f32_32x32x16_bf16(kf[6],qr[3],C0,0,0,0),   P1[10],P1[11],P1[12],P1[13], pw3[0]=PKW(P1,8), pw3[1]=PKW(P1,10), pw3); \
    VRD(7); SBAR(); GAPA(C1=__builtin_amdgcn_mfma_f32_32x32x16_bf16(kf[7],qr[3],C1,0,0,0),   P1[14],P1[15],0.f,0.f,       pw3[2]=PKW(P1,12),pw3[3]=PKW(P1,14), pw3); \
    l_reg+=sacc; \
    if(GK){DMA_K((t)+3,sl_cur);} if(GV){DMA_V((t)+1,sl_next);} \
    CMASK(C0,C1,t); \
    { float a=MX3(C0[0],C0[1],C1[0]),b=MX3(C0[2],C0[3],C1[1]); a=MX3(a,C1[2],C1[3]); \
      _Pragma("unroll") for(int r=4;r<16;r+=4){a=MX3(a,C0[r],C0[r+1]);b=MX3(b,C0[r+2],C0[r+3]);a=MX3(a,C1[r],C1[r+1]);b=MX3(b,C1[r+2],C1[r+3]);} \
      float rm=__builtin_fmaxf(a,b); { auto rr=__builtin_amdgcn_permlane32_swap(__float_as_uint(rm),__float_as_uint(rm),false,false); rm=__builtin_fmaxf(__uint_as_float(rr[0]),__uint_as_float(rr[1])); } \
      resc=false; \
      if(__builtin_expect(__any(rm>(float)THRL),0)){ const float dl=__builtin_fmaxf(rm,0.f); mhat+=dl; \
        _Pragma("unroll") for(int r=0;r<16;++r){C0[r]-=dl;C1[r]-=dl;} \
        _Pragma("unroll") for(int r=0;r<16;++r)negm[r]=-mhat; asm volatile("":"+v"(negm)); \
        const float f=__builtin_amdgcn_exp2f(-dl); l_reg*=f; if(hi==0)wsf[r32]=f; resc=true; } } \
    SBAR(); \
    GAPB(o[0]=__builtin_amdgcn_mfma_f32_32x32x16_bf16(PAF(0),VFR(0),o[0],0,0,0), C0,0); \
    GAPB(o[1]=__builtin_amdgcn_mfma_f32_32x32x16_bf16(PAF(0),VFR(4),o[1],0,0,0), C0,4); \
    KRD(GL,0); GAPB(o[0]=__builtin_amdgcn_mfma_f32_32x32x16_bf16(PAF(1),VFR(1),o[0],0,0,0), C0,8); \
    KRD(GL,1); GAPB(o[1]=__builtin_amdgcn_mfma_f32_32x32x16_bf16(PAF(1),VFR(5),o[1],0,0,0), C0,12); \
    KRD(GL,2); GAPB(o[0]=__builtin_amdgcn_mfma_f32_32x32x16_bf16(PAF(2),VFR(2),o[0],0,0,0), C1,0); \
    KRD(GL,3); GAPB(o[1]=__builtin_amdgcn_mfma_f32_32x32x16_bf16(PAF(2),VFR(6),o[1],0,0,0), C1,4); \
    GAPB(o[0]=__builtin_amdgcn_mfma_f32_32x32x16_bf16(PAF(3),VFR(3),o[0],0,0,0), C1,8); \
    GAPB(o[1]=__builtin_amdgcn_mfma_f32_32x32x16_bf16(PAF(3),VFR(7),o[1],0,0,0), C1,12); \
    }while(0)
  int t=1;
  #undef CMASK
  #define CMASK(P0,P1,t) do{}while(0)
  for(;t+5<NT;t+=2){
    STEP(pB0,pB1,pA0,pA1,t,true,true,true);     WAIT_BAR(2); RESC(); ROT();
    STEP(pA0,pA1,pB0,pB1,t+1,true,true,true);   WAIT_BAR(2); RESC(); ROT();
  }
  #undef CMASK
  #define CMASK(P0,P1,t) do{ if((t)>=NT-2) kmask(P0,P1,(t),hi);}while(0)
  #define ENDW(tt) do{ if((tt)+3<NT){WAIT_BAR(2);} else if((tt)+2<NT){WAIT_BAR(1);} else {WAIT_BAR(0);} }while(0)
  for(;t+1<NT;t+=2){
    STEP(pB0,pB1,pA0,pA1,t,(t+3<NT),(t+1<NT),(t+1<NT));       ENDW(t);   RESC(); ROT();
    STEP(pA0,pA1,pB0,pB1,t+1,(t+4<NT),(t+2<NT),(t+2<NT));     ENDW(t+1); RESC(); ROT();
  }
  STEP(pB0,pB1,pA0,pA1,NT-1,false,false,false); RESC();
  { float sacc=pB0[0]+pB0[1]; _Pragma("unroll") for(int r=2;r<16;++r)sacc+=pB0[r]; _Pragma("unroll") for(int r=0;r<16;++r)sacc+=pB1[r]; l_reg+=sacc;
    pw0=(u32x4){PKW(pB0,0),PKW(pB0,2),PKW(pB0,4),PKW(pB0,6)};pw1=(u32x4){PKW(pB0,8),PKW(pB0,10),PKW(pB0,12),PKW(pB0,14)};pw2=(u32x4){PKW(pB1,0),PKW(pB1,2),PKW(pB1,4),PKW(pB1,6)};pw3=(u32x4){PKW(pB1,8),PKW(pB1,10),PKW(pB1,12),PKW(pB1,14)};
    SBAR(); pv(o,vb0+sl_cur,PAF(0),PAF(1),PAF(2),PAF(3)); }
  #undef PKW
  #undef PAF
  #undef VFR
  #undef PIN
  #undef MX3
  #undef GAPA
  #undef GAPB
  #undef EX
  #undef VRD
  #undef KRD
  #undef STEP
  #undef ENDW
  {auto rr=__builtin_amdgcn_permlane32_swap(__float_as_uint(l_reg),__float_as_uint(l_reg),false,false);l_reg=__uint_as_float(rr[0])+__uint_as_float(rr[1]);}
  if(hi==0)wsf[32+r32]=l_reg;asm volatile("s_waitcnt lgkmcnt(0)":::"memory");
  float rli[16];
  #pragma unroll
  for(int r=0;r<16;++r)rli[r]=__builtin_amdgcn_rcpf(wsf[32+crow(r,hi)]);
  bf16*Ow=Ou+(long)(wid*QBLK)*OP;
  { bf16*stg=(bf16*)(shm+LDS_OST)+wid*2048;
    #pragma unroll
    for(int r=0;r<16;++r){const int orow=crow(r,hi);
      #pragma unroll
      for(int d0=0;d0<2;++d0)stg[orow*64+d0*32+r32]=__float2bfloat16(o[d0][r]*rli[r]);}
    asm volatile("s_waitcnt lgkmcnt(0)":::"memory");
    #pragma unroll
    for(int i=0;i<4;++i){const int row=i*8+(lane>>3),ch=lane&7; const u32x4 v=*(const u32x4*)(stg+row*64+ch*8); ATTN_STORE16(Ow+(long)row*OP+ch*8,v);} }
  asm volatile("s_waitcnt lgkmcnt(0)\n\ts_barrier":::"memory");
  #undef DMA_K
  #undef DMA_V
  #undef CMASK
  #undef START
  #undef RESC
  #undef ROT
}
constexpr int ATTN_LDS_BYTES=LDS_BYTES;
#undef SBAR
#undef WAIT_BAR
}
#include <hip/hip_cooperative_groups.h>
namespace cg = cooperative_groups;
#define GAS __attribute__((address_space(1)))
#define LAS __attribute__((address_space(3)))
typedef unsigned short bf16;
typedef unsigned v4u __attribute__((ext_vector_type(4)));
typedef unsigned v2u __attribute__((ext_vector_type(2)));
typedef float f32x4 __attribute__((ext_vector_type(4)));
typedef short bf16x8 __attribute__((ext_vector_type(8)));

#ifndef ONE_LAUNCH
#define ONE_LAUNCH 1
#endif
constexpr int NWAVES = 8, NTHR = 512, NPHASE = 8;
constexpr int NB = 8, SEQ = 8192, NMETA = 16, LT = 8208, DM = 1024, MTOK = NB * LT, MP = 65792, MR = NB * SEQ, NIN = 3072, FF = 4096;
constexpr int LKP = 8320, NCH = 129, DNR = 8256;
constexpr float EPS = 1e-6f;
constexpr size_t MiB = 1u << 20;
constexpr size_t WS_CTL = 0, CTL_ZERO_BYTES = 1 * MiB;
constexpr size_t WS_WIN = 2 * MiB, WS_WOUT = 8 * MiB, WS_WUP = 10 * MiB, WS_WDN = 18 * MiB;
constexpr size_t WS_XN = 32 * MiB;
constexpr size_t WS_QN = WS_XN, WS_KN = WS_XN + (size_t)NB * DNR * 512 * 2;
constexpr size_t WS_DQKV = 162 * MiB;
constexpr size_t WS_CAT = WS_DQKV, WS_OF = WS_DQKV + 128 * MiB;
constexpr size_t WS_DZ = 355 * MiB;
constexpr size_t WS_AQKV = 420 * MiB;
constexpr size_t WS_OB = WS_AQKV;
constexpr size_t WS_BA = 517 * MiB;
constexpr size_t WS_Q = 522 * MiB;
constexpr size_t WS_KB = 586 * MiB, WS_VB = 603 * MiB;
constexpr size_t WS_CH = 620 * MiB;
constexpr size_t CH_BYTES = 41728, CH_W = 16384, CH_QK = 32768, CH_G = 40960;
constexpr size_t WS_MIX = 32 * MiB;
constexpr size_t WS_HID = 484 * MiB;
constexpr size_t WS_END = 996 * MiB;
static_assert(WS_KN + (size_t)NB * DNR * 512 * 2 <= WS_DQKV && WS_DQKV + (size_t)MP * 1536 * 2 <= WS_DZ && WS_DZ + (size_t)MP * 512 * 2 <= WS_AQKV && WS_AQKV + (size_t)MP * 768 * 2 <= WS_BA, "ws map 1");
static_assert(WS_BA + (size_t)MP * 16 * 4 <= WS_Q && WS_Q + (size_t)MR * 512 * 2 <= WS_KB && WS_KB + (size_t)NB * 2 * LKP * 64 * 2 <= WS_VB && WS_VB + (size_t)NB * 2 * LKP * 64 * 2 <= WS_CH, "ws map 2");
static_assert(WS_CH + CH_BYTES * (size_t)(NB * 2 * NCH * 4) <= WS_END && WS_OF + (size_t)MR * 512 * 2 <= WS_DZ && WS_OB + (size_t)MR * 512 * 2 <= WS_HID && WS_HID + (size_t)MR * FF * 2 <= WS_END && WS_MIX + (size_t)MR * DM * 2 <= WS_DQKV, "ws map 3");
constexpr int LDS_BYTES = 155648 + 256;
constexpr int XBST_OFF = 155648;
constexpr int QSLOT_OFF = 90112;
constexpr int P2_KN = 0, P2_QN = 17408, P2_VV = 34816, P2_RB = 52224, P2_KK = P2_RB, P2_QK = P2_RB + 16640, P2_AS = P2_RB + 33280, P2_CW = 118272, P2_SC = 125952;
constexpr int SC_ST = 0, SC_VT = 34816, SC_W = 53248, SC_Q = 70656, SC_KT = 88064, SC_QK = 106496, SC_U = 115712, SC_O = 134144;

typedef float f32x2_c __attribute__((ext_vector_type(2))); typedef __bf16 bf16x2_c __attribute__((ext_vector_type(2)));
__device__ __forceinline__ unsigned pk2(float lo, float hi) { const f32x2_c v = {lo, hi}; return __builtin_bit_cast(unsigned, __builtin_convertvector(v, bf16x2_c)); }
__device__ __forceinline__ unsigned f2bf(float f) { return pk2(f, 0.f) & 0xffffu; }
__device__ __forceinline__ float bf2f(unsigned short u) { return __builtin_bit_cast(float, (unsigned)u << 16); }
__device__ __forceinline__ void unpack8(const v4u v, float* o) {
#pragma unroll
    for (int i = 0; i < 4; ++i) { o[2 * i] = __builtin_bit_cast(float, v[i] << 16); o[2 * i + 1] = __builtin_bit_cast(float, v[i] & 0xffff0000u); }
}
__device__ __forceinline__ v4u pack8(const float* o) { v4u v; v.x = pk2(o[0], o[1]); v.y = pk2(o[2], o[3]); v.z = pk2(o[4], o[5]); v.w = pk2(o[6], o[7]); return v; }
__device__ __forceinline__ unsigned xcc_id() { return (unsigned)__builtin_amdgcn_s_getreg((3 << 11) | 20) & 0xFu; }
__device__ __forceinline__ float wave_sum(float v) {
#pragma unroll
    for (int o = 1; o < 64; o <<= 1) v += __shfl_xor(v, o);
    return v;
}
__device__ __forceinline__ float bperm_f(int srclane, float v) { return __builtin_bit_cast(float, __builtin_amdgcn_ds_bpermute(srclane << 2, __builtin_bit_cast(int, v))); }
__device__ __forceinline__ float silu_f(float y) { return y * __builtin_amdgcn_rcpf(1.f + __expf(-y)); }

struct Args { const float* in[16]; float* out; unsigned char* ws; int ph_lo, ph_hi; };

template <int MODE> __device__ __forceinline__ void p0_transpose_item(const float* W, int K, int Nsrc, int Ndst, bf16* WT, LAS float* scr, int item, int lane) {
    const int nblk = Ndst / 32, kb = item / nblk, nb = item % nblk, k0 = 64 * kb, n0 = 32 * nb;
    const int c4 = (lane & 7) * 4, nd = n0 + c4;
    const int src = MODE == 0 ? nd : (nd < 2048 ? nd : (nd < 2816 ? nd + 16 : (nd < 2832 ? nd - 2816 + 2048 : -1)));
    const int srcc = src >= 0 ? src : 0;
#pragma unroll
    for (int i = 0; i < 8; ++i) { const int kk = 8 * i + (lane >> 3); f32x4 v = *(const f32x4*)(W + (size_t)(k0 + kk) * Nsrc + srcc); if (src < 0) v = (f32x4){0.f, 0.f, 0.f, 0.f};
        LAS float* d = scr + kk * 33 + c4; d[0] = v[0]; d[1] = v[1]; d[2] = v[2]; d[3] = v[3]; }
    asm volatile("s_waitcnt lgkmcnt(0)" ::: "memory");
    const int c = lane & 7;
#pragma unroll
    for (int j = 0; j < 4; ++j) { const int n = (lane >> 3) + 8 * j; const LAS float* s = scr + (8 * c) * 33 + n;
        v4u o; o.x = pk2(s[0 * 33], s[1 * 33]); o.y = pk2(s[2 * 33], s[3 * 33]); o.z = pk2(s[4 * 33], s[5 * 33]); o.w = pk2(s[6 * 33], s[7 * 33]);
        *(v4u*)(WT + (size_t)(n0 + n) * K + k0 + 8 * c) = o; }
    asm volatile("s_waitcnt lgkmcnt(0)" ::: "memory");
}
__device__ __forceinline__ void rms_row_to_bf16(const float* xrow, const float* w, bf16* orow, int lane) {
    const f32x4* xr = (const f32x4*)xrow + lane; const f32x4* wr = (const f32x4*)w + lane;
    f32x4 v[4]; float s = 0.f;
#pragma unroll
    for (int j = 0; j < 4; ++j) { v[j] = xr[64 * j]; s += (v[j].x * v[j].x + v[j].y * v[j].y) + (v[j].z * v[j].z + v[j].w * v[j].w); }
    const float rs = __builtin_amdgcn_rsqf(wave_sum(s) * (1.f / DM) + EPS);
    v2u* o8 = (v2u*)orow + lane;
#pragma unroll
    for (int j = 0; j < 4; ++j) { const f32x4 ww = wr[64 * j]; v2u o; o.x = pk2(v[j].x * rs * ww.x, v[j].y * rs * ww.y); o.y = pk2(v[j].z * rs * ww.z, v[j].w * rs * ww.w); o8[64 * j] = o; }
}
constexpr int ROPE_OFF = 131072;
__device__ __forceinline__ void attn_prep_row(const v4u qd, const v4u kd, const LAS float* rope, const float* qw, const float* kw, bf16* Q, bf16* KB, bf16* VB, int b, int t, int lane) {
    if (t >= LT) {
        if (lane < 32) { const int l = lane & 15, kvh = l >> 3, sub = l & 7; bf16* dst = (lane < 16 ? KB : VB) + ((size_t)(b * 2 + kvh) * LKP + t) * 64 + sub * 8; *(v4u*)dst = (v4u){0u, 0u, 0u, 0u}; }
        return;
    }
    const bool real = t >= NMETA; const int s = real ? t - NMETA : 0;
    const int sub = lane & 7, axis = sub >> 2, half = (sub >> 1) & 1, f0 = (sub & 1) * 8;
    const int pos = axis == 0 ? (s >> 6) : (s & 63);
    float cs[8], sn[8];
    { const f32x4 c0 = *(const LAS f32x4*)(rope + pos * 16 + f0), c1 = *(const LAS f32x4*)(rope + pos * 16 + f0 + 4), s0 = *(const LAS f32x4*)(rope + 2048 + pos * 16 + f0), s1 = *(const LAS f32x4*)(rope + 2048 + pos * 16 + f0 + 4);
#pragma unroll
      for (int e = 0; e < 4; ++e) { cs[e] = real ? c0[e] : 1.f; cs[4 + e] = real ? c1[e] : 1.f; sn[e] = real ? s0[e] : 0.f; sn[4 + e] = real ? s1[e] : 0.f; } }
    { float q[8]; unpack8(qd, q); float ss = 0.f;
#pragma unroll
      for (int e = 0; e < 8; ++e) ss += q[e] * q[e];
      ss += __shfl_xor(ss, 1); ss += __shfl_xor(ss, 2); ss += __shfl_xor(ss, 4);
      const float rs = __builtin_amdgcn_rsqf(ss * (1.f / 64.f) + EPS); float o[8];
#pragma unroll
      for (int e = 0; e < 8; ++e) q[e] = q[e] * rs * qw[sub * 8 + e];
#pragma unroll
      for (int e = 0; e < 8; ++e) { const float pr = __shfl_xor(q[e], 2); o[e] = (half == 0 ? q[e] * cs[e] - pr * sn[e] : q[e] * cs[e] + pr * sn[e]) * attn_body::C2; }
      if (real) *(v4u*)(Q + ((size_t)(b * SEQ + s)) * 512 + lane * 8) = pack8(o); }
    { const int l = lane & 15, kvh = l >> 3; float k[8]; unpack8(kd, k); float ss = 0.f;
#pragma unroll
      for (int e = 0; e < 8; ++e) ss += k[e] * k[e];
      ss += __shfl_xor(ss, 1); ss += __shfl_xor(ss, 2); ss += __shfl_xor(ss, 4);
      const float rs = __builtin_amdgcn_rsqf(ss * (1.f / 64.f) + EPS); float o[8];
#pragma unroll
      for (int e = 0; e < 8; ++e) k[e] = k[e] * rs * kw[sub * 8 + e];
#pragma unroll
      for (int e = 0; e < 8; ++e) { const float pr = __shfl_xor(k[e], 2); o[e] = half == 0 ? k[e] * cs[e] - pr * sn[e] : k[e] * cs[e] + pr * sn[e]; }
      if (lane < 16) *(v4u*)(KB + ((size_t)(b * 2 + kvh) * LKP + t) * 64 + sub * 8) = pack8(o);
      else if (lane < 32) *(v4u*)(VB + ((size_t)(b * 2 + kvh) * LKP + t) * 64 + sub * 8) = kd; }
}

#define DN_ISSUE(item_, rawv, cwv, pbb, paa, td, ln) do { \
    const int h_ = (item_) & 3, tc_ = ((item_) >> 2) % NCH, b_ = (item_) / (4 * NCH), t0_ = 64 * tc_ - 48; \
    pbb = 0.f; paa = 0.f; \
    if (wave < 2) { const int dir_ = wave; const bool rev_ = dir_ && tc_ > 0; const int j_ = rev_ ? 63 - (ln) : (ln), t_ = t0_ + j_, tq_ = t_ < 0 ? 0 : t_; \
        const float* ba_ = BA + (size_t)(b_ * LT + tq_) * 16; const float vb_ = ba_[dir_ * 4 + h_], va_ = ba_[8 + dir_ * 4 + h_]; pbb = t_ >= 0 ? vb_ : 0.f; paa = t_ >= 0 ? va_ : 0.f; } \
      \
    _Pragma("unroll") for (int e_ = 0; e_ < 4; ++e_) { const int i_ = (td) + NTHR * e_, ic_ = i_ < 5 * 384 ? i_ : 5 * 384 - 1; const int w_ = ic_ / 384, c_ = ic_ % 384, sec_ = c_ >> 7; cwv[e_] = conv_w[w_ * 1536 + sec_ * 512 + h_ * 128 + (c_ & 127)]; } \
    _Pragma("unroll") for (int e_ = 0; e_ < 7; ++e_) { const int i_ = (td) + NTHR * e_, ic_ = i_ < 68 * 48 ? i_ : 68 * 48 - 1, rr_ = ic_ / 48, ck_ = ic_ % 48, sec_ = ck_ >> 4, t_ = t0_ - 2 + rr_; \
        const int tq_ = t_ < 0 ? 0 : (t_ >= LT ? LT - 1 : t_); const v4u v_ = *(const v4u*)(DQKV + (size_t)(b_ * LT + tq_) * 1536 + sec_ * 512 + h_ * 128 + (ck_ & 15) * 8); \
        const bool ok_ = (t_ == tq_); rawv[e_].x = ok_ ? v_.x : 0u; rawv[e_].y = ok_ ? v_.y : 0u; rawv[e_].z = ok_ ? v_.z : 0u; rawv[e_].w = ok_ ? v_.w : 0u; } } while (0)
__device__ __forceinline__ void dn_prep_item(const Args& A, LAS unsigned char* lds, int item, int next_item, v4u (&rawv)[7], float (&cwv)[4], float& pbb, float& paa, int tid, int wave, int lane) {
    unsigned char* ws = A.ws;
    int ln = lane, td = tid; asm volatile("" : "+v"(ln), "+v"(td));
    const bf16* DQKV = (const bf16*)(ws + WS_DQKV); const float* BA = (const float*)(ws + WS_BA);
    bf16* QN = (bf16*)(ws + WS_QN); bf16* KN = (bf16*)(ws + WS_KN);
    const float* conv_w = A.in[3]; const float* a_log = A.in[4]; const float* dt_bias = A.in[5];
    const int h = item & 3, tc = (item >> 2) % NCH, b = item / (4 * NCH);
    const int t0 = 64 * tc - 48;
    LAS bf16* KNs = (LAS bf16*)(lds + P2_KN); LAS bf16* QNs = (LAS bf16*)(lds + P2_QN); LAS bf16* VVs = (LAS bf16*)(lds + P2_VV);
    LAS bf16* raw = (LAS bf16*)(lds + P2_RB); LAS float* cw = (LAS float*)(lds + P2_CW);
    LAS float* KKs = (LAS float*)(lds + P2_KK); LAS float* QKs = (LAS float*)(lds + P2_QK);
    LAS float* gcS = (LAS float*)(lds + P2_SC); LAS float* betaS = gcS + 128; LAS float* egS = gcS + 256;
    DN_ISSUE(item, rawv, cwv, pbb, paa, td, ln);
    const float cbb = pbb, caa = paa;
#pragma unroll
    for (int e = 0; e < 4; ++e) { const int i = td + NTHR * e; if (i < 5 * 384) cw[i] = cwv[e]; }
#pragma unroll
    for (int e = 0; e < 7; ++e) { const int i = td + NTHR * e, rr = i / 48, ck = i % 48; if (i < 68 * 48) *(LAS v4u*)(raw + rr * 392 + ck * 8) = rawv[e]; }
    __syncthreads();
    { v4u rwv[2][6]; f32x4 cvv[2][5][2];
#define CONV_LOAD(e_, S_) do { const int idx_ = td + NTHR * (e_), jp_ = idx_ / 48, ck_ = idx_ - 48 * jp_; \
        _Pragma("unroll") for (int w_ = 0; w_ < 5; ++w_) { cvv[S_][w_][0] = *(const LAS f32x4*)(cw + w_ * 384 + ck_ * 8); cvv[S_][w_][1] = *(const LAS f32x4*)(cw + w_ * 384 + ck_ * 8 + 4); } \
        _Pragma("unroll") for (int r_ = 0; r_ < 6; ++r_) rwv[S_][r_] = *(const LAS v4u*)(raw + (2 * jp_ + r_) * 392 + ck_ * 8); } while (0)
      CONV_LOAD(0, 0);
#pragma unroll
      for (int e = 0; e < 3; ++e) { const int idx = td + NTHR * e, jp = idx / 48, ck = idx - 48 * jp, sec = ck >> 4, c16 = ck & 15, j0 = 2 * jp;
        if (e == 0) CONV_LOAD(1, 1); else if (e == 1) CONV_LOAD(2, 0);
        float y[2][8];
#pragma unroll
        for (int k = 0; k < 8; ++k) { y[0][k] = 0.f; y[1][k] = 0.f; }
#pragma unroll
        for (int r = 0; r < 6; ++r) { float x[8]; unpack8(rwv[e & 1][r], x);
            if (r <= 4) {
#pragma unroll
                for (int k = 0; k < 4; ++k) { y[0][k] += x[k] * cvv[e & 1][r][0][k]; y[0][4 + k] += x[4 + k] * cvv[e & 1][r][1][k]; } }
            if (r >= 1) {
#pragma unroll
                for (int k = 0; k < 4; ++k) { y[1][k] += x[k] * cvv[e & 1][r - 1][0][k]; y[1][4 + k] += x[4 + k] * cvv[e & 1][r - 1][1][k]; } } }
#pragma unroll
        for (int u = 0; u < 2; ++u) { const int j = j0 + u;
            const float vm = (t0 + j) >= 0 ? 1.f : 0.f; float ss = 0.f;
#pragma unroll
            for (int k = 0; k < 8; ++k) { y[u][k] = y[u][k] * __builtin_amdgcn_rcpf(1.f + __expf(-y[u][k])) * vm; ss += y[u][k] * y[u][k]; }
            ss += bperm_f(ln ^ 1, ss); ss += bperm_f(ln ^ 2, ss); ss += bperm_f(ln ^ 4, ss); ss += bperm_f(ln ^ 8, ss);
            const float rq = __builtin_amdgcn_rsqf(ss + EPS); const float sc = sec == 2 ? 1.f : (sec == 0 ? 0.08838834764831845f * rq : rq);
#pragma unroll
            for (int k = 0; k < 8; ++k) y[u][k] *= sc;
            const v4u o = pack8(y[u]);
            LAS bf16* dl = (sec == 0 ? QNs : (sec == 1 ? KNs : VVs)) + j * 136 + c16 * 8; *(LAS v4u*)dl = o;
            if (sec < 2) *(v4u*)((sec == 0 ? QN : KN) + ((size_t)b * DNR + 64 * tc + j) * 512 + h * 128 + c16 * 8) = o; } }
#undef CONV_LOAD
    }
    __syncthreads();
    { const int fr = ln & 15, fq = ln >> 4, which = wave >> 2, ti = wave & 3;
      const LAS bf16* Ap = (which ? QNs : KNs) + (ti * 16 + fr) * 136 + fq * 8;
      bf16x8 af[4], bq[4][4];
#pragma unroll
      for (int ks = 0; ks < 4; ++ks) af[ks] = *(const LAS bf16x8*)(Ap + ks * 32);
#pragma unroll
      for (int tj = 0; tj < 4; ++tj) {
#pragma unroll
          for (int ks = 0; ks < 4; ++ks) bq[tj][ks] = *(const LAS bf16x8*)(KNs + (tj * 16 + fr) * 136 + fq * 8 + ks * 32); }
      f32x4 acc[4];
#pragma unroll
      for (int tj = 0; tj < 4; ++tj) acc[tj] = (f32x4){0.f, 0.f, 0.f, 0.f};
#pragma unroll
      for (int ks = 0; ks < 4; ++ks) {
#pragma unroll
          for (int tj = 0; tj < 4; ++tj) acc[tj] = __builtin_amdgcn_mfma_f32_16x16x32_bf16(af[ks], bq[tj][ks], acc[tj], 0, 0, 0); }
      LAS float* dst = which ? QKs : KKs;
#pragma unroll
      for (int tj = 0; tj < 4; ++tj) {
#pragma unroll
          for (int r = 0; r < 4; ++r) dst[(ti * 16 + 4 * fq + r) * 65 + tj * 16 + fr] = acc[tj][r]; } }
    if (wave < 2) { const int dir = wave, i = ln; const bool rev = dir && tc > 0; const int j = rev ? 63 - i : i, t = t0 + j;
        float beta = 0.f, g = 0.f;
        if (t >= 0) { const float bb = cbb, aa = caa;
            beta = 1.f / (1.f + expf(-bb)); const float x = aa + dt_bias[dir * 4 + h]; const float sp = x > 20.f ? x : log1pf(expf(x)); g = -expf(a_log[dir * 4 + h]) * sp; }
        float gc = g;
#pragma unroll
        for (int o = 1; o < 64; o <<= 1) { const float v = bperm_f(ln - o, gc); if (ln >= o) gc += v; }
        const float gl = bperm_f(63, gc);
        const float eg_ = __expf(gc);
        gcS[dir * 64 + i] = gc; betaS[dir * 64 + i] = beta; egS[dir * 64 + i] = eg_ * beta;
        float* G = (float*)(ws + WS_CH + CH_BYTES * (size_t)((((b * 2 + dir) * NCH + tc) * 4) + h) + CH_G);
        G[j] = eg_; G[64 + j] = __expf(gl - gc); if (i == 0) G[128] = __expf(gl); }
    __syncthreads();
    const int dir = td >> 8; const bool rev = dir && tc > 0;
    unsigned char* chunk = ws + WS_CH + CH_BYTES * (size_t)((((b * 2 + dir) * NCH + tc) * 4) + h);
    LAS float* As = (LAS float*)(lds + P2_AS) + dir * 4096;
    { LAS bf16* QKo = (LAS bf16*)(lds + P2_QN) + dir * 4096;
      const int ip = td & 63, i0_ = (td & 255) >> 6, jp = rev ? 63 - ip : ip;
      const float gp = gcS[dir * 64 + ip];
      float kkv[16], qkv[16], giv[16], biv[16];
#pragma unroll
      for (int e = 0; e < 16; ++e) { const int i = i0_ + 4 * e, j = rev ? 63 - i : i;
          kkv[e] = KKs[j * 65 + jp]; qkv[e] = QKs[j * 65 + jp]; giv[e] = gcS[dir * 64 + i]; biv[e] = betaS[dir * 64 + i]; }
#pragma unroll
      for (int e = 0; e < 16; ++e) { const int i = i0_ + 4 * e, j = rev ? 63 - i : i;
          const float dec = __expf(fminf(giv[e] - gp, 0.f));
          As[i * 64 + ip] = ip < i ? kkv[e] * dec * biv[e] : 0.f;
          QKo[j * 64 + jp] = (bf16)f2bf(ip <= i ? qkv[e] * dec : 0.f); } }
    __syncthreads();
    { unsigned char* cb = ws + WS_CH + CH_BYTES * (size_t)((((b * 2) * NCH + tc) * 4) + h);
#pragma unroll
      for (int e = 0; e < 2; ++e) { const int id = td + NTHR * e, d_ = id >> 9, rest = id & 511, row = rest >> 3, c8 = rest & 7;
          *(v4u*)(cb + (size_t)d_ * (CH_BYTES * NCH * 4) + CH_QK + row * 128 + c8 * 16) = *(const LAS v4u*)(lds + P2_QN + d_ * 8192 + row * 128 + c8 * 16); } }
    { typedef float f32x2 __attribute__((ext_vector_type(2)));
      const int col = td & 255; const bool isU = col < 128; const LAS bf16* src = isU ? VVs + col : KNs + (col - 128);
      const int jb = rev ? 63 : 0, js = rev ? -1 : 1;
      f32x2 x2[32];
      { const LAS bf16* sp = src + jb * 136; const int sstep = js * 136; const LAS float* scp = (isU ? betaS : egS) + dir * 64; asm volatile("" : "+v"(scp));
#pragma unroll
      for (int i = 0; i < 64; ++i) { x2[i >> 1][i & 1] = bf2f(*sp) * scp[i]; sp += sstep; asm volatile("" : "+v"(sp)); if ((i & 7) == 7) { asm volatile("" : "+v"(x2[i >> 1]) :: "memory"); __builtin_amdgcn_sched_barrier(0); } } }
      __syncthreads();
#pragma unroll
      for (int i = 1; i < 64; ++i) {
          f32x2 a01 = (f32x2){0.f, 0.f}, a23 = (f32x2){0.f, 0.f};
#pragma unroll
          for (int q = 0; 4 * q < i; ++q) { const f32x4 a = *(const LAS f32x4*)(As + i * 64 + 4 * q);
              a01 += (f32x2){a[0], a[1]} * x2[2 * q]; a23 += (f32x2){a[2], a[3]} * x2[2 * q + 1]; }
          const f32x2 t = a01 + a23; x2[i >> 1][i & 1] -= (t.x + t.y); asm volatile("" : "+v"(x2[i >> 1])); }
      { LAS bf16* xp = (LAS bf16*)lds + dir * 16384 + jb * 256 + col; const int xstep = js * 256;
#pragma unroll
      for (int i = 0; i < 64; ++i) { *xp = (bf16)f2bf(x2[i >> 1][i & 1]); xp += xstep; asm volatile("" : "+v"(xp)); } } }
    __syncthreads();
    { unsigned char* cb = ws + WS_CH + CH_BYTES * (size_t)((((b * 2) * NCH + tc) * 4) + h); int tl = td; asm volatile("" : "+v"(tl));
#pragma unroll
      for (int e = 0; e < 8; ++e) { const int id = tl + NTHR * e, d_ = id >> 11, rest = id & 2047, row = rest >> 5, c = rest & 31;
          *(v4u*)(cb + (size_t)d_ * (CH_BYTES * NCH * 4) + (c < 16 ? 0 : CH_W) + row * 256 + (c & 15) * 16) = *(const LAS v4u*)(lds + d_ * 32768 + row * 512 + c * 16); } }
    __syncthreads();
}

__device__ __forceinline__ void dn_scan(const Args& A, LAS unsigned char* lds, int chain, int tid, int wave, int lane) {
    unsigned char* ws = A.ws;
    const int b = chain >> 3, dir = (chain >> 2) & 1, h = chain & 3;
    const bf16* QN = (const bf16*)(ws + WS_QN); const bf16* KN = (const bf16*)(ws + WS_KN);
    bf16* Od = (bf16*)(ws + (dir ? WS_OB : WS_OF));
    LAS bf16* St = (LAS bf16*)(lds + SC_ST); LAS bf16* VT = (LAS bf16*)(lds + SC_VT); LAS bf16* Ws = (LAS bf16*)(lds + SC_W); LAS bf16* Qs = (LAS bf16*)(lds + SC_Q);
    LAS bf16* KT = (LAS bf16*)(lds + SC_KT); LAS bf16* QKs = (LAS bf16*)(lds + SC_QK); LAS bf16* Us = (LAS bf16*)(lds + SC_U); LAS bf16* Os = (LAS bf16*)(lds + SC_O);
    const int fr = lane & 15, fq = lane >> 4, vrow = 16 * wave + fr;
    f32x4 S[8];
#pragma unroll
    for (int m = 0; m < 8; ++m) S[m] = (f32x4){0.f, 0.f, 0.f, 0.f};
#pragma unroll
    for (int q = 0; q < 4; ++q) *(LAS v4u*)(St + vrow * 136 + fq * 32 + q * 8) = (v4u){0u, 0u, 0u, 0u};
    v4u rU0[2], rW0[2], rQ0[2], rK0[2], rQK0; float g10[2], g20[2], glp0;
    v4u rU1[2], rW1[2], rQ1[2], rK1[2], rQK1; float g11[2], g21[2], glp1;
#define SC_PREFETCH(s_, X) do { const int tc_ = (dir == 0 || (s_) == 0) ? (s_) : NCH - (s_); \
        const unsigned char* ck_ = ws + WS_CH + CH_BYTES * (size_t)((((b * 2 + dir) * NCH + tc_) * 4) + h); const float* G_ = (const float*)(ck_ + CH_G); \
        _Pragma("unroll") for (int i_ = 0; i_ < 2; ++i_) { const int id_ = tid + NTHR * i_, row_ = id_ >> 4, c16_ = id_ & 15; \
            rU##X[i_] = *(const v4u*)(ck_ + row_ * 256 + c16_ * 16); rW##X[i_] = *(const v4u*)(ck_ + CH_W + row_ * 256 + c16_ * 16); \
            const size_t qo_ = ((size_t)b * DNR + 64 * tc_ + row_) * 512 + h * 128 + c16_ * 8; rQ##X[i_] = *(const v4u*)(QN + qo_); rK##X[i_] = *(const v4u*)(KN + qo_); \
            g1##X[i_] = G_[row_]; g2##X[i_] = G_[64 + row_]; } \
        rQK##X = *(const v4u*)(ck_ + CH_QK + tid * 16); glp##X = G_[128]; } while (0)
    SC_PREFETCH(0, 0); SC_PREFETCH(1, 1);
#pragma unroll 1
    for (int s2 = 0; s2 < NCH; s2 += 2) {
      { const int s = s2;
        const int tc = (dir == 0 || s == 0) ? s : NCH - s;
        __syncthreads();
        const float gl = glp0;
        if (s > 0) { const int tcp = (dir == 0 || s == 1) ? s - 1 : NCH - (s - 1);
            if (tcp >= 1) {
#pragma unroll
                for (int i = 0; i < 2; ++i) { const int id = tid + NTHR * i, row = id >> 4, c16 = id & 15;
                    *(v4u*)(Od + ((size_t)b * SEQ + 64 * (tcp - 1) + row) * 512 + h * 128 + c16 * 8) = *(const LAS v4u*)(Os + row * 136 + c16 * 8); } } }
#pragma unroll
        for (int i = 0; i < 2; ++i) { const int id = tid + NTHR * i, row = id >> 4, c16 = id & 15;
            *(LAS v4u*)(Us + row * 136 + c16 * 8) = rU0[i]; *(LAS v4u*)(Ws + row * 136 + c16 * 8) = rW0[i];
            float q[8]; unpack8(rQ0[i], q);
#pragma unroll
            for (int e = 0; e < 8; ++e) q[e] *= g10[i];
            *(LAS v4u*)(Qs + row * 136 + c16 * 8) = pack8(q);
            float k[8]; unpack8(rK0[i], k);
#pragma unroll
            for (int e = 0; e < 8; ++e) KT[(c16 * 8 + e) * 72 + ((((row >> 3) ^ (c16 & 7)) << 3) | (row & 7))] = (bf16)f2bf(k[e] * g20[i]); }
        *(LAS v4u*)(QKs + (tid >> 3) * 72 + (tid & 7) * 8) = rQK0;
        __syncthreads();
        { const int sn_ = s + 2 < NCH ? s + 2 : NCH - 1; SC_PREFETCH(sn_, 0); }
        bf16x8 bS[4];
#pragma unroll
        for (int ks = 0; ks < 4; ++ks) bS[ks] = *(const LAS bf16x8*)(St + vrow * 136 + ks * 32 + fq * 8);
#pragma unroll
        for (int mt = 0; mt < 4; ++mt) { f32x4 acc = (f32x4){0.f, 0.f, 0.f, 0.f};
#pragma unroll
            for (int ks = 0; ks < 4; ++ks) acc = __builtin_amdgcn_mfma_f32_16x16x32_bf16(*(const LAS bf16x8*)(Ws + (16 * mt + fr) * 136 + ks * 32 + fq * 8), bS[ks], acc, 0, 0, 0);
            float vn[4];
#pragma unroll
            for (int r = 0; r < 4; ++r) vn[r] = bf2f(Us[(16 * mt + 4 * fq + r) * 136 + vrow]) - acc[r];
            v2u o; o.x = pk2(vn[0], vn[1]); o.y = pk2(vn[2], vn[3]); *(LAS v2u*)(VT + vrow * 72 + 16 * mt + 4 * fq) = o; }
        asm volatile("s_waitcnt lgkmcnt(0)" ::: "memory");
        bf16x8 bV[2];
#pragma unroll
        for (int ks = 0; ks < 2; ++ks) bV[ks] = *(const LAS bf16x8*)(VT + vrow * 72 + ks * 32 + fq * 8);
#pragma unroll
        for (int mt = 0; mt < 4; ++mt) { f32x4 acc = (f32x4){0.f, 0.f, 0.f, 0.f};
#pragma unroll
            for (int ks = 0; ks < 4; ++ks) acc = __builtin_amdgcn_mfma_f32_16x16x32_bf16(*(const LAS bf16x8*)(Qs + (16 * mt + fr) * 136 + ks * 32 + fq * 8), bS[ks], acc, 0, 0, 0);
#pragma unroll
            for (int ks = 0; ks < 2; ++ks) acc = __builtin_amdgcn_mfma_f32_16x16x32_bf16(*(const LAS bf16x8*)(QKs + (16 * mt + fr) * 72 + ks * 32 + fq * 8), bV[ks], acc, 0, 0, 0);
            if (tc >= 1) {
#pragma unroll
                for (int r = 0; r < 4; ++r) Os[(16 * mt + 4 * fq + r) * 136 + vrow] = (bf16)f2bf(acc[r]); } }
#pragma unroll
        for (int mt = 0; mt < 8; ++mt) { f32x4 acc = S[mt] * gl;
#pragma unroll
            for (int ks = 0; ks < 2; ++ks) acc = __builtin_amdgcn_mfma_f32_16x16x32_bf16(*(const LAS bf16x8*)(KT + (16 * mt + fr) * 72 + (((4 * ks + fq) ^ ((2 * mt + (fr >> 3)) & 7)) << 3)), bV[ks], acc, 0, 0, 0);
            S[mt] = acc; v2u o; o.x = pk2(acc[0], acc[1]); o.y = pk2(acc[2], acc[3]); *(LAS v2u*)(St + vrow * 136 + 16 * mt + 4 * fq) = o; }
        asm volatile("s_waitcnt lgkmcnt(0)" ::: "memory");
      }
      if (s2 + 1 < NCH) { const int s = s2 + 1;
        const int tc = (dir == 0 || s == 0) ? s : NCH - s;
        __syncthreads();
        const float gl = glp1;
        if (s > 0) { const int tcp = (dir == 0 || s == 1) ? s - 1 : NCH - (s - 1);
            if (tcp >= 1) {
#pragma unroll
                for (int i = 0; i < 2; ++i) { const int id = tid + NTHR * i, row = id >> 4, c16 = id & 15;
                    *(v4u*)(Od + ((size_t)b * SEQ + 64 * (tcp - 1) + row) * 512 + h * 128 + c16 * 8) = *(const LAS v4u*)(Os + row * 136 + c16 * 8); } } }
#pragma unroll
        for (int i = 0; i < 2; ++i) { const int id = tid + NTHR * i, row = id >> 4, c16 = id & 15;
            *(LAS v4u*)(Us + row * 136 + c16 * 8) = rU1[i]; *(LAS v4u*)(Ws + row * 136 + c16 * 8) = rW1[i];
            float q[8]; unpack8(rQ1[i], q);
#pragma unroll
            for (int e = 0; e < 8; ++e) q[e] *= g11[i];
            *(LAS v4u*)(Qs + row * 136 + c16 * 8) = pack8(q);
            float k[8]; unpack8(rK1[i], k);
#pragma unroll
            for (int e = 0; e < 8; ++e) KT[(c16 * 8 + e) * 72 + ((((row >> 3) ^ (c16 & 7)) << 3) | (row & 7))] = (bf16)f2bf(k[e] * g21[i]); }
        *(LAS v4u*)(QKs + (tid >> 3) * 72 + (tid & 7) * 8) = rQK1;
        __syncthreads();
        { const int sn_ = s + 2 < NCH ? s + 2 : NCH - 1; SC_PREFETCH(sn_, 1); }
        bf16x8 bS[4];
#pragma unroll
        for (int ks = 0; ks < 4; ++ks) bS[ks] = *(const LAS bf16x8*)(St + vrow * 136 + ks * 32 + fq * 8);
#pragma unroll
        for (int mt = 0; mt < 4; ++mt) { f32x4 acc = (f32x4){0.f, 0.f, 0.f, 0.f};
#pragma unroll
            for (int ks = 0; ks < 4; ++ks) acc = __builtin_amdgcn_mfma_f32_16x16x32_bf16(*(const LAS bf16x8*)(Ws + (16 * mt + fr) * 136 + ks * 32 + fq * 8), bS[ks], acc, 0, 0, 0);
            float vn[4];
#pragma unroll
            for (int r = 0; r < 4; ++r) vn[r] = bf2f(Us[(16 * mt + 4 * fq + r) * 136 + vrow]) - acc[r];
            v2u o; o.x = pk2(vn[0], vn[1]); o.y = pk2(vn[2], vn[3]); *(LAS v2u*)(VT + vrow * 72 + 16 * mt + 4 * fq) = o; }
        asm volatile("s_waitcnt lgkmcnt(0)" ::: "memory");
        bf16x8 bV[2];
#pragma unroll
        for (int ks = 0; ks < 2; ++ks) bV[ks] = *(const LAS bf16x8*)(VT + vrow * 72 + ks * 32 + fq * 8);
#pragma unroll
        for (int mt = 0; mt < 4; ++mt) { f32x4 acc = (f32x4){0.f, 0.f, 0.f, 0.f};
#pragma unroll
            for (int ks = 0; ks < 4; ++ks) acc = __builtin_amdgcn_mfma_f32_16x16x32_bf16(*(const LAS bf16x8*)(Qs + (16 * mt + fr) * 136 + ks * 32 + fq * 8), bS[ks], acc, 0, 0, 0);
#pragma unroll
            for (int ks = 0; ks < 2; ++ks) acc = __builtin_amdgcn_mfma_f32_16x16x32_bf16(*(const LAS bf16x8*)(QKs + (16 * mt + fr) * 72 + ks * 32 + fq * 8), bV[ks], acc, 0, 0, 0);
            if (tc >= 1) {
#pragma unroll
                for (int r = 0; r < 4; ++r) Os[(16 * mt + 4 * fq + r) * 136 + vrow] = (bf16)f2bf(acc[r]); } }
#pragma unroll
        for (int mt = 0; mt < 8; ++mt) { f32x4 acc = S[mt] * gl;
#pragma unroll
            for (int ks = 0; ks < 2; ++ks) acc = __builtin_amdgcn_mfma_f32_16x16x32_bf16(*(const LAS bf16x8*)(KT + (16 * mt + fr) * 72 + (((4 * ks + fq) ^ ((2 * mt + (fr >> 3)) & 7)) << 3)), bV[ks], acc, 0, 0, 0);
            S[mt] = acc; v2u o; o.x = pk2(acc[0], acc[1]); o.y = pk2(acc[2], acc[3]); *(LAS v2u*)(St + vrow * 136 + 16 * mt + 4 * fq) = o; }
        asm volatile("s_waitcnt lgkmcnt(0)" ::: "memory");
      }
    }
#undef SC_PREFETCH
    __syncthreads();
    { const int tcp = (dir == 0) ? NCH - 1 : 1;
#pragma unroll
      for (int i = 0; i < 2; ++i) { const int id = tid + NTHR * i, row = id >> 4, c16 = id & 15;
          *(v4u*)(Od + ((size_t)b * SEQ + 64 * (tcp - 1) + row) * 512 + h * 128 + c16 * 8) = *(const LAS v4u*)(Os + row * 136 + c16 * 8); } }
    __syncthreads();
}
#define XB_TMO      128
#define XB_XCNT(j)  (256  + 64 * (j))
#define XB_XSUB(j)  (1280 + 64 * (j))
#define XB_XGEN(j)  (2304 + 64 * (j))
#define XB_TOP      3328
#define XB_TOPGEN   3392
#define XCD_BAR_WORDS 3456
#define XB_SPIN_CAP (1u << 18)

__device__ __forceinline__ unsigned xb_ld(unsigned* p)              { return __hip_atomic_load(p, __ATOMIC_RELAXED, __HIP_MEMORY_SCOPE_AGENT); }
__device__ __forceinline__ unsigned xb_add(unsigned* p, unsigned v) { return __hip_atomic_fetch_add(p, v, __ATOMIC_RELAXED, __HIP_MEMORY_SCOPE_AGENT); }
__device__ __forceinline__ unsigned xb_xcc_id() { return (unsigned)__builtin_amdgcn_s_getreg((3 << 11) | 20) & 0xFu; }
#define XB_SPIN(cond, bar) do { unsigned _sp = 0; while (cond) { __builtin_amdgcn_s_sleep(1); \
    if ((++_sp & 255u) == 0u) { if (xb_ld(&(bar)[XB_TMO])) break; if (_sp > XB_SPIN_CAP) { atomicAdd(&(bar)[XB_TMO], 1u); break; } } } } while (0)

struct XcdBarrier {
    unsigned* bar; unsigned x;
    volatile LAS unsigned* st;
};

__device__ __forceinline__ XcdBarrier xcd_barrier_post(unsigned* bar, volatile LAS unsigned* st) {
    XcdBarrier b; b.bar = bar; b.x = xb_xcc_id(); b.st = st;
    if (threadIdx.x == 0) (void)xb_add(&bar[XB_XCNT(b.x)], 1u);
    return b;
}
__device__ __forceinline__ void xcd_barrier_complete(unsigned* bar, unsigned x, unsigned& nloc, unsigned& nx) {
    const unsigned G = gridDim.x * gridDim.y * gridDim.z;
    unsigned sum, cnt, mine, sp = 0u;
    for (;;) {
        sum = 0u; cnt = 0u; mine = 0u;
#pragma unroll
        for (unsigned j = 0; j < 16; ++j) { const unsigned c = xb_ld(&bar[XB_XCNT(j)]); sum += c; cnt += (c > 0u) ? 1u : 0u; mine = (j == x) ? c : mine; }
        if (sum == G) break;
        __builtin_amdgcn_s_sleep(1);
        if ((++sp & 255u) == 0u) { if (xb_ld(&bar[XB_TMO])) break; if (sp > XB_SPIN_CAP) { atomicAdd(&bar[XB_TMO], 1u); break; } }
    }
    nloc = mine > 0u ? mine : 1u; nx = cnt > 0u ? cnt : 1u;
}

__device__ __forceinline__ void xcd_barrier(const XcdBarrier& b) {
    asm volatile("s_waitcnt vmcnt(0)" ::: "memory");
    __syncthreads();
    if (threadIdx.x == 0) {
        unsigned* bar = b.bar;
        __builtin_amdgcn_s_waitcnt(0);
        unsigned nloc = b.st[0], nx = b.st[1];
        if (nloc == 0u) { xcd_barrier_complete(bar, b.x, nloc, nx); b.st[0] = nloc; b.st[1] = nx; }
        const unsigned old = xb_add(&bar[XB_XSUB(b.x)], 1u);
        const unsigned gen = old / nloc;
        if (old + 1u == (gen + 1u) * nloc) {
            __builtin_amdgcn_fence(__ATOMIC_RELEASE, "agent");
            asm volatile("s_waitcnt vmcnt(0)" ::: "memory");
            const unsigned og = xb_add(&bar[XB_TOP], 1u);
            const unsigned tg = og / nx;
            if (og + 1u == (tg + 1u) * nx) xb_add(&bar[XB_TOPGEN], 1u);
            else XB_SPIN(xb_ld(&bar[XB_TOPGEN]) == tg, bar);
            __builtin_amdgcn_fence(__ATOMIC_ACQUIRE, "agent");
            xb_add(&bar[XB_XGEN(b.x)], 1u);
            asm volatile("s_waitcnt vmcnt(0)" ::: "memory");
        } else {
            XB_SPIN(xb_ld(&bar[XB_XGEN(b.x)]) == gen, bar);
            __builtin_amdgcn_fence(__ATOMIC_ACQUIRE, "agent");
            asm volatile("s_waitcnt vmcnt(0)" ::: "memory");
        }
    }
    __syncthreads();
}

__device__ __forceinline__ void dn_combine_panel(const Args& args, int pm, int wave, int lane) {
    unsigned char* ws = args.ws;
    const bf16* OF = (const bf16*)(ws + WS_OF); const bf16* OB = (const bf16*)(ws + WS_OB); const bf16* DZ = (const bf16*)(ws + WS_DZ); bf16* CAT = (bf16*)(ws + WS_CAT);
    const float* onw = args.in[6]; const int r0 = pm * 256;
            { int ln_ = lane; asm volatile("" : "+v"(ln_));
              float onv[8];
#pragma unroll
              for (int e = 0; e < 8; ++e) onv[e] = onw[(ln_ & 15) * 8 + e];
#pragma unroll 1
              for (int rb = wave * 32; rb < wave * 32 + 32; rb += 4) { v4u va[4], vc[4], vz[4];
#pragma unroll
                  for (int u = 0; u < 4; ++u) { const int r = r0 + rb + u, b = r >> 13, s = r & (SEQ - 1);
                      va[u] = *(const v4u*)(OF + (size_t)r * 512 + ln_ * 8); vc[u] = *(const v4u*)(OB + (size_t)r * 512 + ln_ * 8); vz[u] = *(const v4u*)(DZ + ((size_t)b * LT + NMETA + s) * 512 + ln_ * 8); }
#pragma unroll
                  for (int u = 0; u < 4; ++u) { const int r = r0 + rb + u; float a[8], c[8], z[8]; unpack8(va[u], a); unpack8(vc[u], c); unpack8(vz[u], z);
                      float ss = 0.f;
#pragma unroll
                      for (int e = 0; e < 8; ++e) { a[e] += c[e]; ss += a[e] * a[e]; }
                      ss += __shfl_xor(ss, 1); ss += __shfl_xor(ss, 2); ss += __shfl_xor(ss, 4); ss += __shfl_xor(ss, 8);
                      const float rs = __builtin_amdgcn_rsqf(ss * (1.f / 128.f) + EPS);
#pragma unroll
                      for (int e = 0; e < 8; ++e) a[e] = a[e] * rs * onv[e] * silu_f(z[e]);
                      *(v4u*)(CAT + (size_t)r * 1024 + ln_ * 8) = pack8(a); } } }
}

__global__ void __launch_bounds__(NWAVES * 64, 2) hymba_fwd(Args args) {
    extern __shared__ __attribute__((aligned(16))) unsigned char lds_raw[];
    LAS unsigned char* lds = (LAS unsigned char*)lds_raw;
    cg::grid_group grid = cg::this_grid();
    const int tid = threadIdx.x, lane = tid & 63, wave = __builtin_amdgcn_readfirstlane(tid >> 6);
    const int G = gridDim.x, bx = blockIdx.x;
    const int vcu = (G % 8 == 0) ? (bx % 8) * (G / 8) + bx / 8 : bx;
    const int gw = vcu * NWAVES + wave, NGW = G * NWAVES;
    unsigned char* ws = args.ws;
    const int lo = args.ph_lo, hi = args.ph_hi;
#define IN(k) (lo <= (k) && (k) < hi)
#define SEAM(k) do { if (IN(k) && IN((k) + 1)) { if ((k) == 0) grid.sync(); else xcd_barrier(xbar); } } while (0)
    volatile LAS unsigned* xbst = (volatile LAS unsigned*)(lds + XBST_OFF);
    if (tid < 16) xbst[tid] = 0u;
    __syncthreads();
    const XcdBarrier xbar = xcd_barrier_post((unsigned*)(ws + WS_CTL) + 4096, xbst);
    bf16* Win_t = (bf16*)(ws + WS_WIN); bf16* Wout_t = (bf16*)(ws + WS_WOUT); bf16* Wup_t = (bf16*)(ws + WS_WUP); bf16* Wdn_t = (bf16*)(ws + WS_WDN);

    if (IN(0)) {
        LAS float* scr = (LAS float*)(lds + wave * 16384);
        constexpr int I_IN = (DM / 64) * (NIN / 32), I_OUT = (DM / 64) * (DM / 32), I_UP = (DM / 64) * (FF / 32), I_DN = (FF / 64) * (DM / 32);
        for (int it = gw; it < I_IN + I_OUT + I_UP + I_DN; it += NGW) {
            int r = it;
            if (r < I_IN) { p0_transpose_item<1>(args.in[2], DM, 2832, NIN, Win_t, scr, r, lane); continue; } r -= I_IN;
            if (r < I_OUT) { p0_transpose_item<0>(args.in[9], DM, DM, DM, Wout_t, scr, r, lane); continue; } r -= I_OUT;
            if (r < I_UP) { p0_transpose_item<0>(args.in[12], DM, FF, FF, Wup_t, scr, r, lane); continue; } r -= I_UP;
            p0_transpose_item<0>(args.in[13], FF, DM, DM, Wdn_t, scr, r, lane);
        }
        bf16* XN = (bf16*)(ws + WS_XN);
        { f32x4 wv[4];
#pragma unroll
          for (int j = 0; j < 4; ++j) wv[j] = ((const f32x4*)args.in[10] + lane)[64 * j];
          if (gw < NMETA) rms_row_to_bf16(args.in[1] + (size_t)gw * DM, args.in[10], XN + (size_t)(MR + gw) * DM, lane);
#pragma unroll 1
          for (int mb = gw; mb < MR; mb += 4 * NGW) { f32x4 xv[4][4];
#pragma unroll
              for (int u = 0; u < 4; ++u) { const f32x4* src = (const f32x4*)(args.in[0] + (size_t)(mb + u * NGW) * DM) + lane;
#pragma unroll
                  for (int j = 0; j < 4; ++j) xv[u][j] = src[64 * j]; }
#pragma unroll
              for (int u = 0; u < 4; ++u) { const int m = mb + u * NGW; float s = 0.f;
#pragma unroll
                  for (int j = 0; j < 4; ++j) s += (xv[u][j].x * xv[u][j].x + xv[u][j].y * xv[u][j].y) + (xv[u][j].z * xv[u][j].z + xv[u][j].w * xv[u][j].w);
                  const float rs = __builtin_amdgcn_rsqf(wave_sum(s) * (1.f / DM) + EPS);
                  v2u* o8 = (v2u*)(XN + (size_t)m * DM) + lane;
#pragma unroll
                  for (int j = 0; j < 4; ++j) { const f32x4 v = xv[u][j], ww = wv[j]; v2u o; o.x = pk2(v.x * rs * ww.x, v.y * rs * ww.y); o.y = pk2(v.z * rs * ww.z, v.w * rs * ww.w); o8[64 * j] = o; } } } }
    }
    SEAM(0);
    if (IN(1)) {
        if (gw < NIN / 16) {
            const int fr = lane & 15, fq = lane >> 4, nt = gw;
            const bf16* Ap = (const bf16*)(ws + WS_XN) + (size_t)(MR + fr) * DM + fq * 8; const bf16* Bp = Win_t + (size_t)(16 * nt + fr) * DM + fq * 8;
            f32x4 acc = (f32x4){0.f, 0.f, 0.f, 0.f};
#pragma unroll 8
            for (int ks = 0; ks < DM / 32; ++ks) acc = __builtin_amdgcn_mfma_f32_16x16x32_bf16(*(const bf16x8*)(Ap + ks * 32), *(const bf16x8*)(Bp + ks * 32), acc, 0, 0, 0);
            const int c = 16 * nt + fr;
            for (int b = 0; b < NB; ++b) {
#pragma unroll
                for (int r = 0; r < 4; ++r) { const size_t m = (size_t)b * LT + 4 * fq + r; const float v = acc[r];
                    if (c < 1536) ((bf16*)(ws + WS_DQKV))[m * 1536 + c] = (bf16)f2bf(v);
                    else if (c < 2048) ((bf16*)(ws + WS_DZ))[m * 512 + (c - 1536)] = (bf16)f2bf(v);
                    else if (c < 2816) ((bf16*)(ws + WS_AQKV))[m * 768 + (c - 2048)] = (bf16)f2bf(v);
                    else if (c < 2832) ((float*)(ws + WS_BA))[m * 16 + (c - 2816)] = v; } }
        }
        pg8::Gemm g{(const bf16*)(ws + WS_XN), Win_t, MR, NIN, DM}; pg8::StaticOrder S; S.init(MR, NIN, G, bx);
        pg8::EpiProj E{(bf16*)(ws + WS_DQKV), (bf16*)(ws + WS_DZ), (bf16*)(ws + WS_AQKV), (float*)(ws + WS_BA)};
        pg8::gemm_phase<pg8::EpiProj, pg8::StaticOrder, true, true>(lds, g, S, E);
    }
    SEAM(1);
    if (IN(2)) {
        { LAS float* rope = (LAS float*)(lds + ROPE_OFF);
#pragma unroll 1
          for (int e = 0; e < 4; ++e) { const int idx = tid + NTHR * e, pos = idx >> 4, f = idx & 15; float sv, cv; sincosf((float)pos * exp2f(-(float)f * (13.287712379549449f / 16.f)), &sv, &cv); rope[idx] = cv; rope[2048 + idx] = sv; }
          __syncthreads(); }
        { v4u rawv[7]; float cwv[4]; float pbb = 0.f, paa = 0.f;
          const bf16* DQKV = (const bf16*)(ws + WS_DQKV); const float* BA = (const float*)(ws + WS_BA); const float* conv_w = args.in[3];
          for (int item = bx; item < NB * NCH * 4; item += G) dn_prep_item(args, lds, item, item + G, rawv, cwv, pbb, paa, tid, wave, lane); }
        { const bf16* AQ = (const bf16*)(ws + WS_AQKV); const LAS float* rope = (const LAS float*)(lds + ROPE_OFF);
          constexpr int NGRP = NB * LKP / 4, HEAVY_G = 18; const int extra = (NB * NCH * 4) % G;
          int gs, ge;
          if (bx < extra) { gs = bx * HEAVY_G; ge = gs + HEAVY_G; }
          else { const long rem = NGRP - (long)extra * HEAVY_G; const int nl = G - extra; gs = extra * HEAVY_G + (int)(((long)(bx - extra) * rem) / nl); ge = extra * HEAVY_G + (int)(((long)(bx - extra + 1) * rem) / nl); }
#pragma unroll 1
          for (int g = gs + wave; g < ge; g += NWAVES) { v4u qd[4], kd[4];
#pragma unroll
              for (int u = 0; u < 4; ++u) { const int i_ = 4 * g + u, b = i_ / LKP, t = i_ % LKP, tq = t < LT ? t : LT - 1;
                  const bf16* row = AQ + (size_t)(b * LT + tq) * 768; qd[u] = *(const v4u*)(row + lane * 8); kd[u] = *(const v4u*)(row + 512 + (lane & 31) * 8); }
#pragma unroll
              for (int u = 0; u < 4; ++u) { const int i_ = 4 * g + u;
                  attn_prep_row(qd[u], kd[u], rope, args.in[7], args.in[8], (bf16*)(ws + WS_Q), (bf16*)(ws + WS_KB), (bf16*)(ws + WS_VB), i_ / LKP, i_ % LKP, lane); } } }
    }
    SEAM(2);
    if (IN(3)) {
        unsigned* ctl = (unsigned*)(ws + WS_CTL);
        for (int chain = bx; chain < NB * 8; chain += G) { dn_scan(args, lds, chain, tid, wave, lane);
            asm volatile("s_waitcnt vmcnt(0)" ::: "memory"); __syncthreads();
            if (tid == 0) { __builtin_amdgcn_fence(__ATOMIC_RELEASE, "agent"); asm volatile("s_waitcnt vmcnt(0)" ::: "memory"); __hip_atomic_fetch_add(ctl + 64 * 12, 1u, __ATOMIC_RELAXED, __HIP_MEMORY_SCOPE_AGENT); } }
        volatile LAS int* slot = (volatile LAS int*)(lds + QSLOT_OFF);
        const unsigned xcc = xcc_id() & 7u;
        for (;;) {
            if (tid == 0) { int u = -1;
                for (unsigned k = 0; k < 8; ++k) { const unsigned q = (xcc + k) & 7u; const unsigned idx = __hip_atomic_fetch_add(ctl + 64 * (1 + q), 1u, __ATOMIC_RELAXED, __HIP_MEMORY_SCOPE_AGENT); if (idx < 256u) { u = (int)(q * 512u + idx); break; } }
                if (u < 0) { const unsigned p = __hip_atomic_fetch_add(ctl + 64 * 13, 1u, __ATOMIC_RELAXED, __HIP_MEMORY_SCOPE_AGENT); if (p < 256u) u = (int)((p >> 5) * 512u + 256u + (p & 31u)); }
                if (u >= 0 && (u & 511) >= 256) {
                    unsigned sp = 0; while (__hip_atomic_load(ctl + 64 * 12, __ATOMIC_RELAXED, __HIP_MEMORY_SCOPE_AGENT) < (unsigned)(NB * 8) && ++sp < (1u << 22)) __builtin_amdgcn_s_sleep(2);
                    __builtin_amdgcn_fence(__ATOMIC_ACQUIRE, "agent"); asm volatile("s_waitcnt vmcnt(0)" ::: "memory"); }
                *slot = u; }
            __syncthreads();
            const int u = *slot;
            __syncthreads();
            if (u < 0) break;
            if ((u & 511) >= 256) { dn_combine_panel(args, (u >> 9) * 32 + ((u & 511) - 256), wave, lane); continue; }
            const int q = u >> 9, idx = u & 255, pair = q * 2 + (idx >> 7), gh = (idx >> 5) & 3, qb = idx & 31, b = pair >> 1, kvh = pair & 1, h = kvh * 4 + gh;
            const attn_body::bf16* Qu = (const attn_body::bf16*)(ws + WS_Q) + ((size_t)(b * SEQ + qb * 256)) * 512 + h * 64;
            const attn_body::bf16* Kh = (const attn_body::bf16*)(ws + WS_KB) + ((size_t)(b * 2 + kvh) * LKP) * 64;
            const attn_body::bf16* Vh = (const attn_body::bf16*)(ws + WS_VB) + ((size_t)(b * 2 + kvh) * LKP) * 64;
            attn_body::bf16* Ou = (attn_body::bf16*)(ws + WS_CAT) + ((size_t)(b * SEQ + qb * 256)) * 1024 + 512 + h * 64;
            attn_body::attn_unit<8>(Qu, Kh, Vh, Ou, (char*)lds_raw);
        }
    }
    SEAM(3);
    if (IN(4)) {
#define CU_LOCAL_SYNC() do { asm volatile("s_waitcnt vmcnt(0)" ::: "memory"); __syncthreads(); __builtin_amdgcn_fence(__ATOMIC_ACQUIRE, "agent"); asm volatile("s_waitcnt vmcnt(0)" ::: "memory"); } while (0)
        const bf16* OF = (const bf16*)(ws + WS_OF); const bf16* OB = (const bf16*)(ws + WS_OB); const bf16* DZ = (const bf16*)(ws + WS_DZ); bf16* CAT = (bf16*)(ws + WS_CAT);
        bf16* MIXB = (bf16*)(ws + WS_MIX); bf16* XN2 = (bf16*)(ws + WS_CAT);
        const float* onw = args.in[6];
        if (bx < MR / 256) { const int pm = bx;
            const int r0 = pm * 256;
            { pg8::Gemm g{(const bf16*)CAT, Wout_t, MR, DM, DM}; pg8::PanelOrder S{pm, DM / 256};
              pg8::EpiBf16<0> E{MIXB, DM, nullptr, 0, 0, 1.f};
              pg8::gemm_phase<pg8::EpiBf16<0>, pg8::PanelOrder, true, true>(lds, g, S, E); }
            CU_LOCAL_SYNC();
            { int ln_ = lane; asm volatile("" : "+v"(ln_));
              f32x4 w1v[4], w2v[4];
#pragma unroll
              for (int j = 0; j < 4; ++j) { w1v[j] = ((const f32x4*)args.in[11] + ln_)[64 * j]; w2v[j] = ((const f32x4*)args.in[14] + ln_)[64 * j]; }
#pragma unroll 1
              for (int rb = wave * 32; rb < wave * 32 + 32; rb += 4) { v2u mv[4][4]; f32x4 xv[4][4];
#pragma unroll
                  for (int u = 0; u < 4; ++u) { const int r = r0 + rb + u; const v2u* mr = (const v2u*)(MIXB + (size_t)r * DM) + ln_; const f32x4* xr = (const f32x4*)(args.in[0] + (size_t)r * DM) + ln_;
#pragma unroll
                      for (int j = 0; j < 4; ++j) { mv[u][j] = mr[64 * j]; xv[u][j] = xr[64 * j]; } }
#pragma unroll
                  for (int u = 0; u < 4; ++u) { const int r = r0 + rb + u; f32x4 v[4]; float s = 0.f;
#pragma unroll
                      for (int j = 0; j < 4; ++j) { const v2u m = mv[u][j]; v[j] = (f32x4){__builtin_bit_cast(float, m.x << 16), __builtin_bit_cast(float, m.x & 0xffff0000u), __builtin_bit_cast(float, m.y << 16), __builtin_bit_cast(float, m.y & 0xffff0000u)};
                          s += (v[j].x * v[j].x + v[j].y * v[j].y) + (v[j].z * v[j].z + v[j].w * v[j].w); }
                      const float rs = __builtin_amdgcn_rsqf(wave_sum(s) * (1.f / DM) + EPS); float s2 = 0.f;
                      f32x4* orow = (f32x4*)(args.out + (size_t)r * DM) + ln_;
#pragma unroll
                      for (int j = 0; j < 4; ++j) { v[j] = xv[u][j] + v[j] * rs * w1v[j]; orow[64 * j] = v[j]; s2 += (v[j].x * v[j].x + v[j].y * v[j].y) + (v[j].z * v[j].z + v[j].w * v[j].w); }
                      const float rs2 = __builtin_amdgcn_rsqf(wave_sum(s2) * (1.f / DM) + EPS);
                      v2u* o8 = (v2u*)(XN2 + (size_t)r * DM) + ln_;
#pragma unroll
                      for (int j = 0; j < 4; ++j) { const f32x4 ww = w2v[j]; v2u o; o.x = pk2(v[j].x * rs2 * ww.x, v[j].y * rs2 * ww.y); o.y = pk2(v[j].z * rs2 * ww.z, v[j].w * rs2 * ww.w); o8[64 * j] = o; } } } }
            CU_LOCAL_SYNC();
        }
#undef CU_LOCAL_SYNC
    }
    SEAM(4);
    if (IN(5)) {
        pg8::Gemm g{(const bf16*)(ws + WS_CAT), Wup_t, MR, FF, DM}; pg8::StaticOrder S; S.init(MR, FF, G, bx);
        pg8::EpiRelu2 E{(bf16*)(ws + WS_HID), FF};
        pg8::gemm_phase<pg8::EpiRelu2, pg8::StaticOrder, true, true>(lds, g, S, E);
    }
    SEAM(5);
    if (IN(6)) {
        pg8::Gemm g{(const bf16*)(ws + WS_HID), Wdn_t, MR, DM, FF}; pg8::StaticOrder S; S.init(MR, DM, G, bx);
        pg8::EpiBf16<0> E{(bf16*)(ws + WS_MIX), DM, nullptr, 0, 0, 1.f};
        pg8::gemm_phase<pg8::EpiBf16<0>, pg8::StaticOrder, true, true>(lds, g, S, E);
    }
    SEAM(6);
    if (IN(7)) {
        const bf16* MIXB = (const bf16*)(ws + WS_MIX);
        f32x4 w1v[4];
#pragma unroll
        for (int j = 0; j < 4; ++j) w1v[j] = ((const f32x4*)args.in[15] + lane)[64 * j];
#pragma unroll 1
        for (int rb = gw; rb < MR; rb += 4 * NGW) { v2u mv[4][4]; f32x4 hv[4][4];
#pragma unroll
            for (int u = 0; u < 4; ++u) { const int r = rb + u * NGW; const v2u* mr = (const v2u*)(MIXB + (size_t)r * DM) + lane; const f32x4* hr = (const f32x4*)(args.out + (size_t)r * DM) + lane;
#pragma unroll
                for (int j = 0; j < 4; ++j) { mv[u][j] = mr[64 * j]; hv[u][j] = hr[64 * j]; } }
#pragma unroll
            for (int u = 0; u < 4; ++u) { const int r = rb + u * NGW; f32x4 v[4]; float s = 0.f;
#pragma unroll
                for (int j = 0; j < 4; ++j) { const v2u m = mv[u][j]; v[j] = (f32x4){__builtin_bit_cast(float, m.x << 16), __builtin_bit_cast(float, m.x & 0xffff0000u), __builtin_bit_cast(float, m.y << 16), __builtin_bit_cast(float, m.y & 0xffff0000u)};
                    s += (v[j].x * v[j].x + v[j].y * v[j].y) + (v[j].z * v[j].z + v[j].w * v[j].w); }
                const float rs = __builtin_amdgcn_rsqf(wave_sum(s) * (1.f / DM) + EPS);
                f32x4* orow = (f32x4*)(args.out + (size_t)r * DM) + lane;
#pragma unroll
                for (int j = 0; j < 4; ++j) orow[64 * j] = hv[u][j] + v[j] * rs * w1v[j]; } }
    }
#undef IN
#undef SEAM
}

extern "C" void kernel_launch(void* const* d_in, const int* in_sizes, int n_in, void* d_out, int out_size, void* d_ws, size_t ws_size, hipStream_t stream) {
    static int grid = 0;
    if (grid == 0) {
        if (n_in != 16 || in_sizes[0] != MR * DM || out_size != MR * DM || ws_size < WS_END) { fprintf(stderr, "kernel_launch: unexpected shapes / workspace (n_in %d, in0 %d, out %d, ws %zu)\n", n_in, n_in > 0 ? in_sizes[0] : -1, out_size, ws_size); grid = -1; return; }
        int dev = 0, cus = 0, per_cu = 0;
        if (hipGetDevice(&dev) != hipSuccess || hipDeviceGetAttribute(&cus, hipDeviceAttributeMultiprocessorCount, dev) != hipSuccess) { grid = -1; return; }
        if (hipFuncSetAttribute((const void*)hymba_fwd, hipFuncAttributeMaxDynamicSharedMemorySize, LDS_BYTES) != hipSuccess) { fprintf(stderr, "kernel_launch: hipFuncSetAttribute failed\n"); grid = -1; return; }
        if (hipOccupancyMaxActiveBlocksPerMultiprocessor(&per_cu, (const void*)hymba_fwd, NWAVES * 64, LDS_BYTES) != hipSuccess || per_cu < 1) { fprintf(stderr, "kernel_launch: occupancy query says %d\n", per_cu); per_cu = 1; }
        (void)hipGetLastError();
        grid = cus >= 256 ? 256 : cus;
        if (grid != 256) fprintf(stderr, "kernel_launch: %d CUs: this build needs 256 workgroups\n", cus);
    }
    if (grid < 0) return;
    (void)hipMemsetAsync((char*)d_ws + WS_CTL, 0, CTL_ZERO_BYTES, stream);
    Args a{};
    for (int i = 0; i < 16; ++i) a.in[i] = (const float*)d_in[i];
    a.out = (float*)d_out; a.ws = (unsigned char*)d_ws;
#if ONE_LAUNCH
    a.ph_lo = 0; a.ph_hi = NPHASE;
    void* kargs[] = {&a};
    hipError_t e = hipLaunchCooperativeKernel((const void*)hymba_fwd, dim3(grid), dim3(NWAVES * 64), kargs, LDS_BYTES, stream);
    if (e != hipSuccess) fprintf(stderr, "kernel_launch: cooperative launch failed: %s (grid %d)\n", hipGetErrorString(e), grid);
#else
    for (int p = 0; p < NPHASE; ++p) { a.ph_lo = p; a.ph_hi = p + 1; hipLaunchKernelGGL(hymba_fwd, dim3(grid), dim3(NWAVES * 64), LDS_BYTES, stream, a); }
#endif
}
```

```cpp
#include <hip/hip_runtime.h>
#include <cstdio>
#include <cstdint>
namespace pg8 {
#define PG8_LAS __attribute__((address_space(3)))
typedef unsigned short bf16_t;
typedef short bf16x8 __attribute__((ext_vector_type(8)));
typedef float f32x4 __attribute__((ext_vector_type(4)));
typedef unsigned u32x4 __attribute__((ext_vector_type(4)));
constexpr int BM = 256, BK = 64, HALF = 128, HTB = HALF * BK * 2  , STAGE_BYTES = 8 * HTB, NXCD = 8, WGM = 8;

__host__ __device__ __forceinline__ int lds_byte(int r, int c) { const int st = (r >> 4) * 2 + (c >> 5), rr = r & 15, cc = c & 31, ob = rr * 64 + cc * 2; return st * 1024 + (ob ^ (((ob >> 9) & 1) << 5)); }
__host__ __device__ __forceinline__ void stage_rc(int b, int& R, int& C) { const int st = b / 1024, sb = b % 1024, swz = sb ^ (((sb >> 9) & 1) << 5); R = (st >> 1) * 16 + swz / 64; C = (st & 1) * 32 + (swz % 64) / 2; }
__host__ __device__ __forceinline__ int perm32(int rho) { const int n = rho >> 4, i = rho & 15; return 8 * (i >> 2) + 4 * n + (i & 3); }

struct Unit { int pm, pn; };
struct Gemm { const bf16_t* A; const bf16_t* Bt; int M, N, K; };

struct StaticOrder {
    int nM, nN, nwg, G, c;
    __host__ __device__ void init(int M, int N, int G_, int c_) { nM = M / BM; nN = N / BM; nwg = nM * nN; G = G_; c = c_; }
    __host__ __device__ bool next(int i, Unit& u) const {
        const long L = (long)i * G + c; if (L >= nwg) return false;
        int wgid = (int)L; { const int q = nwg / NXCD, r = nwg % NXCD, xcd = wgid % NXCD, off = wgid / NXCD; wgid = (xcd < r ? xcd * (q + 1) : r * (q + 1) + (xcd - r) * q) + off; }
        const int nig = WGM * nN, gid = wgid / nig, fm = gid * WGM, gsz = (nM - fm) < WGM ? (nM - fm) : WGM;
        u.pm = fm + ((wgid % nig) % gsz); u.pn = (wgid % nig) / gsz; return true;
    }
    __device__ __forceinline__ void a_ready(const Unit&) const {}
    __device__ __forceinline__ void done(const Unit&) const {}
};

__device__ __forceinline__ unsigned cvt_pk_bf16(float lo, float hi) { unsigned r; asm volatile("v_cvt_pk_bf16_f32 %0, %1, %2" : "=v"(r) : "v"(lo), "v"(hi)); return r; }
typedef float f32x2 __attribute__((ext_vector_type(2)));
__device__ __forceinline__ f32x2 gelu_pk(f32x2 v) {
    const f32x2 av = __builtin_elementwise_abs(v), d = av * 0.2316418882f + 1.0f;
    f32x2 t; t.x = __builtin_amdgcn_rcpf(d.x); t.y = __builtin_amdgcn_rcpf(d.y);
    f32x2 q = t * 0.5307027145f + (-0.7265760135f); q = q * t + 0.7107068705f; q = q * t + (-0.142248368f); q = q * t + 0.127414796f; q = q * t;
    const f32x2 s = (v * v) * (-0.72134752044f);
    f32x2 e; e.x = __builtin_amdgcn_exp2f(s.x); e.y = __builtin_amdgcn_exp2f(s.y);
    const f32x2 m = v * (q * e), r = v - m;
    f32x2 o; o.x = v.x < 0.f ? m.x : r.x; o.y = v.y < 0.f ? m.y : r.y; return o;
}

template <int ACT  > struct EpiBf16 {
    static constexpr bool PERM = true, AFTER_DRAIN = false; static_assert(ACT == 0 || ACT == 1, "EpiBf16: ACT is 0 (none) or 1 (gelu_pk)");
    bf16_t* O; int ldc; const float* bias; int split_cols; size_t split_stride; float scale0;
    __device__ __forceinline__ void operator()(const f32x4 (&acc)[2][2][4][2], const Unit& u, int wr, int wc, int fr, int fq) const {
        const int row0 = u.pm * BM + wr * 64 + fr; int colt = u.pn * BM; bf16_t* base = O;
        float sc = 1.f; if (split_cols) { const int t = colt / split_cols; base += (size_t)t * split_stride; colt -= t * split_cols; if (t == 0) sc = scale0; }
        const int col0 = colt + wc * 32 + 8 * fq, bcol0 = u.pn * BM + wc * 32 + 8 * fq;
        f32x4 bv[2][2];
#pragma unroll
        for (int bj = 0; bj < 2; ++bj)
#pragma unroll
            for (int n = 0; n < 2; ++n) bv[bj][n] = bias ? *(const f32x4*)(bias + bcol0 + bj * HALF + 4 * n) : (f32x4){0.f, 0.f, 0.f, 0.f};
#pragma unroll
        for (int ai = 0; ai < 2; ++ai)
#pragma unroll
            for (int m = 0; m < 4; ++m) { bf16_t* rowp = base + (size_t)(row0 + ai * HALF + m * 16) * ldc + col0;
#pragma unroll
                for (int bj = 0; bj < 2; ++bj) { f32x4 v0 = acc[ai][bj][m][0] + bv[bj][0], v1 = acc[ai][bj][m][1] + bv[bj][1];
                    if (ACT == 1) { f32x2 a = gelu_pk((f32x2){v0[0], v0[1]}), b = gelu_pk((f32x2){v0[2], v0[3]}), c = gelu_pk((f32x2){v1[0], v1[1]}), d = gelu_pk((f32x2){v1[2], v1[3]});
                        v0 = (f32x4){a.x, a.y, b.x, b.y}; v1 = (f32x4){c.x, c.y, d.x, d.y}; }
                    v0 = v0 * sc; v1 = v1 * sc; u32x4 w; w.x = cvt_pk_bf16(v0[0], v0[1]); w.y = cvt_pk_bf16(v0[2], v0[3]); w.z = cvt_pk_bf16(v1[0], v1[1]); w.w = cvt_pk_bf16(v1[2], v1[3]);
                    *(u32x4*)(rowp + bj * HALF) = w; } }
    }
};
struct PanelOrder {
    int pm, nN;
    __device__ __forceinline__ bool next(int i, Unit& u) const { if (i >= nN) return false; int p = i; asm volatile("" : "+s"(p)); u.pm = pm; u.pn = p; return true; }
    __device__ __forceinline__ void a_ready(const Unit&) const {}
    __device__ __forceinline__ void done(const Unit&) const {}
};
struct EpiProj {
    static constexpr bool PERM = true, AFTER_DRAIN = false;
    bf16_t* dqkv; bf16_t* dz; bf16_t* aqkv; float* ba;
    __device__ __forceinline__ void operator()(const f32x4 (&acc)[2][2][4][2], const Unit& u, int wr, int wc, int fr, int fq) const {
        const int row0 = u.pm * BM + 16 * ((u.pm >> 5) + 1) + wr * 64 + fr; const int pn = u.pn;
        if (pn == 11) {
            if (wc == 0 && fq < 2) {
#pragma unroll
                for (int ai = 0; ai < 2; ++ai)
#pragma unroll
                    for (int m = 0; m < 4; ++m) { float* p = ba + (size_t)(row0 + ai * HALF + m * 16) * 16 + 8 * fq; *(f32x4*)p = acc[ai][0][m][0]; *(f32x4*)(p + 4) = acc[ai][0][m][1]; }
            }
            return;
        }
        bf16_t* base; int ldc, colt;
        if (pn < 6) { base = dqkv; ldc = 1536; colt = pn * 256; } else if (pn < 8) { base = dz; ldc = 512; colt = (pn - 6) * 256; } else { base = aqkv; ldc = 768; colt = (pn - 8) * 256; }
        const int col0 = colt + wc * 32 + 8 * fq;
#pragma unroll
        for (int ai = 0; ai < 2; ++ai)
#pragma unroll
            for (int m = 0; m < 4; ++m) { bf16_t* rowp = base + (size_t)(row0 + ai * HALF + m * 16) * ldc + col0;
#pragma unroll
                for (int bj = 0; bj < 2; ++bj) { const f32x4 v0 = acc[ai][bj][m][0], v1 = acc[ai][bj][m][1];
                    u32x4 w; w.x = cvt_pk_bf16(v0[0], v0[1]); w.y = cvt_pk_bf16(v0[2], v0[3]); w.z = cvt_pk_bf16(v1[0], v1[1]); w.w = cvt_pk_bf16(v1[2], v1[3]);
                    *(u32x4*)(rowp + bj * HALF) = w; } }
    }
};
struct EpiRelu2 {
    static constexpr bool PERM = true, AFTER_DRAIN = false;
    bf16_t* O; int ldc;
    __device__ __forceinline__ void operator()(const f32x4 (&acc)[2][2][4][2], const Unit& u, int wr, int wc, int fr, int fq) const {
        const int row0 = u.pm * BM + wr * 64 + fr; const int col0 = u.pn * BM + wc * 32 + 8 * fq;
#pragma unroll
        for (int ai = 0; ai < 2; ++ai)
#pragma unroll
            for (int m = 0; m < 4; ++m) { bf16_t* rowp = O + (size_t)(row0 + ai * HALF + m * 16) * ldc + col0;
#pragma unroll
                for (int bj = 0; bj < 2; ++bj) { f32x4 v0 = acc[ai][bj][m][0], v1 = acc[ai][bj][m][1];
#pragma unroll
                    for (int e = 0; e < 4; ++e) { const float a = fmaxf(v0[e], 0.f), b = fmaxf(v1[e], 0.f); v0[e] = a * a; v1[e] = b * b; }
                    u32x4 w; w.x = cvt_pk_bf16(v0[0], v0[1]); w.y = cvt_pk_bf16(v0[2], v0[3]); w.z = cvt_pk_bf16(v1[0], v1[1]); w.w = cvt_pk_bf16(v1[2], v1[3]);
                    *(u32x4*)(rowp + bj * HALF) = w; } }
    }
};
struct EpiF32 {
    static constexpr bool PERM = false, AFTER_DRAIN = false;
    float* O; int ldc;
    __device__ __forceinline__ void operator()(const f32x4 (&acc)[2][2][4][2], const Unit& u, int wr, int wc, int fr, int fq) const {
        const int row0 = u.pm * BM + wr * 64 + fr; const int col0 = u.pn * BM + wc * 32 + 4 * fq;
#pragma unroll
        for (int ai = 0; ai < 2; ++ai)
#pragma unroll
            for (int m = 0; m < 4; ++m) { float* rowp = O + (size_t)(row0 + ai * HALF + m * 16) * ldc + col0;
#pragma unroll
                for (int bj = 0; bj < 2; ++bj)
#pragma unroll
                    for (int n = 0; n < 2; ++n) *(f32x4*)(rowp + bj * HALF + n * 16) = acc[ai][bj][m][n]; }
    }
};
template <class Epi, class Sched, bool ALIGN_EPI = false, bool SP2 = false>
__device__ __forceinline__ void gemm_phase(PG8_LAS unsigned char* lds, const Gemm g, const Sched& S, const Epi& E) {
    const int tid = threadIdx.x, wid = __builtin_amdgcn_readfirstlane(tid >> 6), lane = tid & 63, wr = wid >> 2, wc = wid & 3, fr = lane & 15, fq = lane >> 4;
    const int K = g.K, nt = K / BK;
    unsigned voffA[2], voffB[2];
#pragma unroll
    for (int i = 0; i < 2; ++i) { int R, C; stage_rc(tid * 16 + i * 8192, R, C); const int Rb = Epi::PERM ? ((R & ~31) + perm32(R & 31)) : R;
        voffA[i] = (unsigned)(R * K + C) * 2u; voffB[i] = (unsigned)(Rb * K + C) * 2u; }
    const size_t kstep = (size_t)(BK * 2);
    const size_t hstep = (size_t)HALF * K * 2;
    const size_t tstep = 2 * hstep;
    const unsigned ldsw = (unsigned)wid * 1024u;
    const int aoff = lds_byte(wr * 64 + fr, fq * 8), boff = lds_byte(wc * 32 + fr, fq * 8);
#define PG8_SA(b, h) (((b) * 2 + (h)) * HTB)
#define PG8_SB(b, h) ((4 + (b) * 2 + (h)) * HTB)
#define PG8_STAGE(bufoff, gbase, voff) do { _Pragma("unroll") for (int _i = 0; _i < 2; ++_i) \
        __builtin_amdgcn_global_load_lds((const unsigned*)((const char*)(gbase) + (voff)[_i]), (PG8_LAS unsigned*)(lds + (bufoff) + ldsw + _i * 8192), 16, 0, 0); } while (0)
#define PG8_LDA(dst, b, h) do { _Pragma("unroll") for (int m = 0; m < 4; ++m) _Pragma("unroll") for (int k = 0; k < 2; ++k) dst[m][k] = *(const PG8_LAS bf16x8*)(lds + PG8_SA(b, h) + aoff + m * 2048 + k * 1024); } while (0)
#define PG8_LDB(dst, b, h) do { _Pragma("unroll") for (int n = 0; n < 2; ++n) _Pragma("unroll") for (int k = 0; k < 2; ++k) dst[n][k] = *(const PG8_LAS bf16x8*)(lds + PG8_SB(b, h) + boff + n * 2048 + k * 1024); } while (0)
#define PG8_MMA(ai, bj, At, Bt) do { __builtin_amdgcn_s_setprio(1); _Pragma("unroll") for (int m = 0; m < 4; ++m) _Pragma("unroll") for (int n = 0; n < 2; ++n) _Pragma("unroll") for (int k = 0; k < 2; ++k) \
        acc[ai][bj][m][n] = __builtin_amdgcn_mfma_f32_16x16x32_bf16(Bt[n][k], At[m][k], acc[ai][bj][m][n], 0, 0, 0); __builtin_amdgcn_s_setprio(0); } while (0)
#define PG8_WAIT_V(n) asm volatile("s_waitcnt vmcnt(" #n ")" ::: "memory")
#define PG8_WAIT_L(n) asm volatile("s_waitcnt lgkmcnt(" #n ")" ::: "memory")
#define PG8_BAR __builtin_amdgcn_s_barrier()
#define PG8_SCHED __builtin_amdgcn_sched_barrier(0)
    Unit cur, nxt; int ui = 0;
    if (!S.next(0, cur)) return;
    f32x4 acc[2][2][4][2];
#pragma unroll
    for (int a = 0; a < 2; ++a)
#pragma unroll
        for (int b = 0; b < 2; ++b)
#pragma unroll
            for (int m = 0; m < 4; ++m)
#pragma unroll
                for (int n = 0; n < 2; ++n) acc[a][b][m][n] = (f32x4){0.f, 0.f, 0.f, 0.f};
    bf16x8 At[4][2], B0[2][2], B1[2][2];
    const char* cA = (const char*)g.A + (size_t)cur.pm * tstep; const char* cB = (const char*)g.Bt + (size_t)cur.pn * tstep;
    S.a_ready(cur);
    if constexpr (SP2) {
        PG8_STAGE(PG8_SB(0, 0), cB, voffB); PG8_STAGE(PG8_SB(0, 1), cB + hstep, voffB); PG8_STAGE(PG8_SA(0, 0), cA, voffA); PG8_STAGE(PG8_SA(0, 1), cA + hstep, voffA);
        if (wr == 1) PG8_BAR;
        PG8_WAIT_V(2); PG8_BAR;
        PG8_STAGE(PG8_SB(1, 0), cB + kstep, voffB); PG8_STAGE(PG8_SA(1, 0), cA + kstep, voffA); PG8_STAGE(PG8_SB(1, 1), cB + hstep + kstep, voffB);
        PG8_WAIT_V(6); PG8_BAR;
    } else {
        PG8_STAGE(PG8_SB(0, 0), cB, voffB); PG8_STAGE(PG8_SA(0, 0), cA, voffA); PG8_STAGE(PG8_SB(0, 1), cB + hstep, voffB); PG8_STAGE(PG8_SA(0, 1), cA + hstep, voffA);
        if (wr == 1) PG8_BAR;
        PG8_WAIT_V(4); PG8_BAR;
        PG8_STAGE(PG8_SB(1, 0), cB + kstep, voffB); PG8_STAGE(PG8_SA(1, 0), cA + kstep, voffA); PG8_STAGE(PG8_SB(1, 1), cB + hstep + kstep, voffB);
        PG8_WAIT_V(6); PG8_BAR;
    }
    for (;;) {
        const bool has_next = S.next(ui + 1, nxt);
        const char* nA = has_next ? (const char*)g.A + (size_t)nxt.pm * tstep : cA; const char* nB = has_next ? (const char*)g.Bt + (size_t)nxt.pn * tstep : cB;
        for (int t = 0; t < nt; t += 2) {
            const bool last = (t == nt - 2);
            const char* a1 = cA + (size_t)(t + 1) * kstep;
            const char* a2 = last ? nA : cA + (size_t)(t + 2) * kstep; const char* b2 = last ? nB : cB + (size_t)(t + 2) * kstep;
            const char* a3 = a2 + kstep; const char* b3 = b2 + kstep;
            if (last && has_next) S.a_ready(nxt);
            if constexpr (SP2) {
            PG8_LDB(B0, 0, 0); PG8_LDB(B1, 0, 1); PG8_SCHED; PG8_LDA(At, 0, 0); PG8_STAGE(PG8_SA(1, 1), a1 + hstep, voffA);
            PG8_WAIT_V(8); PG8_WAIT_L(0); PG8_BAR; PG8_MMA(0, 0, At, B0); PG8_MMA(0, 1, At, B1); PG8_BAR; PG8_SCHED;
            PG8_LDA(At, 0, 1); PG8_STAGE(PG8_SB(0, 0), b2, voffB); PG8_STAGE(PG8_SB(0, 1), b2 + hstep, voffB); PG8_STAGE(PG8_SA(0, 0), a2, voffA);
            PG8_WAIT_V(8); PG8_WAIT_L(0); PG8_BAR; PG8_MMA(1, 0, At, B0); PG8_MMA(1, 1, At, B1); PG8_BAR; PG8_SCHED;
            PG8_LDB(B0, 1, 0); PG8_LDB(B1, 1, 1); PG8_SCHED; PG8_LDA(At, 1, 0); PG8_STAGE(PG8_SA(0, 1), a2 + hstep, voffA);
            PG8_WAIT_V(8); PG8_WAIT_L(0); PG8_BAR; PG8_MMA(0, 0, At, B0); PG8_MMA(0, 1, At, B1); PG8_BAR; PG8_SCHED;
            PG8_LDA(At, 1, 1); PG8_STAGE(PG8_SB(1, 0), b3, voffB); PG8_STAGE(PG8_SB(1, 1), b3 + hstep, voffB); PG8_STAGE(PG8_SA(1, 0), a3, voffA);
            PG8_WAIT_V(8); PG8_WAIT_L(0); PG8_BAR; PG8_MMA(1, 0, At, B0); PG8_MMA(1, 1, At, B1); PG8_BAR; PG8_SCHED;
            } else {
            PG8_LDB(B0, 0, 0); PG8_SCHED; PG8_LDA(At, 0, 0); PG8_STAGE(PG8_SA(1, 1), a1 + hstep, voffA);
            PG8_WAIT_L(8); PG8_BAR; PG8_WAIT_L(0); PG8_MMA(0, 0, At, B0); PG8_BAR; PG8_SCHED;
            PG8_LDB(B1, 0, 1); PG8_STAGE(PG8_SB(0, 0), b2, voffB);
            PG8_BAR; PG8_WAIT_L(0); PG8_MMA(0, 1, At, B1); PG8_BAR;
            PG8_LDA(At, 0, 1); PG8_STAGE(PG8_SA(0, 0), a2, voffA);
            PG8_BAR; PG8_WAIT_L(0); PG8_MMA(1, 0, At, B0); PG8_BAR; PG8_SCHED;
            PG8_STAGE(PG8_SB(0, 1), b2 + hstep, voffB);
            PG8_WAIT_V(6); PG8_BAR; PG8_MMA(1, 1, At, B1); PG8_BAR;
            PG8_LDB(B0, 1, 0); PG8_SCHED; PG8_LDA(At, 1, 0); PG8_STAGE(PG8_SA(0, 1), a2 + hstep, voffA);
            PG8_WAIT_L(8); PG8_BAR; PG8_WAIT_L(0); PG8_MMA(0, 0, At, B0); PG8_BAR; PG8_SCHED;
            PG8_LDB(B1, 1, 1); PG8_STAGE(PG8_SB(1, 0), b3, voffB);
            PG8_BAR; PG8_WAIT_L(0); PG8_MMA(0, 1, At, B1); PG8_BAR;
            PG8_LDA(At, 1, 1); PG8_STAGE(PG8_SA(1, 0), a3, voffA);
            PG8_BAR; PG8_WAIT_L(0); PG8_MMA(1, 0, At, B0); PG8_BAR; PG8_SCHED;
            PG8_STAGE(PG8_SB(1, 1), b3 + hstep, voffB);
            PG8_WAIT_V(6); PG8_BAR; PG8_MMA(1, 1, At, B1); PG8_BAR;
            }
        }
        if constexpr (ALIGN_EPI) { if (wr == 0) PG8_BAR; }
        if constexpr (!Epi::AFTER_DRAIN) { E(acc, cur, wr, wc, fr, fq); S.done(cur); }
        if (!has_next) break;
#pragma unroll
        for (int a = 0; a < 2; ++a)
#pragma unroll
            for (int b = 0; b < 2; ++b)
#pragma unroll
                for (int m = 0; m < 4; ++m)
#pragma unroll
                    for (int n = 0; n < 2; ++n) acc[a][b][m][n] = (f32x4){0.f, 0.f, 0.f, 0.f};
        cur = nxt; cA = nA; cB = nB; ++ui;
        if constexpr (ALIGN_EPI) { if (wr == 1) PG8_BAR; }
    }
    PG8_WAIT_V(0);
    if constexpr (!ALIGN_EPI) { if (wr == 0) PG8_BAR; }
    PG8_BAR;
    if constexpr (Epi::AFTER_DRAIN) { E.fused(acc, cur, wr, wc, fr, fq, lds, wid, lane); S.done(cur); }
#undef PG8_SA
#undef PG8_SB
#undef PG8_STAGE
#undef PG8_LDA
#undef PG8_LDB
#undef PG8_MMA
#undef PG8_WAIT_V
#undef PG8_WAIT_L
#undef PG8_BAR
#undef PG8_SCHED
}
}

#ifndef PG8_SP2
#define PG8_SP2 true
#endif
#ifndef PG8_ALIGN
#define PG8_ALIGN true
#endif
#include <hip/hip_bf16.h>
#include <cmath>
namespace attn_body {
using bf16=__hip_bfloat16;
using bf16x8=__attribute__((ext_vector_type(8)))short;
using s16x4=__attribute__((ext_vector_type(4)))short;
using f32x16=__attribute__((ext_vector_type(16)))float;
using u32x4=__attribute__((ext_vector_type(4)))unsigned;
constexpr int D=64,QP=512,OP=1024,KP=64,NKT=130,NKEYS=8208;
constexpr int NW=8,QBLK=32,QB=QBLK*NW,KVBLK=64;
constexpr int ATTN_UNIT_ROWS=QB;
__device__ __forceinline__ int crow(int r,int hi){return (r&3)+8*(r>>2)+4*hi;}
#define SBAR() __builtin_amdgcn_sched_barrier(0)
__device__ __forceinline__ void kmask(f32x16&p0,f32x16&p1,int t,int hi){
  const float NEG=-INFINITY; int kb=64*t+4*hi;
  #pragma unroll
  for(int r=0;r<16;++r){int kv=kb+(r&3)+8*(r>>2); if(kv>=NKEYS)p0[r]=NEG; if(kv+32>=NKEYS)p1[r]=NEG;}
}

constexpr int NSLOT=3, SLOTB=8192;
constexpr int LDS_K=0, LDS_V=NSLOT*SLOTB, LDS_WS=2*NSLOT*SLOTB, LDS_OST=LDS_WS+NW*64*4, LDS_BYTES=LDS_OST+NW*4096;
constexpr float C2=0.125f*1.4426950408889634f;
__device__ __forceinline__ void glds16(const void*gsrc,unsigned lds_dst){unsigned keep;
  asm volatile("s_mov_b32 %0, m0\n\ts_mov_b32 m0, %2\n\ts_nop 0\n\tglobal_load_lds_dwordx4 %1, off\n\ts_mov_b32 m0, %0":"=&s"(keep):"v"(gsrc),"s"(lds_dst):"memory");}
__device__ __forceinline__ float max3f(float a,float b,float c){float r;asm("v_max3_f32 %0, %1, %2, %3":"=v"(r):"v"(a),"v"(b),"v"(c));return r;}
__device__ __forceinline__ float max2f(float a,float b){float r;asm("v_max_f32_e32 %0, %1, %2":"=v"(r):"v"(a),"v"(b));return r;}
__device__ __forceinline__ float fadd_s(float a,float b){float r;asm("v_add_f32_e32 %0, %1, %2":"=v"(r):"v"(a),"v"(b));return r;}
__device__ __forceinline__ float fsub_s(float a,float b){float r;asm("v_sub_f32_e32 %0, %1, %2":"=v"(r):"v"(a),"v"(b));return r;}
typedef float f32x2_t __attribute__((ext_vector_type(2))); typedef __bf16 bf16x2_t __attribute__((ext_vector_type(2)));
__device__ __forceinline__ unsigned cvtpk_s(float lo,float hi){f32x2_t v={lo,hi};bf16x2_t b=__builtin_convertvector(v,bf16x2_t);return __builtin_bit_cast(unsigned,b);}
#define WAIT_BAR(N) asm volatile("s_waitcnt vmcnt(" #N ") lgkmcnt(0)\n\ts_barrier":::"memory")

__device__ __forceinline__ void qkt(f32x16&p0,f32x16&p1,const char*Kslot,const bf16x8*qr,const f32x16&negm,int r32,int hi){
  const char*kb=Kslot+hi*1024+r32*16;
  #pragma unroll
  for(int d0=0;d0<4;++d0){
    const bf16x8 b0=*reinterpret_cast<const bf16x8*>(kb+d0*2048);
    const bf16x8 b1=*reinterpret_cast<const bf16x8*>(kb+d0*2048+512);
    if(d0==0){p0=__builtin_amdgcn_mfma_f32_32x32x16_bf16(b0,qr[0],negm,0,0,0);p1=__builtin_amdgcn_mfma_f32_32x32x16_bf16(b1,qr[0],negm,0,0,0);}
    else{p0=__builtin_amdgcn_mfma_f32_32x32x16_bf16(b0,qr[d0],p0,0,0,0);p1=__builtin_amdgcn_mfma_f32_32x32x16_bf16(b1,qr[d0],p1,0,0,0);}}
}
typedef __attribute__((address_space(3))) const char* lds_cptr;
typedef short v4i16_t __attribute__((ext_vector_type(4)));
__device__ __forceinline__ void kload8(bf16x8*kf,lds_cptr kp){
  kf[0]=*(const __attribute__((address_space(3))) bf16x8*)(kp);      kf[1]=*(const __attribute__((address_space(3))) bf16x8*)(kp+512);
  kf[2]=*(const __attribute__((address_space(3))) bf16x8*)(kp+2048); kf[3]=*(const __attribute__((address_space(3))) bf16x8*)(kp+2560);
  kf[4]=*(const __attribute__((address_space(3))) bf16x8*)(kp+4096); kf[5]=*(const __attribute__((address_space(3))) bf16x8*)(kp+4608);
  kf[6]=*(const __attribute__((address_space(3))) bf16x8*)(kp+6144); kf[7]=*(const __attribute__((address_space(3))) bf16x8*)(kp+6656);
}
__device__ __forceinline__ void kload2(bf16x8*kf,lds_cptr kp,int j){ kf[2*j]=*(const __attribute__((address_space(3))) bf16x8*)(kp+j*2048); kf[2*j+1]=*(const __attribute__((address_space(3))) bf16x8*)(kp+j*2048+512); }
__device__ __forceinline__ s16x4 vtr(lds_cptr p){ return __builtin_bit_cast(s16x4,__builtin_amdgcn_ds_read_tr16_b64_v4i16((__attribute__((address_space(3))) v4i16_t*)p)); }
__device__ __forceinline__ float rowmax(const f32x16&p0,const f32x16&p1){
  float a=max3f(p0[0],p0[1],p1[0]),b=max3f(p0[2],p0[3],p1[1]);a=max3f(a,p1[2],p1[3]);
  #pragma unroll
  for(int r=4;r<16;r+=4){a=max3f(a,p0[r],p0[r+1]);b=max3f(b,p0[r+2],p0[r+3]);a=max3f(a,p1[r],p1[r+1]);b=max3f(b,p1[r+2],p1[r+3]);}
  const float m=max2f(a,b);
  auto rr=__builtin_amdgcn_permlane32_swap(__float_as_uint(m),__float_as_uint(m),false,false);
  return max2f(__uint_as_float(rr[0]),__uint_as_float(rr[1]));
}
__device__ __forceinline__ void pv(f32x16*o,int vb,bf16x8 pa0,bf16x8 pa1,bf16x8 pa2,bf16x8 pa3){
  #pragma unroll
  for(int d0=0;d0<2;++d0){s16x4 lo[4],hi[4];
    #pragma unroll
    for(int ks=0;ks<4;++ks){
      asm volatile("ds_read_b64_tr_b16 %0,%1 offset:%c2":"=&v"(lo[ks]):"v"(vb),"i"(d0*4096+ks*1024):"memory");
      asm volatile("ds_read_b64_tr_b16 %0,%1 offset:%c2":"=&v"(hi[ks]):"v"(vb),"i"(d0*4096+ks*1024+512):"memory");}
    asm volatile("s_waitcnt lgkmcnt(0)":::"memory");SBAR();
    #define PK(k) (bf16x8){lo[k][0],lo[k][1],lo[k][2],lo[k][3],hi[k][0],hi[k][1],hi[k][2],hi[k][3]}
    o[d0]=__builtin_amdgcn_mfma_f32_32x32x16_bf16(pa0,PK(0),o[d0],0,0,0);
    o[d0]=__builtin_amdgcn_mfma_f32_32x32x16_bf16(pa1,PK(1),o[d0],0,0,0);
    o[d0]=__builtin_amdgcn_mfma_f32_32x32x16_bf16(pa2,PK(2),o[d0],0,0,0);
    o[d0]=__builtin_amdgcn_mfma_f32_32x32x16_bf16(pa3,PK(3),o[d0],0,0,0);
    #undef PK
  }
}

#ifndef ATTN_STORE16
#define ATTN_STORE16(p,v) (*(u32x4*)(p)=(v))
#endif
template<int THRL> __device__ __forceinline__ void attn_unit(const bf16*Qu,const bf16*__restrict__ Kh,const bf16*__restrict__ Vh,bf16*Ou,char*shm){
  const int tid=threadIdx.x,lane=tid&63,r32=lane&31,hi=lane>>5; const int wid=__builtin_amdgcn_readfirstlane(tid>>6);
  const bf16*Qw=Qu+(long)(wid*QBLK)*QP;
  const unsigned lds0=(unsigned)(uintptr_t)shm;
  float*wsf=(float*)(shm+LDS_WS)+wid*64;
  const bf16*ksrc=Kh+(long)lane*KP+wid*8;
  const bf16*vsrc=Vh+(long)(16*(wid&3)+(lane>>2))*KP+(wid>>2)*32+(lane&3)*8;
  const unsigned kdst=lds0+LDS_K+wid*1024, vdst=lds0+LDS_V+wid*1024;
  #define DMA_K(t,slot) glds16(ksrc+(long)(t)*KVBLK*KP,(unsigned)__builtin_amdgcn_readfirstlane(kdst+(slot)))
  #define DMA_V(t,slot) glds16(vsrc+(long)(t)*KVBLK*KP,(unsigned)__builtin_amdgcn_readfirstlane(vdst+(slot)))
  const int vb0=(int)(lds0+LDS_V)+((lane>>4)&1)*32+(lane&3)*8+(4*hi+((lane&15)>>2))*64;
  const char*Kbase=shm+LDS_K; bf16x8 kf[8];
  const lds_cptr shm3=(lds_cptr)shm; const lds_cptr kp0=shm3+LDS_K+hi*1024+r32*16; const lds_cptr vp0=shm3+LDS_V+((lane>>4)&1)*32+(lane&3)*8+(4*hi+((lane&15)>>2))*64;
  constexpr int NT=NKT;
  DMA_K(0,0);DMA_V(0,0);DMA_K(1,SLOTB);
  bf16x8 qr[4];
  #pragma unroll
  for(int d0=0;d0<4;++d0)qr[d0]=*reinterpret_cast<const bf16x8*>(&Qw[(long)r32*QP+d0*16+hi*8]);
  float mhat=0.f,l_reg=0.f;f32x16 o[2];o[0]=f32x16{};o[1]=f32x16{};f32x16 negm=f32x16{};asm volatile("":"+v"(negm));
  #define CMASK(P0,P1,t) do{ if((t)>=NT-2) kmask(P0,P1,(t),hi);}while(0)
  bool resc=false;
  #define START(P0,P1) do{ const float rm=rowmax(P0,P1); resc=false; \
    { const float dl=rm; mhat=fadd_s(mhat,dl); \
      _Pragma("unroll") for(int r=0;r<16;++r){P0[r]=fsub_s(P0[r],dl);P1[r]=fsub_s(P1[r],dl);} \
      _Pragma("unroll") for(int r=0;r<16;++r)negm[r]=-mhat; asm volatile("":"+v"(negm)); } \
    _Pragma("unroll") for(int r=0;r<16;++r)P0[r]=__builtin_amdgcn_exp2f(P0[r]); }while(0)
  #define RESC() do{ if(resc){ asm volatile("s_waitcnt lgkmcnt(0)":::"memory"); \
      _Pragma("unroll") for(int d_=0;d_<2;++d_) _Pragma("unroll") for(int r=0;r<16;++r)o[d_][r]*=wsf[crow(r,hi)]; } }while(0)
  f32x16 pA0,pA1,pB0,pB1;
  int sl_prev=0,sl_cur=0,sl_next=SLOTB;
  #define ROT() do{sl_prev=sl_cur;sl_cur=sl_next;sl_next=(sl_next==(NSLOT-1)*SLOTB)?0:sl_next+SLOTB;}while(0)
  DMA_K(2,2*SLOTB);
  WAIT_BAR(3);
  qkt(pA0,pA1,Kbase,qr,negm,r32,hi);asm volatile("s_nop 15\n\ts_nop 7":"+v"(pA0),"+v"(pA1));CMASK(pA0,pA1,0);
  START(pA0,pA1);
  _Pragma("unroll") for(int r=0;r<16;++r)pA1[r]=__builtin_amdgcn_exp2f(pA1[r]);
  WAIT_BAR(0);
  DMA_K(3,0);DMA_V(1,SLOTB);
  ROT();
  kload8(kf,kp0+sl_cur);
  WAIT_BAR(2);
  s16x4 vlo[8],vhi[8]; u32x4 pw0,pw1,pw2,pw3;
  #define PKW(P,B) cvtpk_s(P[B],P[B+1])
  #define PAF(k) __builtin_bit_cast(bf16x8,pw##k)
  #define VFR(i) (bf16x8){vlo[i][0],vlo[i][1],vlo[i][2],vlo[i][3],vhi[i][0],vhi[i][1],vhi[i][2],vhi[i][3]}
  #define PIN(x) asm volatile("":"+v"(x))
  #define MX3(a,b,c) __builtin_fmaxf(__builtin_fmaxf((a),(b)),(c))
  #define GAPA(MF,A0,A1,A2,A3,W0,W1,PW) do{ MF; sacc+=A0; sacc+=A1; sacc+=A2; sacc+=A3; PIN(sacc); W0; W1; PIN(PW); SBAR(); }while(0)
  #define EX(v) __builtin_amdgcn_exp2f(v)
  #define GAPB(MF,X,B) do{ MF; X[B]=EX(X[B]); X[B+1]=EX(X[B+1]); X[B+2]=EX(X[B+2]); X[B+3]=EX(X[B+3]); PIN(X); SBAR(); }while(0)
  #define VRD(i) do{ vlo[i]=vtr(vp_+(((i)>>2)*4096+((i)&3)*1024)); vhi[i]=vtr(vp_+(((i)>>2)*4096+((i)&3)*1024+512)); }while(0)
  #define KRD(G,j) do{ if(G){ kload2(kf,kp0+sl_next,j); SBAR(); } }while(0)
  #define STEP(C0,C1,P0,P1,t,GK,GV,GL) do{ SBAR(); \
    const lds_cptr vp_=vp0+sl_prev; \
    VRD(0); SBAR(); float sacc=(P0[0]+P0[1]); \
    GAPA(C0=__builtin_amdgcn_mfma_f32_32x32x16_bf16(kf[0],qr[0],negm,0,0,0), P0[2],P0[3],P0[4],P0[5],     pw0[0]=PKW(P0,0), pw0[1]=PKW(P0,2), pw0); \
    VRD(4); SBAR(); GAPA(C1=__builtin_amdgcn_mfma_f32_32x32x16_bf16(kf[1],qr[0],negm,0,0,0), P0[6],P0[7],P0[8],P0[9],     pw0[2]=PKW(P0,4), pw0[3]=PKW(P0,6), pw0); \
    VRD(1); SBAR(); GAPA(C0=__builtin_amdgcn_mfma_f32_32x32x16_bf16(kf[2],qr[1],C0,0,0,0),   P0[10],P0[11],P0[12],P0[13], pw1[0]=PKW(P0,8), pw1[1]=PKW(P0,10), pw1); \
    VRD(5); SBAR(); GAPA(C1=__builtin_amdgcn_mfma_f32_32x32x16_bf16(kf[3],qr[1],C1,0,0,0),   P0[14],P0[15],P1[0],P1[1],   pw1[2]=PKW(P0,12),pw1[3]=PKW(P0,14), pw1); \
    VRD(2); SBAR(); GAPA(C0=__builtin_amdgcn_mfma_f32_32x32x16_bf16(kf[4],qr[2],C0,0,0,0),   P1[2],P1[3],P1[4],P1[5],     pw2[0]=PKW(P1,0), pw2[1]=PKW(P1,2), pw2); \
    VRD(6); SBAR(); GAPA(C1=__builtin_amdgcn_mfma_f32_32x32x16_bf16(kf[5],qr[2],C1,0,0,0),   P1[6],P1[7],P1[8],P1[9],     pw2[2]=PKW(P1,4), pw2[3]=PKW(P1,6), pw2); \
    VRD(3); SBAR(); GAPA(C0=__builtin_amdgcn_mfma_f32_32x32x16_bf16(kf[6],qr[3],C0,0,0,0),   P1[10],P1[11],P1[12],P1[13], pw3[0]=PKW(P1,8), pw3[1]=PKW(P1,10), pw3); \
    VRD(7); SBAR(); GAPA(C1=__builtin_amdgcn_mfma_f32_32x32x16_bf16(kf[7],qr[3],C1,0,0,0),   P1[14],P1[15],0.f,0.f,       pw3[2]=PKW(P1,12),pw3[3]=PKW(P1,14), pw3); \
    l_reg+=sacc; \
    if(GK){DMA_K((t)+3,sl_cur);} if(GV){DMA_V((t)+1,sl_next);} \
    CMASK(C0,C1,t); \
    { float a=MX3(C0[0],C0[1],C1[0]),b=MX3(C0[2],C0[3],C1[1]); a=MX3(a,C1[2],C1[3]); \
      _Pragma("unroll") for(int r=4;r<16;r+=4){a=MX3(a,C0[r],C0[r+1]);b=MX3(b,C0[r+2],C0[r+3]);a=MX3(a,C1[r],C1[r+1]);b=MX3(b,C1[r+2],C1[r+3]);} \
      float rm=__builtin_fmaxf(a,b); { auto rr=__builtin_amdgcn_permlane32_swap(__float_as_uint(rm),__float_as_uint(rm),false,false); rm=__builtin_fmaxf(__uint_as_float(rr[0]),__uint_as_float(rr[1])); } \
      resc=false; \
      if(__builtin_expect(__any(rm>(float)THRL),0)){ const float dl=__builtin_fmaxf(rm,0.f); mhat+=dl; \
        _Pragma("unroll") for(int r=0;r<16;++r){C0[r]-=dl;C1[r]-=dl;} \
        _Pragma("unroll") for(int r=0;r<16;++r)negm[r]=-mhat; asm volatile("":"+v"(negm)); \
        const float f=__builtin_amdgcn_exp2f(-dl); l_reg*=f; if(hi==0)wsf[r32]=f; resc=true; } } \
    SBAR(); \
    GAPB(o[0]=__builtin_amdgcn_mfma_f32_32x32x16_bf16(PAF(0),VFR(0),o[0],0,0,0), C0,0); \
    GAPB(o[1]=__builtin_amdgcn_mfma_f32_32x32x16_bf16(PAF(0),VFR(4),o[1],0,0,0), C0,4); \
    KRD(GL,0); GAPB(o[0]=__builtin_amdgcn_mfma_f32_32x32x16_bf16(PAF(1),VFR(1),o[0],0,0,0), C0,8); \
    KRD(GL,1); GAPB(o[1]=__builtin_amdgcn_mfma_f32_32x32x16_bf16(PAF(1),VFR(5),o[1],0,0,0), C0,12); \
    KRD(GL,2); GAPB(o[0]=__builtin_amdgcn_mfma_f32_32x32x16_bf16(PAF(2),VFR(2),o[0],0,0,0), C1,0); \
    KRD(GL,3); GAPB(o[1]=__builtin_amdgcn_mfma_f32_32x32x16_bf16(PAF(2),VFR(6),o[1],0,0,0), C1,4); \
    GAPB(o[0]=__builtin_amdgcn_mfma_f32_32x32x16_bf16(PAF(3),VFR(3),o[0],0,0,0), C1,8); \
    GAPB(o[1]=__builtin_amdgcn_mfma_f32_32x32x16_bf16(PAF(3),VFR(7),o[1],0,0,0), C1,12); \
    }while(0)
  int t=1;
  #undef CMASK
  #define CMASK(P0,P1,t) do{}while(0)
  for(;t+5<NT;t+=2){
    STEP(pB0,pB1,pA0,pA1,t,true,true,true);     WAIT_BAR(2); RESC(); ROT();
    STEP(pA0,pA1,pB0,pB1,t+1,true,true,true);   WAIT_BAR(2); RESC(); ROT();
  }
  #undef CMASK
  #define CMASK(P0,P1,t) do{ if((t)>=NT-2) kmask(P0,P1,(t),hi);}while(0)
  #define ENDW(tt) do{ if((tt)+3<NT){WAIT_BAR(2);} else if((tt)+2<NT){WAIT_BAR(1);} else {WAIT_BAR(0);} }while(0)
  for(;t+1<NT;t+=2){
    STEP(pB0,pB1,pA0,pA1,t,(t+3<NT),(t+1<NT),(t+1<NT));       ENDW(t);   RESC(); ROT();
    STEP(pA0,pA1,pB0,pB1,t+1,(t+4<NT),(t+2<NT),(t+2<NT));     ENDW(t+1); RESC(); ROT();
  }
  STEP(pB0,pB1,pA0,pA1,NT-1,false,false,false); RESC();
  { float sacc=pB0[0]+pB0[1]; _Pragma("unroll") for(int r=2;r<16;++r)sacc+=pB0[r]; _Pragma("unroll") for(int r=0;r<16;++r)sacc+=pB1[r]; l_reg+=sacc;
    pw0=(u32x4){PKW(pB0,0),PKW(pB0,2),PKW(pB0,4),PKW(pB0,6)};pw1=(u32x4){PKW(pB0,8),PKW(pB0,10),PKW(pB0,12),PKW(pB0,14)};pw2=(u32x4){PKW(pB1,0),PKW(pB1,2),PKW(pB1,4),PKW(pB1,6)};pw3=(u32x4){PKW(pB1,8),PKW(pB1,10),PKW(pB1,12),PKW(pB1,14)};
    SBAR(); pv(o,vb0+sl_cur,PAF(0),PAF(1),PAF(2),PAF(3)); }
  #undef PKW
  #undef PAF
  #undef VFR
  #undef PIN
  #undef MX3
  #undef GAPA
  #undef GAPB
  #undef EX
  #undef VRD
  #undef KRD
  #undef STEP
  #undef ENDW
  {auto rr=__builtin_amdgcn_permlane32_swap(__float_as_uint(l_reg),__float_as_uint(l_reg),false,false);l_reg=__uint_as_float(rr[0])+__uint_as_float(rr[1]);}
  if(hi==0)wsf[32+r32]=l_reg;asm volatile("s_waitcnt lgkmcnt(0)":::"memory");
  float rli[16];
  #pragma unroll
  for(int r=0;r<16;++r)rli[r]=__builtin_amdgcn_rcpf(wsf[32+crow(r,hi)]);
  bf16*Ow=Ou+(long)(wid*QBLK)*OP;
  { bf16*stg=(bf16*)(shm+LDS_OST)+wid*2048;
    #pragma unroll
    for(int r=0;r<16;++r){const int orow=crow(r,hi);
      #pragma unroll
      for(int d0=0;d0<2;++d0)stg[orow*64+d0*32+r32]=__float2bfloat16(o[d0][r]*rli[r]);}
    asm volatile("s_waitcnt lgkmcnt(0)":::"memory");
    #pragma unroll
    for(int i=0;i<4;++i){const int row=i*8+(lane>>3),ch=lane&7; const u32x4 v=*(const u32x4*)(stg+row*64+ch*8); ATTN_STORE16(Ow+(long)row*OP+ch*8,v);} }
  asm volatile("s_waitcnt lgkmcnt(0)\n\ts_barrier":::"memory");
  #undef DMA_K
  #undef DMA_V
  #undef CMASK
  #undef START
  #undef RESC
  #undef ROT
}
constexpr int ATTN_LDS_BYTES=LDS_BYTES;
#undef SBAR
#undef WAIT_BAR
}
#include <hip/hip_cooperative_groups.h>
namespace cg = cooperative_groups;
#define GAS __attribute__((address_space(1)))
#define LAS __attribute__((address_space(3)))
typedef unsigned short bf16;
typedef unsigned v4u __attribute__((ext_vector_type(4)));
typedef unsigned v2u __attribute__((ext_vector_type(2)));
typedef float f32x4 __attribute__((ext_vector_type(4)));
typedef short bf16x8 __attribute__((ext_vector_type(8)));

#ifndef ONE_LAUNCH
#define ONE_LAUNCH 1
#endif
constexpr int NWAVES = 8, NTHR = 512, NPHASE = 8;
constexpr int NB = 8, SEQ = 8192, NMETA = 16, LT = 8208, DM = 1024, MTOK = NB * LT, MP = 65792, MR = NB * SEQ, NIN = 3072, FF = 4096;
constexpr int LKP = 8320, NCH = 129, DNR = 8256;
constexpr float EPS = 1e-6f;
constexpr size_t MiB = 1u << 20;
constexpr size_t WS_CTL = 0, CTL_ZERO_BYTES = 1 * MiB;
constexpr size_t WS_WIN = 2 * MiB, WS_WOUT = 8 * MiB, WS_WUP = 10 * MiB, WS_WDN = 18 * MiB;
constexpr size_t WS_XN = 32 * MiB;
constexpr size_t WS_QN = WS_XN, WS_KN = WS_XN + (size_t)NB * DNR * 512 * 2;
constexpr size_t WS_DQKV = 162 * MiB;
constexpr size_t WS_CAT = WS_DQKV, WS_OF = WS_DQKV + 128 * MiB;
constexpr size_t WS_DZ = 355 * MiB;
constexpr size_t WS_AQKV = 420 * MiB;
constexpr size_t WS_OB = WS_AQKV;
constexpr size_t WS_BA = 517 * MiB;
constexpr size_t WS_Q = 522 * MiB;
constexpr size_t WS_KB = 586 * MiB, WS_VB = 603 * MiB;
constexpr size_t WS_CH = 620 * MiB;
constexpr size_t CH_BYTES = 41728, CH_W = 16384, CH_QK = 32768, CH_G = 40960;
constexpr size_t WS_MIX = 32 * MiB;
constexpr size_t WS_HID = 484 * MiB;
constexpr size_t WS_END = 996 * MiB;
static_assert(WS_KN + (size_t)NB * DNR * 512 * 2 <= WS_DQKV && WS_DQKV + (size_t)MP * 1536 * 2 <= WS_DZ && WS_DZ + (size_t)MP * 512 * 2 <= WS_AQKV && WS_AQKV + (size_t)MP * 768 * 2 <= WS_BA, "ws map 1");
static_assert(WS_BA + (size_t)MP * 16 * 4 <= WS_Q && WS_Q + (size_t)MR * 512 * 2 <= WS_KB && WS_KB + (size_t)NB * 2 * LKP * 64 * 2 <= WS_VB && WS_VB + (size_t)NB * 2 * LKP * 64 * 2 <= WS_CH, "ws map 2");
static_assert(WS_CH + CH_BYTES * (size_t)(NB * 2 * NCH * 4) <= WS_END && WS_OF + (size_t)MR * 512 * 2 <= WS_DZ && WS_OB + (size_t)MR * 512 * 2 <= WS_HID && WS_HID + (size_t)MR * FF * 2 <= WS_END && WS_MIX + (size_t)MR * DM * 2 <= WS_DQKV, "ws map 3");
constexpr int LDS_BYTES = 155648 + 256;
constexpr int XBST_OFF = 155648;
constexpr int QSLOT_OFF = 90112;
constexpr int P2_KN = 0, P2_QN = 17408, P2_VV = 34816, P2_RB = 52224, P2_KK = P2_RB, P2_QK = P2_RB + 16640, P2_AS = P2_RB + 33280, P2_CW = 118272, P2_SC = 125952;
constexpr int SC_ST = 0, SC_VT = 34816, SC_W = 53248, SC_Q = 70656, SC_KT = 88064, SC_QK = 106496, SC_U = 115712, SC_O = 134144;

typedef float f32x2_c __attribute__((ext_vector_type(2))); typedef __bf16 bf16x2_c __attribute__((ext_vector_type(2)));
__device__ __forceinline__ unsigned pk2(float lo, float hi) { const f32x2_c v = {lo, hi}; return __builtin_bit_cast(unsigned, __builtin_convertvector(v, bf16x2_c)); }
__device__ __forceinline__ unsigned f2bf(float f) { return pk2(f, 0.f) & 0xffffu; }
__device__ __forceinline__ float bf2f(unsigned short u) { return __builtin_bit_cast(float, (unsigned)u << 16); }
__device__ __forceinline__ void unpack8(const v4u v, float* o) {
#pragma unroll
    for (int i = 0; i < 4; ++i) { o[2 * i] = __builtin_bit_cast(float, v[i] << 16); o[2 * i + 1] = __builtin_bit_cast(float, v[i] & 0xffff0000u); }
}
__device__ __forceinline__ v4u pack8(const float* o) { v4u v; v.x = pk2(o[0], o[1]); v.y = pk2(o[2], o[3]); v.z = pk2(o[4], o[5]); v.w = pk2(o[6], o[7]); return v; }
__device__ __forceinline__ unsigned xcc_id() { return (unsigned)__builtin_amdgcn_s_getreg((3 << 11) | 20) & 0xFu; }
__device__ __forceinline__ float wave_sum(float v) {
#pragma unroll
    for (int o = 1; o < 64; o <<= 1) v += __shfl_xor(v, o);
    return v;
}
__device__ __forceinline__ float bperm_f(int srclane, float v) { return __builtin_bit_cast(float, __builtin_amdgcn_ds_bpermute(srclane << 2, __builtin_bit_cast(int, v))); }
__device__ __forceinline__ float silu_f(float y) { return y * __builtin_amdgcn_rcpf(1.f + __expf(-y)); }

struct Args { const float* in[16]; float* out; unsigned char* ws; int ph_lo, ph_hi; };

template <int MODE> __device__ __forceinline__ void p0_transpose_item(const float* W, int K, int Nsrc, int Ndst, bf16* WT, LAS float* scr, int item, int lane) {
    const int nblk = Ndst / 32, kb = item / nblk, nb = item % nblk, k0 = 64 * kb, n0 = 32 * nb;
    const int c4 = (lane & 7) * 4, nd = n0 + c4;
    const int src = MODE == 0 ? nd : (nd < 2048 ? nd : (nd < 2816 ? nd + 16 : (nd < 2832 ? nd - 2816 + 2048 : -1)));
    const int srcc = src >= 0 ? src : 0;
#pragma unroll
    for (int i = 0; i < 8; ++i) { const int kk = 8 * i + (lane >> 3); f32x4 v = *(const f32x4*)(W + (size_t)(k0 + kk) * Nsrc + srcc); if (src < 0) v = (f32x4){0.f, 0.f, 0.f, 0.f};
        LAS float* d = scr + kk * 33 + c4; d[0] = v[0]; d[1] = v[1]; d[2] = v[2]; d[3] = v[3]; }
    asm volatile("s_waitcnt lgkmcnt(0)" ::: "memory");
    const int c = lane & 7;
#pragma unroll
    for (int j = 0; j < 4; ++j) { const int n = (lane >> 3) + 8 * j; const LAS float* s = scr + (8 * c) * 33 + n;
        v4u o; o.x = pk2(s[0 * 33], s[1 * 33]); o.y = pk2(s[2 * 33], s[3 * 33]); o.z = pk2(s[4 * 33], s[5 * 33]); o.w = pk2(s[6 * 33], s[7 * 33]);
        *(v4u*)(WT + (size_t)(n0 + n) * K + k0 + 8 * c) = o; }
    asm volatile("s_waitcnt lgkmcnt(0)" ::: "memory");
}
__device__ __forceinline__ void rms_row_to_bf16(const float* xrow, const float* w, bf16* orow, int lane) {
    const f32x4* xr = (const f32x4*)xrow + lane; const f32x4* wr = (const f32x4*)w + lane;
    f32x4 v[4]; float s = 0.f;
#pragma unroll
    for (int j = 0; j < 4; ++j) { v[j] = xr[64 * j]; s += (v[j].x * v[j].x + v[j].y * v[j].y) + (v[j].z * v[j].z + v[j].w * v[j].w); }
    const float rs = __builtin_amdgcn_rsqf(wave_sum(s) * (1.f / DM) + EPS);
    v2u* o8 = (v2u*)orow + lane;
#pragma unroll
    for (int j = 0; j < 4; ++j) { const f32x4 ww = wr[64 * j]; v2u o; o.x = pk2(v[j].x * rs * ww.x, v[j].y * rs * ww.y); o.y = pk2(v[j].z * rs * ww.z, v[j].w * rs * ww.w); o8[64 * j] = o; }
}
constexpr int ROPE_OFF = 131072;
__device__ __forceinline__ void attn_prep_row(const v4u qd, const v4u kd, const LAS float* rope, const float* qw, const float* kw, bf16* Q, bf16* KB, bf16* VB, int b, int t, int lane) {
    if (t >= LT) {
        if (lane < 32) { const int l = lane & 15, kvh = l >> 3, sub = l & 7; bf16* dst = (lane < 16 ? KB : VB) + ((size_t)(b * 2 + kvh) * LKP + t) * 64 + sub * 8; *(v4u*)dst = (v4u){0u, 0u, 0u, 0u}; }
        return;
    }
    const bool real = t >= NMETA; const int s = real ? t - NMETA : 0;
    const int sub = lane & 7, axis = sub >> 2, half = (sub >> 1) & 1, f0 = (sub & 1) * 8;
    const int pos = axis == 0 ? (s >> 6) : (s & 63);
    float cs[8], sn[8];
    { const f32x4 c0 = *(const LAS f32x4*)(rope + pos * 16 + f0), c1 = *(const LAS f32x4*)(rope + pos * 16 + f0 + 4), s0 = *(const LAS f32x4*)(rope + 2048 + pos * 16 + f0), s1 = *(const LAS f32x4*)(rope + 2048 + pos * 16 + f0 + 4);
#pragma unroll
      for (int e = 0; e < 4; ++e) { cs[e] = real ? c0[e] : 1.f; cs[4 + e] = real ? c1[e] : 1.f; sn[e] = real ? s0[e] : 0.f; sn[4 + e] = real ? s1[e] : 0.f; } }
    { float q[8]; unpack8(qd, q); float ss = 0.f;
#pragma unroll
      for (int e = 0; e < 8; ++e) ss += q[e] * q[e];
      ss += __shfl_xor(ss, 1); ss += __shfl_xor(ss, 2); ss += __shfl_xor(ss, 4);
      const float rs = __builtin_amdgcn_rsqf(ss * (1.f / 64.f) + EPS); float o[8];
#pragma unroll
      for (int e = 0; e < 8; ++e) q[e] = q[e] * rs * qw[sub * 8 + e];
#pragma unroll
      for (int e = 0; e < 8; ++e) { const float pr = __shfl_xor(q[e], 2); o[e] = (half == 0 ? q[e] * cs[e] - pr * sn[e] : q[e] * cs[e] + pr * sn[e]) * attn_body::C2; }
      if (real) *(v4u*)(Q + ((size_t)(b * SEQ + s)) * 512 + lane * 8) = pack8(o); }
    { const int l = lane & 15, kvh = l >> 3; float k[8]; unpack8(kd, k); float ss = 0.f;
#pragma unroll
      for (int e = 0; e < 8; ++e) ss += k[e] * k[e];
      ss += __shfl_xor(ss, 1); ss += __shfl_xor(ss, 2); ss += __shfl_xor(ss, 4);
      const float rs = __builtin_amdgcn_rsqf(ss * (1.f / 64.f) + EPS); float o[8];
#pragma unroll
      for (int e = 0; e < 8; ++e) k[e] = k[e] * rs * kw[sub * 8 + e];
#pragma unroll
      for (int e = 0; e < 8; ++e) { const float pr = __shfl_xor(k[e], 2); o[e] = half == 0 ? k[e] * cs[e] - pr * sn[e] : k[e] * cs[e] + pr * sn[e]; }
      if (lane < 16) *(v4u*)(KB + ((size_t)(b * 2 + kvh) * LKP + t) * 64 + sub * 8) = pack8(o);
      else if (lane < 32) *(v4u*)(VB + ((size_t)(b * 2 + kvh) * LKP + t) * 64 + sub * 8) = kd; }
}

#define DN_ISSUE(item_, rawv, cwv, pbb, paa, td, ln) do { \
    const int h_ = (item_) & 3, tc_ = ((item_) >> 2) % NCH, b_ = (item_) / (4 * NCH), t0_ = 64 * tc_ - 48; \
    pbb = 0.f; paa = 0.f; \
    if (wave < 2) { const int dir_ = wave; const bool rev_ = dir_ && tc_ > 0; const int j_ = rev_ ? 63 - (ln) : (ln), t_ = t0_ + j_, tq_ = t_ < 0 ? 0 : t_; \
        const float* ba_ = BA + (size_t)(b_ * LT + tq_) * 16; const float vb_ = ba_[dir_ * 4 + h_], va_ = ba_[8 + dir_ * 4 + h_]; pbb = t_ >= 0 ? vb_ : 0.f; paa = t_ >= 0 ? va_ : 0.f; } \
      \
    _Pragma("unroll") for (int e_ = 0; e_ < 4; ++e_) { const int i_ = (td) + NTHR * e_, ic_ = i_ < 5 * 384 ? i_ : 5 * 384 - 1; const int w_ = ic_ / 384, c_ = ic_ % 384, sec_ = c_ >> 7; cwv[e_] = conv_w[w_ * 1536 + sec_ * 512 + h_ * 128 + (c_ & 127)]; } \
    _Pragma("unroll") for (int e_ = 0; e_ < 7; ++e_) { const int i_ = (td) + NTHR * e_, ic_ = i_ < 68 * 48 ? i_ : 68 * 48 - 1, rr_ = ic_ / 48, ck_ = ic_ % 48, sec_ = ck_ >> 4, t_ = t0_ - 2 + rr_; \
        const int tq_ = t_ < 0 ? 0 : (t_ >= LT ? LT - 1 : t_); const v4u v_ = *(const v4u*)(DQKV + (size_t)(b_ * LT + tq_) * 1536 + sec_ * 512 + h_ * 128 + (ck_ & 15) * 8); \
        const bool ok_ = (t_ == tq_); rawv[e_].x = ok_ ? v_.x : 0u; rawv[e_].y = ok_ ? v_.y : 0u; rawv[e_].z = ok_ ? v_.z : 0u; rawv[e_].w = ok_ ? v_.w : 0u; } } while (0)
__device__ __forceinline__ void dn_prep_item(const Args& A, LAS unsigned char* lds, int item, int next_item, v4u (&rawv)[7], float (&cwv)[4], float& pbb, float& paa, int tid, int wave, int lane) {
    unsigned char* ws = A.ws;
    int ln = lane, td = tid; asm volatile("" : "+v"(ln), "+v"(td));
    const bf16* DQKV = (const bf16*)(ws + WS_DQKV); const float* BA = (const float*)(ws + WS_BA);
    bf16* QN = (bf16*)(ws + WS_QN); bf16* KN = (bf16*)(ws + WS_KN);
    const float* conv_w = A.in[3]; const float* a_log = A.in[4]; const float* dt_bias = A.in[5];
    const int h = item & 3, tc = (item >> 2) % NCH, b = item / (4 * NCH);
    const int t0 = 64 * tc - 48;
    LAS bf16* KNs = (LAS bf16*)(lds + P2_KN); LAS bf16* QNs = (LAS bf16*)(lds + P2_QN); LAS bf16* VVs = (LAS bf16*)(lds + P2_VV);
    LAS bf16* raw = (LAS bf16*)(lds + P2_RB); LAS float* cw = (LAS float*)(lds + P2_CW);
    LAS float* KKs = (LAS float*)(lds + P2_KK); LAS float* QKs = (LAS float*)(lds + P2_QK);
    LAS float* gcS = (LAS float*)(lds + P2_SC); LAS float* betaS = gcS + 128; LAS float* egS = gcS + 256;
    DN_ISSUE(item, rawv, cwv, pbb, paa, td, ln);
    const float cbb = pbb, caa = paa;
#pragma unroll
    for (int e = 0; e < 4; ++e) { const int i = td + NTHR * e; if (i < 5 * 384) cw[i] = cwv[e]; }
#pragma unroll
    for (int e = 0; e < 7; ++e) { const int i = td + NTHR * e, rr = i / 48, ck = i % 48; if (i < 68 * 48) *(LAS v4u*)(raw + rr * 392 + ck * 8) = rawv[e]; }
    __syncthreads();
    { v4u rwv[2][6]; f32x4 cvv[2][5][2];
#define CONV_LOAD(e_, S_) do { const int idx_ = td + NTHR * (e_), jp_ = idx_ / 48, ck_ = idx_ - 48 * jp_; \
        _Pragma("unroll") for (int w_ = 0; w_ < 5; ++w_) { cvv[S_][w_][0] = *(const LAS f32x4*)(cw + w_ * 384 + ck_ * 8); cvv[S_][w_][1] = *(const LAS f32x4*)(cw + w_ * 384 + ck_ * 8 + 4); } \
        _Pragma("unroll") for (int r_ = 0; r_ < 6; ++r_) rwv[S_][r_] = *(const LAS v4u*)(raw + (2 * jp_ + r_) * 392 + ck_ * 8); } while (0)
      CONV_LOAD(0, 0);
#pragma unroll
      for (int e = 0; e < 3; ++e) { const int idx = td + NTHR * e, jp = idx / 48, ck = idx - 48 * jp, sec = ck >> 4, c16 = ck & 15, j0 = 2 * jp;
        if (e == 0) CONV_LOAD(1, 1); else if (e == 1) CONV_LOAD(2, 0);
        float y[2][8];
#pragma unroll
        for (int k = 0; k < 8; ++k) { y[0][k] = 0.f; y[1][k] = 0.f; }
#pragma unroll
        for (int r = 0; r < 6; ++r) { float x[8]; unpack8(rwv[e & 1][r], x);
            if (r <= 4) {
#pragma unroll
                for (int k = 0; k < 4; ++k) { y[0][k] += x[k] * cvv[e & 1][r][0][k]; y[0][4 + k] += x[4 + k] * cvv[e & 1][r][1][k]; } }
            if (r >= 1) {
#pragma unroll
                for (int k = 0; k < 4; ++k) { y[1][k] += x[k] * cvv[e & 1][r - 1][0][k]; y[1][4 + k] += x[4 + k] * cvv[e & 1][r - 1][1][k]; } } }
#pragma unroll
        for (int u = 0; u < 2; ++u) { const int j = j0 + u;
            const float vm = (t0 + j) >= 0 ? 1.f : 0.f; float ss = 0.f;
#pragma unroll
            for (int k = 0; k < 8; ++k) { y[u][k] = y[u][k] * __builtin_amdgcn_rcpf(1.f + __expf(-y[u][k])) * vm; ss += y[u][k] * y[u][k]; }
            ss += bperm_f(ln ^ 1, ss); ss += bperm_f(ln ^ 2, ss); ss += bperm_f(ln ^ 4, ss); ss += bperm_f(ln ^ 8, ss);
            const float rq = __builtin_amdgcn_rsqf(ss + EPS); const float sc = sec == 2 ? 1.f : (sec == 0 ? 0.08838834764831845f * rq : rq);
#pragma unroll
            for (int k = 0; k < 8; ++k) y[u][k] *= sc;
            const v4u o = pack8(y[u]);
            LAS bf16* dl = (sec == 0 ? QNs : (sec == 1 ? KNs : VVs)) + j * 136 + c16 * 8; *(LAS v4u*)dl = o;
            if (sec < 2) *(v4u*)((sec == 0 ? QN : KN) + ((size_t)b * DNR + 64 * tc + j) * 512 + h * 128 + c16 * 8) = o; } }
#undef CONV_LOAD
    }
    __syncthreads();
    { const int fr = ln & 15, fq = ln >> 4, which = wave >> 2, ti = wave & 3;
      const LAS bf16* Ap = (which ? QNs : KNs) + (ti * 16 + fr) * 136 + fq * 8;
      bf16x8 af[4], bq[4][4];
#pragma unroll
      for (int ks = 0; ks < 4; ++ks) af[ks] = *(const LAS bf16x8*)(Ap + ks * 32);
#pragma unroll
      for (int tj = 0; tj < 4; ++tj) {
#pragma unroll
          for (int ks = 0; ks < 4; ++ks) bq[tj][ks] = *(const LAS bf16x8*)(KNs + (tj * 16 + fr) * 136 + fq * 8 + ks * 32); }
      f32x4 acc[4];
#pragma unroll
      for (int tj = 0; tj < 4; ++tj) acc[tj] = (f32x4){0.f, 0.f, 0.f, 0.f};
#pragma unroll
      for (int ks = 0; ks < 4; ++ks) {
#pragma unroll
          for (int tj = 0; tj < 4; ++tj) acc[tj] = __builtin_amdgcn_mfma_f32_16x16x32_bf16(af[ks], bq[tj][ks], acc[tj], 0, 0, 0); }
      LAS float* dst = which ? QKs : KKs;
#pragma unroll
      for (int tj = 0; tj < 4; ++tj) {
#pragma unroll
          for (int r = 0; r < 4; ++r) dst[(ti * 16 + 4 * fq + r) * 65 + tj * 16 + fr] = acc[tj][r]; } }
    if (wave < 2) { const int dir = wave, i = ln; const bool rev = dir && tc > 0; const int j = rev ? 63 - i : i, t = t0 + j;
        float beta = 0.f, g = 0.f;
        if (t >= 0) { const float bb = cbb, aa = caa;
            beta = 1.f / (1.f + expf(-bb)); const float x = aa + dt_bias[dir * 4 + h]; const float sp = x > 20.f ? x : log1pf(expf(x)); g = -expf(a_log[dir * 4 + h]) * sp; }
        float gc = g;
#pragma unroll
        for (int o = 1; o < 64; o <<= 1) { const float v = bperm_f(ln - o, gc); if (ln >= o) gc += v; }
        const float gl = bperm_f(63, gc);
        const float eg_ = __expf(gc);
        gcS[dir * 64 + i] = gc; betaS[dir * 64 + i] = beta; egS[dir * 64 + i] = eg_ * beta;
        float* G = (float*)(ws + WS_CH + CH_BYTES * (size_t)((((b * 2 + dir) * NCH + tc) * 4) + h) + CH_G);
        G[j] = eg_; G[64 + j] = __expf(gl - gc); if (i == 0) G[128] = __expf(gl); }
    __syncthreads();
    const int dir = td >> 8; const bool rev = dir && tc > 0;
    unsigned char* chunk = ws + WS_CH + CH_BYTES * (size_t)((((b * 2 + dir) * NCH + tc) * 4) + h);
    LAS float* As = (LAS float*)(lds + P2_AS) + dir * 4096;
    { LAS bf16* QKo = (LAS bf16*)(lds + P2_QN) + dir * 4096;
      const int ip = td & 63, i0_ = (td & 255) >> 6, jp = rev ? 63 - ip : ip;
      const float gp = gcS[dir * 64 + ip];
      float kkv[16], qkv[16], giv[16], biv[16];
#pragma unroll
      for (int e = 0; e < 16; ++e) { const int i = i0_ + 4 * e, j = rev ? 63 - i : i;
          kkv[e] = KKs[j * 65 + jp]; qkv[e] = QKs[j * 65 + jp]; giv[e] = gcS[dir * 64 + i]; biv[e] = betaS[dir * 64 + i]; }
#pragma unroll
      for (int e = 0; e < 16; ++e) { const int i = i0_ + 4 * e, j = rev ? 63 - i : i;
          const float dec = __expf(fminf(giv[e] - gp, 0.f));
          As[i * 64 + ip] = ip < i ? kkv[e] * dec * biv[e] : 0.f;
          QKo[j * 64 + jp] = (bf16)f2bf(ip <= i ? qkv[e] * dec : 0.f); } }
    __syncthreads();
    { unsigned char* cb = ws + WS_CH + CH_BYTES * (size_t)((((b * 2) * NCH + tc) * 4) + h);
#pragma unroll
      for (int e = 0; e < 2; ++e) { const int id = td + NTHR * e, d_ = id >> 9, rest = id & 511, row = rest >> 3, c8 = rest & 7;
          *(v4u*)(cb + (size_t)d_ * (CH_BYTES * NCH * 4) + CH_QK + row * 128 + c8 * 16) = *(const LAS v4u*)(lds + P2_QN + d_ * 8192 + row * 128 + c8 * 16); } }
    { typedef float f32x2 __attribute__((ext_vector_type(2)));
      const int col = td & 255; const bool isU = col < 128; const LAS bf16* src = isU ? VVs + col : KNs + (col - 128);
      const int jb = rev ? 63 : 0, js = rev ? -1 : 1;
      f32x2 x2[32];
      { const LAS bf16* sp = src + jb * 136; const int sstep = js * 136; const LAS float* scp = (isU ? betaS : egS) + dir * 64; asm volatile("" : "+v"(scp));
#pragma unroll
      for (int i = 0; i < 64; ++i) { x2[i >> 1][i & 1] = bf2f(*sp) * scp[i]; sp += sstep; asm volatile("" : "+v"(sp)); if ((i & 7) == 7) { asm volatile("" : "+v"(x2[i >> 1]) :: "memory"); __builtin_amdgcn_sched_barrier(0); } } }
      __syncthreads();
#pragma unroll
      for (int i = 1; i < 64; ++i) {
          f32x2 a01 = (f32x2){0.f, 0.f}, a23 = (f32x2){0.f, 0.f};
#pragma unroll
          for (int q = 0; 4 * q < i; ++q) { const f32x4 a = *(const LAS f32x4*)(As + i * 64 + 4 * q);
              a01 += (f32x2){a[0], a[1]} * x2[2 * q]; a23 += (f32x2){a[2], a[3]} * x2[2 * q + 1]; }
          const f32x2 t = a01 + a23; x2[i >> 1][i & 1] -= (t.x + t.y); asm volatile("" : "+v"(x2[i >> 1])); }
      { LAS bf16* xp = (LAS bf16*)lds + dir * 16384 + jb * 256 + col; const int xstep = js * 256;
#pragma unroll
      for (int i = 0; i < 64; ++i) { *xp = (bf16)f2bf(x2[i >> 1][i & 1]); xp += xstep; asm volatile("" : "+v"(xp)); } } }
    __syncthreads();
    { unsigned char* cb = ws + WS_CH + CH_BYTES * (size_t)((((b * 2) * NCH + tc) * 4) + h); int tl = td; asm volatile("" : "+v"(tl));
#pragma unroll
      for (int e = 0; e < 8; ++e) { const int id = tl + NTHR * e, d_ = id >> 11, rest = id & 2047, row = rest >> 5, c = rest & 31;
          *(v4u*)(cb + (size_t)d_ * (CH_BYTES * NCH * 4) + (c < 16 ? 0 : CH_W) + row * 256 + (c & 15) * 16) = *(const LAS v4u*)(lds + d_ * 32768 + row * 512 + c * 16); } }
    __syncthreads();
}

__device__ __forceinline__ void dn_scan(const Args& A, LAS unsigned char* lds, int chain, int tid, int wave, int lane) {
    unsigned char* ws = A.ws;
    const int b = chain >> 3, dir = (chain >> 2) & 1, h = chain & 3;
    const bf16* QN = (const bf16*)(ws + WS_QN); const bf16* KN = (const bf16*)(ws + WS_KN);
    bf16* Od = (bf16*)(ws + (dir ? WS_OB : WS_OF));
    LAS bf16* St = (LAS bf16*)(lds + SC_ST); LAS bf16* VT = (LAS bf16*)(lds + SC_VT); LAS bf16* Ws = (LAS bf16*)(lds + SC_W); LAS bf16* Qs = (LAS bf16*)(lds + SC_Q);
    LAS bf16* KT = (LAS bf16*)(lds + SC_KT); LAS bf16* QKs = (LAS bf16*)(lds + SC_QK); LAS bf16* Us = (LAS bf16*)(lds + SC_U); LAS bf16* Os = (LAS bf16*)(lds + SC_O);
    const int fr = lane & 15, fq = lane >> 4, vrow = 16 * wave + fr;
    f32x4 S[8];
#pragma unroll
    for (int m = 0; m < 8; ++m) S[m] = (f32x4){0.f, 0.f, 0.f, 0.f};
#pragma unroll
    for (int q = 0; q < 4; ++q) *(LAS v4u*)(St + vrow * 136 + fq * 32 + q * 8) = (v4u){0u, 0u, 0u, 0u};
    v4u rU0[2], rW0[2], rQ0[2], rK0[2], rQK0; float g10[2], g20[2], glp0;
    v4u rU1[2], rW1[2], rQ1[2], rK1[2], rQK1; float g11[2], g21[2], glp1;
#define SC_PREFETCH(s_, X) do { const int tc_ = (dir == 0 || (s_) == 0) ? (s_) : NCH - (s_); \
        const unsigned char* ck_ = ws + WS_CH + CH_BYTES * (size_t)((((b * 2 + dir) * NCH + tc_) * 4) + h); const float* G_ = (const float*)(ck_ + CH_G); \
        _Pragma("unroll") for (int i_ = 0; i_ < 2; ++i_) { const int id_ = tid + NTHR * i_, row_ = id_ >> 4, c16_ = id_ & 15; \
            rU##X[i_] = *(const v4u*)(ck_ + row_ * 256 + c16_ * 16); rW##X[i_] = *(const v4u*)(ck_ + CH_W + row_ * 256 + c16_ * 16); \
            const size_t qo_ = ((size_t)b * DNR + 64 * tc_ + row_) * 512 + h * 128 + c16_ * 8; rQ##X[i_] = *(const v4u*)(QN + qo_); rK##X[i_] = *(const v4u*)(KN + qo_); \
            g1##X[i_] = G_[row_]; g2##X[i_] = G_[64 + row_]; } \
        rQK##X = *(const v4u*)(ck_ + CH_QK + tid * 16); glp##X = G_[128]; } while (0)
    SC_PREFETCH(0, 0); SC_PREFETCH(1, 1);
#pragma unroll 1
    for (int s2 = 0; s2 < NCH; s2 += 2) {
      { const int s = s2;
        const int tc = (dir == 0 || s == 0) ? s : NCH - s;
        __syncthreads();
        const float gl = glp0;
        if (s > 0) { const int tcp = (dir == 0 || s == 1) ? s - 1 : NCH - (s - 1);
            if (tcp >= 1) {
#pragma unroll
                for (int i = 0; i < 2; ++i) { const int id = tid + NTHR * i, row = id >> 4, c16 = id & 15;
                    *(v4u*)(Od + ((size_t)b * SEQ + 64 * (tcp - 1) + row) * 512 + h * 128 + c16 * 8) = *(const LAS v4u*)(Os + row * 136 + c16 * 8); } } }
#pragma unroll
        for (int i = 0; i < 2; ++i) { const int id = tid + NTHR * i, row = id >> 4, c16 = id & 15;
            *(LAS v4u*)(Us + row * 136 + c16 * 8) = rU0[i]; *(LAS v4u*)(Ws + row * 136 + c16 * 8) = rW0[i];
            float q[8]; unpack8(rQ0[i], q);
#pragma unroll
            for (int e = 0; e < 8; ++e) q[e] *= g10[i];
            *(LAS v4u*)(Qs + row * 136 + c16 * 8) = pack8(q);
            float k[8]; unpack8(rK0[i], k);
#pragma unroll
            for (int e = 0; e < 8; ++e) KT[(c16 * 8 + e) * 72 + ((((row >> 3) ^ (c16 & 7)) << 3) | (row & 7))] = (bf16)f2bf(k[e] * g20[i]); }
        *(LAS v4u*)(QKs + (tid >> 3) * 72 + (tid & 7) * 8) = rQK0;
        __syncthreads();
        { const int sn_ = s + 2 < NCH ? s + 2 : NCH - 1; SC_PREFETCH(sn_, 0); }
        bf16x8 bS[4];
#pragma unroll
        for (int ks = 0; ks < 4; ++ks) bS[ks] = *(const LAS bf16x8*)(St + vrow * 136 + ks * 32 + fq * 8);
#pragma unroll
        for (int mt = 0; mt < 4; ++mt) { f32x4 acc = (f32x4){0.f, 0.f, 0.f, 0.f};
#pragma unroll
            for (int ks = 0; ks < 4; ++ks) acc = __builtin_amdgcn_mfma_f32_16x16x32_bf16(*(const LAS bf16x8*)(Ws + (16 * mt + fr) * 136 + ks * 32 + fq * 8), bS[ks], acc, 0, 0, 0);
            float vn[4];
#pragma unroll
            for (int r = 0; r < 4; ++r) vn[r] = bf2f(Us[(16 * mt + 4 * fq + r) * 136 + vrow]) - acc[r];
            v2u o; o.x = pk2(vn[0], vn[1]); o.y = pk2(vn[2], vn[3]); *(LAS v2u*)(VT + vrow * 72 + 16 * mt + 4 * fq) = o; }
        asm volatile("s_waitcnt lgkmcnt(0)" ::: "memory");
        bf16x8 bV[2];
#pragma unroll
        for (int ks = 0; ks < 2; ++ks) bV[ks] = *(const LAS bf16x8*)(VT + vrow * 72 + ks * 32 + fq * 8);
#pragma unroll
        for (int mt = 0; mt < 4; ++mt) { f32x4 acc = (f32x4){0.f, 0.f, 0.f, 0.f};
#pragma unroll
            for (int ks = 0; ks < 4; ++ks) acc = __builtin_amdgcn_mfma_f32_16x16x32_bf16(*(const LAS bf16x8*)(Qs + (16 * mt + fr) * 136 + ks * 32 + fq * 8), bS[ks], acc, 0, 0, 0);
#pragma unroll
            for (int ks = 0; ks < 2; ++ks) acc = __builtin_amdgcn_mfma_f32_16x16x32_bf16(*(const LAS bf16x8*)(QKs + (16 * mt + fr) * 72 + ks * 32 + fq * 8), bV[ks], acc, 0, 0, 0);
            if (tc >= 1) {
#pragma unroll
                for (int r = 0; r < 4; ++r) Os[(16 * mt + 4 * fq + r) * 136 + vrow] = (bf16)f2bf(acc[r]); } }
#pragma unroll
        for (int mt = 0; mt < 8; ++mt) { f32x4 acc = S[mt] * gl;
#pragma unroll
            for (int ks = 0; ks < 2; ++ks) acc = __builtin_amdgcn_mfma_f32_16x16x32_bf16(*(const LAS bf16x8*)(KT + (16 * mt + fr) * 72 + (((4 * ks + fq) ^ ((2 * mt + (fr >> 3)) & 7)) << 3)), bV[ks], acc, 0, 0, 0);
            S[mt] = acc; v2u o; o.x = pk2(acc[0], acc[1]); o.y = pk2(acc[2], acc[3]); *(LAS v2u*)(St + vrow * 136 + 16 * mt + 4 * fq) = o; }
        asm volatile("s_waitcnt lgkmcnt(0)" ::: "memory");
      }
      if (s2 + 1 < NCH) { const int s = s2 + 1;
        const int tc = (dir == 0 || s == 0) ? s : NCH - s;
        __syncthreads();
        const float gl = glp1;
        if (s > 0) { const int tcp = (dir == 0 || s == 1) ? s - 1 : NCH - (s - 1);
            if (tcp >= 1) {
#pragma unroll
                for (int i = 0; i < 2; ++i) { const int id = tid + NTHR * i, row = id >> 4, c16 = id & 15;
                    *(v4u*)(Od + ((size_t)b * SEQ + 64 * (tcp - 1) + row) * 512 + h * 128 + c16 * 8) = *(const LAS v4u*)(Os + row * 136 + c16 * 8); } } }
#pragma unroll
        for (int i = 0; i < 2; ++i) { const int id = tid + NTHR * i, row = id >> 4, c16 = id & 15;
            *(LAS v4u*)(Us + row * 136 + c16 * 8) = rU1[i]; *(LAS v4u*)(Ws + row * 136 + c16 * 8) = rW1[i];
            float q[8]; unpack8(rQ1[i], q);
#pragma unroll
            for (int e = 0; e < 8; ++e) q[e] *= g11[i];
            *(LAS v4u*)(Qs + row * 136 + c16 * 8) = pack8(q);
            float k[8]; unpack8(rK1[i], k);
#pragma unroll
            for (int e = 0; e < 8; ++e) KT[(c16 * 8 + e) * 72 + ((((row >> 3) ^ (c16 & 7)) << 3) | (row & 7))] = (bf16)f2bf(k[e] * g21[i]); }
        *(LAS v4u*)(QKs + (tid >> 3) * 72 + (tid & 7) * 8) = rQK1;
        __syncthreads();
        { const int sn_ = s + 2 < NCH ? s + 2 : NCH - 1; SC_PREFETCH(sn_, 1); }
        bf16x8 bS[4];
#pragma unroll
        for (int ks = 0; ks < 4; ++ks) bS[ks] = *(const LAS bf16x8*)(St + vrow * 136 + ks * 32 + fq * 8);
#pragma unroll
        for (int mt = 0; mt < 4; ++mt) { f32x4 acc = (f32x4){0.f, 0.f, 0.f, 0.f};
#pragma unroll
            for (int ks = 0; ks < 4; ++ks) acc = __builtin_amdgcn_mfma_f32_16x16x32_bf16(*(const LAS bf16x8*)(Ws + (16 * mt + fr) * 136 + ks * 32 + fq * 8), bS[ks], acc, 0, 0, 0);
            float vn[4];
#pragma unroll
            for (int r = 0; r < 4; ++r) vn[r] = bf2f(Us[(16 * mt + 4 * fq + r) * 136 + vrow]) - acc[r];
            v2u o; o.x = pk2(vn[0], vn[1]); o.y = pk2(vn[2], vn[3]); *(LAS v2u*)(VT + vrow * 72 + 16 * mt + 4 * fq) = o; }
        asm volatile("s_waitcnt lgkmcnt(0)" ::: "memory");
        bf16x8 bV[2];
#pragma unroll
        for (int ks = 0; ks < 2; ++ks) bV[ks] = *(const LAS bf16x8*)(VT + vrow * 72 + ks * 32 + fq * 8);
#pragma unroll
        for (int mt = 0; mt < 4; ++mt) { f32x4 acc = (f32x4){0.f, 0.f, 0.f, 0.f};
#pragma unroll
            for (int ks = 0; ks < 4; ++ks) acc = __builtin_amdgcn_mfma_f32_16x16x32_bf16(*(const LAS bf16x8*)(Qs + (16 * mt + fr) * 136 + ks * 32 + fq * 8), bS[ks], acc, 0, 0, 0);
#pragma unroll
            for (int ks = 0; ks < 2; ++ks) acc = __builtin_amdgcn_mfma_f32_16x16x32_bf16(*(const LAS bf16x8*)(QKs + (16 * mt + fr) * 72 + ks * 32 + fq * 8), bV[ks], acc, 0, 0, 0);
            if (tc >= 1) {
#pragma unroll
                for (int r = 0; r < 4; ++r) Os[(16 * mt + 4 * fq + r) * 136 + vrow] = (bf16)f2bf(acc[r]); } }
#pragma unroll
        for (int mt = 0; mt < 8; ++mt) { f32x4 acc = S[mt] * gl;
#pragma unroll
            for (int ks = 0; ks < 2; ++ks) acc = __builtin_amdgcn_mfma_f32_16x16x32_bf16(*(const LAS bf16x8*)(KT + (16 * mt + fr) * 72 + (((4 * ks + fq) ^ ((2 * mt + (fr >> 3)) & 7)) << 3)), bV[ks], acc, 0, 0, 0);
            S[mt] = acc; v2u o; o.x = pk2(acc[0], acc[1]); o.y = pk2(acc[2], acc[3]); *(LAS v2u*)(St + vrow * 136 + 16 * mt + 4 * fq) = o; }
        asm volatile("s_waitcnt lgkmcnt(0)" ::: "memory");
      }
    }
#undef SC_PREFETCH
    __syncthreads();
    { const int tcp = (dir == 0) ? NCH - 1 : 1;
#pragma unroll
      for (int i = 0; i < 2; ++i) { const int id = tid + NTHR * i, row = id >> 4, c16 = id & 15;
          *(v4u*)(Od + ((size_t)b * SEQ + 64 * (tcp - 1) + row) * 512 + h * 128 + c16 * 8) = *(const LAS v4u*)(Os + row * 136 + c16 * 8); } }
    __syncthreads();
}
#define XB_TMO      128
#define XB_XCNT(j)  (256  + 64 * (j))
#define XB_XSUB(j)  (1280 + 64 * (j))
#define XB_XGEN(j)  (2304 + 64 * (j))
#define XB_TOP      3328
#define XB_TOPGEN   3392
#define XCD_BAR_WORDS 3456
#define XB_SPIN_CAP (1u << 18)

__device__ __forceinline__ unsigned xb_ld(unsigned* p)              { return __hip_atomic_load(p, __ATOMIC_RELAXED, __HIP_MEMORY_SCOPE_AGENT); }
__device__ __forceinline__ unsigned xb_add(unsigned* p, unsigned v) { return __hip_atomic_fetch_add(p, v, __ATOMIC_RELAXED, __HIP_MEMORY_SCOPE_AGENT); }
__device__ __forceinline__ unsigned xb_xcc_id() { return (unsigned)__builtin_amdgcn_s_getreg((3 << 11) | 20) & 0xFu; }
#define XB_SPIN(cond, bar) do { unsigned _sp = 0; while (cond) { __builtin_amdgcn_s_sleep(1); \
    if ((++_sp & 255u) == 0u) { if (xb_ld(&(bar)[XB_TMO])) break; if (_sp > XB_SPIN_CAP) { atomicAdd(&(bar)[XB_TMO], 1u); break; } } } } while (0)

struct XcdBarrier {
    unsigned* bar; unsigned x;
    volatile LAS unsigned* st;
};

__device__ __forceinline__ XcdBarrier xcd_barrier_post(unsigned* bar, volatile LAS unsigned* st) {
    XcdBarrier b; b.bar = bar; b.x = xb_xcc_id(); b.st = st;
    if (threadIdx.x == 0) (void)xb_add(&bar[XB_XCNT(b.x)], 1u);
    return b;
}
__device__ __forceinline__ void xcd_barrier_complete(unsigned* bar, unsigned x, unsigned& nloc, unsigned& nx) {
    const unsigned G = gridDim.x * gridDim.y * gridDim.z;
    unsigned sum, cnt, mine, sp = 0u;
    for (;;) {
        sum = 0u; cnt = 0u; mine = 0u;
#pragma unroll
        for (unsigned j = 0; j < 16; ++j) { const unsigned c = xb_ld(&bar[XB_XCNT(j)]); sum += c; cnt += (c > 0u) ? 1u : 0u; mine = (j == x) ? c : mine; }
        if (sum == G) break;
        __builtin_amdgcn_s_sleep(1);
        if ((++sp & 255u) == 0u) { if (xb_ld(&bar[XB_TMO])) break; if (sp > XB_SPIN_CAP) { atomicAdd(&bar[XB_TMO], 1u); break; } }
    }
    nloc = mine > 0u ? mine : 1u; nx = cnt > 0u ? cnt : 1u;
}

__device__ __forceinline__ void xcd_barrier(const XcdBarrier& b) {
    asm volatile("s_waitcnt vmcnt(0)" ::: "memory");
    __syncthreads();
    if (threadIdx.x == 0) {
        unsigned* bar = b.bar;
        __builtin_amdgcn_s_waitcnt(0);
        unsigned nloc = b.st[0], nx = b.st[1];
        if (nloc == 0u) { xcd_barrier_complete(bar, b.x, nloc, nx); b.st[0] = nloc; b.st[1] = nx; }
        const unsigned old = xb_add(&bar[XB_XSUB(b.x)], 1u);
        const unsigned gen = old / nloc;
        if (old + 1u == (gen + 1u) * nloc) {
            __builtin_amdgcn_fence(__ATOMIC_RELEASE, "agent");
            asm volatile("s_waitcnt vmcnt(0)" ::: "memory");
            const unsigned og = xb_add(&bar[XB_TOP], 1u);
            const unsigned tg = og / nx;
            if (og + 1u == (tg + 1u) * nx) xb_add(&bar[XB_TOPGEN], 1u);
            else XB_SPIN(xb_ld(&bar[XB_TOPGEN]) == tg, bar);
            __builtin_amdgcn_fence(__ATOMIC_ACQUIRE, "agent");
            xb_add(&bar[XB_XGEN(b.x)], 1u);
            asm volatile("s_waitcnt vmcnt(0)" ::: "memory");
        } else {
            XB_SPIN(xb_ld(&bar[XB_XGEN(b.x)]) == gen, bar);
            __builtin_amdgcn_fence(__ATOMIC_ACQUIRE, "agent");
            asm volatile("s_waitcnt vmcnt(0)" ::: "memory");
        }
    }
    __syncthreads();
}

__device__ __forceinline__ void dn_combine_panel(const Args& args, int pm, int wave, int lane) {
    unsigned char* ws = args.ws;
    const bf16* OF = (const bf16*)(ws + WS_OF); const bf16* OB = (const bf16*)(ws + WS_OB); const bf16* DZ = (const bf16*)(ws + WS_DZ); bf16* CAT = (bf16*)(ws + WS_CAT);
    const float* onw = args.in[6]; const int r0 = pm * 256;
            { int ln_ = lane; asm volatile("" : "+v"(ln_));
              float onv[8];
#pragma unroll
              for (int e = 0; e < 8; ++e) onv[e] = onw[(ln_ & 15) * 8 + e];
#pragma unroll 1
              for (int rb = wave * 32; rb < wave * 32 + 32; rb += 4) { v4u va[4], vc[4], vz[4];
#pragma unroll
                  for (int u = 0; u < 4; ++u) { const int r = r0 + rb + u, b = r >> 13, s = r & (SEQ - 1);
                      va[u] = *(const v4u*)(OF + (size_t)r * 512 + ln_ * 8); vc[u] = *(const v4u*)(OB + (size_t)r * 512 + ln_ * 8); vz[u] = *(const v4u*)(DZ + ((size_t)b * LT + NMETA + s) * 512 + ln_ * 8); }
#pragma unroll
                  for (int u = 0; u < 4; ++u) { const int r = r0 + rb + u; float a[8], c[8], z[8]; unpack8(va[u], a); unpack8(vc[u], c); unpack8(vz[u], z);
                      float ss = 0.f;
#pragma unroll
                      for (int e = 0; e < 8; ++e) { a[e] += c[e]; ss += a[e] * a[e]; }
                      ss += __shfl_xor(ss, 1); ss += __shfl_xor(ss, 2); ss += __shfl_xor(ss, 4); ss += __shfl_xor(ss, 8);
                      const float rs = __builtin_amdgcn_rsqf(ss * (1.f / 128.f) + EPS);
#pragma unroll
                      for (int e = 0; e < 8; ++e) a[e] = a[e] * rs * onv[e] * silu_f(z[e]);
                      *(v4u*)(CAT + (size_t)r * 1024 + ln_ * 8) = pack8(a); } } }
}

__global__ void __launch_bounds__(NWAVES * 64, 2) hymba_fwd(Args args) {
    extern __shared__ __attribute__((aligned(16))) unsigned char lds_raw[];
    LAS unsigned char* lds = (LAS unsigned char*)lds_raw;
    cg::grid_group grid = cg::this_grid();
    const int tid = threadIdx.x, lane = tid & 63, wave = __builtin_amdgcn_readfirstlane(tid >> 6);
    const int G = gridDim.x, bx = blockIdx.x;
    const int vcu = (G % 8 == 0) ? (bx % 8) * (G / 8) + bx / 8 : bx;
    const int gw = vcu * NWAVES + wave, NGW = G * NWAVES;
    unsigned char* ws = args.ws;
    const int lo = args.ph_lo, hi = args.ph_hi;
#define IN(k) (lo <= (k) && (k) < hi)
#define SEAM(k) do { if (IN(k) && IN((k) + 1)) xcd_barrier(xbar); } while (0)
    volatile LAS unsigned* xbst = (volatile LAS unsigned*)(lds + XBST_OFF);
    if (tid < 16) xbst[tid] = 0u;
    __syncthreads();
    const XcdBarrier xbar = xcd_barrier_post((unsigned*)(ws + WS_CTL) + 4096, xbst);
    bf16* Win_t = (bf16*)(ws + WS_WIN); bf16* Wout_t = (bf16*)(ws + WS_WOUT); bf16* Wup_t = (bf16*)(ws + WS_WUP); bf16* Wdn_t = (bf16*)(ws + WS_WDN);

    if (IN(0)) {
        LAS float* scr = (LAS float*)(lds + wave * 16384);
        constexpr int I_IN = (DM / 64) * (NIN / 32), I_OUT = (DM / 64) * (DM / 32), I_UP = (DM / 64) * (FF / 32), I_DN = (FF / 64) * (DM / 32);
        for (int it = gw; it < I_IN + I_OUT + I_UP + I_DN; it += NGW) {
            int r = it;
            if (r < I_IN) { p0_transpose_item<1>(args.in[2], DM, 2832, NIN, Win_t, scr, r, lane); continue; } r -= I_IN;
            if (r < I_OUT) { p0_transpose_item<0>(args.in[9], DM, DM, DM, Wout_t, scr, r, lane); continue; } r -= I_OUT;
            if (r < I_UP) { p0_transpose_item<0>(args.in[12], DM, FF, FF, Wup_t, scr, r, lane); continue; } r -= I_UP;
            p0_transpose_item<0>(args.in[13], FF, DM, DM, Wdn_t, scr, r, lane);
        }
        bf16* XN = (bf16*)(ws + WS_XN);
        { f32x4 wv[4];
#pragma unroll
          for (int j = 0; j < 4; ++j) wv[j] = ((const f32x4*)args.in[10] + lane)[64 * j];
          if (gw < NMETA) rms_row_to_bf16(args.in[1] + (size_t)gw * DM, args.in[10], XN + (size_t)(MR + gw) * DM, lane);
#pragma unroll 1
          for (int mb = gw; mb < MR; mb += 4 * NGW) { f32x4 xv[4][4];
#pragma unroll
              for (int u = 0; u < 4; ++u) { const f32x4* src = (const f32x4*)(args.in[0] + (size_t)(mb + u * NGW) * DM) + lane;
#pragma unroll
                  for (int j = 0; j < 4; ++j) xv[u][j] = src[64 * j]; }
#pragma unroll
              for (int u = 0; u < 4; ++u) { const int m = mb + u * NGW; float s = 0.f;
#pragma unroll
                  for (int j = 0; j < 4; ++j) s += (xv[u][j].x * xv[u][j].x + xv[u][j].y * xv[u][j].y) + (xv[u][j].z * xv[u][j].z + xv[u][j].w * xv[u][j].w);
                  const float rs = __builtin_amdgcn_rsqf(wave_sum(s) * (1.f / DM) + EPS);
                  v2u* o8 = (v2u*)(XN + (size_t)m * DM) + lane;
#pragma unroll
                  for (int j = 0; j < 4; ++j) { const f32x4 v = xv[u][j], ww = wv[j]; v2u o; o.x = pk2(v.x * rs * ww.x, v.y * rs * ww.y); o.y = pk2(v.z * rs * ww.z, v.w * rs * ww.w); o8[64 * j] = o; } } } }
    }
    SEAM(0);
    if (IN(1)) {
        if (gw < NIN / 16) {
            const int fr = lane & 15, fq = lane >> 4, nt = gw;
            const bf16* Ap = (const bf16*)(ws + WS_XN) + (size_t)(MR + fr) * DM + fq * 8; const bf16* Bp = Win_t + (size_t)(16 * nt + fr) * DM + fq * 8;
            f32x4 acc = (f32x4){0.f, 0.f, 0.f, 0.f};
#pragma unroll 8
            for (int ks = 0; ks < DM / 32; ++ks) acc = __builtin_amdgcn_mfma_f32_16x16x32_bf16(*(const bf16x8*)(Ap + ks * 32), *(const bf16x8*)(Bp + ks * 32), acc, 0, 0, 0);
            const int c = 16 * nt + fr;
            for (int b = 0; b < NB; ++b) {
#pragma unroll
                for (int r = 0; r < 4; ++r) { const size_t m = (size_t)b * LT + 4 * fq + r; const float v = acc[r];
                    if (c < 1536) ((bf16*)(ws + WS_DQKV))[m * 1536 + c] = (bf16)f2bf(v);
                    else if (c < 2048) ((bf16*)(ws + WS_DZ))[m * 512 + (c - 1536)] = (bf16)f2bf(v);
                    else if (c < 2816) ((bf16*)(ws + WS_AQKV))[m * 768 + (c - 2048)] = (bf16)f2bf(v);
                    else if (c < 2832) ((float*)(ws + WS_BA))[m * 16 + (c - 2816)] = v; } }
        }
        pg8::Gemm g{(const bf16*)(ws + WS_XN), Win_t, MR, NIN, DM}; pg8::StaticOrder S; S.init(MR, NIN, G, bx);
        pg8::EpiProj E{(bf16*)(ws + WS_DQKV), (bf16*)(ws + WS_DZ), (bf16*)(ws + WS_AQKV), (float*)(ws + WS_BA)};
        pg8::gemm_phase<pg8::EpiProj, pg8::StaticOrder, true, true>(lds, g, S, E);
    }
    SEAM(1);
    if (IN(2)) {
        { LAS float* rope = (LAS float*)(lds + ROPE_OFF);
#pragma unroll 1
          for (int e = 0; e < 4; ++e) { const int idx = tid + NTHR * e, pos = idx >> 4, f = idx & 15; float sv, cv; sincosf((float)pos * exp2f(-(float)f * (13.287712379549449f / 16.f)), &sv, &cv); rope[idx] = cv; rope[2048 + idx] = sv; }
          __syncthreads(); }
        { v4u rawv[7]; float cwv[4]; float pbb = 0.f, paa = 0.f;
          const bf16* DQKV = (const bf16*)(ws + WS_DQKV); const float* BA = (const float*)(ws + WS_BA); const float* conv_w = args.in[3];
          for (int item = bx; item < NB * NCH * 4; item += G) dn_prep_item(args, lds, item, item + G, rawv, cwv, pbb, paa, tid, wave, lane); }
        { const bf16* AQ = (const bf16*)(ws + WS_AQKV); const LAS float* rope = (const LAS float*)(lds + ROPE_OFF);
          constexpr int NGRP = NB * LKP / 4, HEAVY_G = 18; const int extra = (NB * NCH * 4) % G;
          int gs, ge;
          if (bx < extra) { gs = bx * HEAVY_G; ge = gs + HEAVY_G; }
          else { const long rem = NGRP - (long)extra * HEAVY_G; const int nl = G - extra; gs = extra * HEAVY_G + (int)(((long)(bx - extra) * rem) / nl); ge = extra * HEAVY_G + (int)(((long)(bx - extra + 1) * rem) / nl); }
#pragma unroll 1
          for (int g = gs + wave; g < ge; g += NWAVES) { v4u qd[4], kd[4];
#pragma unroll
              for (int u = 0; u < 4; ++u) { const int i_ = 4 * g + u, b = i_ / LKP, t = i_ % LKP, tq = t < LT ? t : LT - 1;
                  const bf16* row = AQ + (size_t)(b * LT + tq) * 768; qd[u] = *(const v4u*)(row + lane * 8); kd[u] = *(const v4u*)(row + 512 + (lane & 31) * 8); }
#pragma unroll
              for (int u = 0; u < 4; ++u) { const int i_ = 4 * g + u;
                  attn_prep_row(qd[u], kd[u], rope, args.in[7], args.in[8], (bf16*)(ws + WS_Q), (bf16*)(ws + WS_KB), (bf16*)(ws + WS_VB), i_ / LKP, i_ % LKP, lane); } } }
    }
    SEAM(2);
    if (IN(3)) {
        unsigned* ctl = (unsigned*)(ws + WS_CTL);
        for (int chain = bx; chain < NB * 8; chain += G) { dn_scan(args, lds, chain, tid, wave, lane);
            asm volatile("s_waitcnt vmcnt(0)" ::: "memory"); __syncthreads();
            if (tid == 0) { __builtin_amdgcn_fence(__ATOMIC_RELEASE, "agent"); asm volatile("s_waitcnt vmcnt(0)" ::: "memory"); __hip_atomic_fetch_add(ctl + 64 * 12, 1u, __ATOMIC_RELAXED, __HIP_MEMORY_SCOPE_AGENT); } }
        volatile LAS int* slot = (volatile LAS int*)(lds + QSLOT_OFF);
        const unsigned xcc = xcc_id() & 7u;
        for (;;) {
            if (tid == 0) { int u = -1;
                for (unsigned k = 0; k < 8; ++k) { const unsigned q = (xcc + k) & 7u; const unsigned idx = __hip_atomic_fetch_add(ctl + 64 * (1 + q), 1u, __ATOMIC_RELAXED, __HIP_MEMORY_SCOPE_AGENT); if (idx < 256u) { u = (int)(q * 512u + idx); break; } }
                if (u < 0) { const unsigned p = __hip_atomic_fetch_add(ctl + 64 * 13, 1u, __ATOMIC_RELAXED, __HIP_MEMORY_SCOPE_AGENT); if (p < 256u) u = (int)((p >> 5) * 512u + 256u + (p & 31u)); }
                if (u >= 0 && (u & 511) >= 256) {
                    unsigned sp = 0; while (__hip_atomic_load(ctl + 64 * 12, __ATOMIC_RELAXED, __HIP_MEMORY_SCOPE_AGENT) < (unsigned)(NB * 8) && ++sp < (1u << 22)) __builtin_amdgcn_s_sleep(2);
                    __builtin_amdgcn_fence(__ATOMIC_ACQUIRE, "agent"); asm volatile("s_waitcnt vmcnt(0)" ::: "memory"); }
                *slot = u; }
            __syncthreads();
            const int u = *slot;
            __syncthreads();
            if (u < 0) break;
            if ((u & 511) >= 256) { dn_combine_panel(args, (u >> 9) * 32 + ((u & 511) - 256), wave, lane); continue; }
            const int q = u >> 9, idx = u & 255, pair = q * 2 + (idx >> 7), gh = (idx >> 5) & 3, qb = idx & 31, b = pair >> 1, kvh = pair & 1, h = kvh * 4 + gh;
            const attn_body::bf16* Qu = (const attn_body::bf16*)(ws + WS_Q) + ((size_t)(b * SEQ + qb * 256)) * 512 + h * 64;
            const attn_body::bf16* Kh = (const attn_body::bf16*)(ws + WS_KB) + ((size_t)(b * 2 + kvh) * LKP) * 64;
            const attn_body::bf16* Vh = (const attn_body::bf16*)(ws + WS_VB) + ((size_t)(b * 2 + kvh) * LKP) * 64;
            attn_body::bf16* Ou = (attn_body::bf16*)(ws + WS_CAT) + ((size_t)(b * SEQ + qb * 256)) * 1024 + 512 + h * 64;
            attn_body::attn_unit<8>(Qu, Kh, Vh, Ou, (char*)lds_raw);
        }
    }
    SEAM(3);
    if (IN(4)) {
#define CU_LOCAL_SYNC() do { asm volatile("s_waitcnt vmcnt(0)" ::: "memory"); __syncthreads(); __builtin_amdgcn_fence(__ATOMIC_ACQUIRE, "agent"); asm volatile("s_waitcnt vmcnt(0)" ::: "memory"); } while (0)
        const bf16* OF = (const bf16*)(ws + WS_OF); const bf16* OB = (const bf16*)(ws + WS_OB); const bf16* DZ = (const bf16*)(ws + WS_DZ); bf16* CAT = (bf16*)(ws + WS_CAT);
        bf16* MIXB = (bf16*)(ws + WS_MIX); bf16* XN2 = (bf16*)(ws + WS_CAT);
        const float* onw = args.in[6];
        if (bx < MR / 256) { const int pm = bx;
            const int r0 = pm * 256;
            { pg8::Gemm g{(const bf16*)CAT, Wout_t, MR, DM, DM}; pg8::PanelOrder S{pm, DM / 256};
              pg8::EpiBf16<0> E{MIXB, DM, nullptr, 0, 0, 1.f};
              pg8::gemm_phase<pg8::EpiBf16<0>, pg8::PanelOrder, true, true>(lds, g, S, E); }
            CU_LOCAL_SYNC();
            { int ln_ = lane; asm volatile("" : "+v"(ln_));
              f32x4 w1v[4], w2v[4];
#pragma unroll
              for (int j = 0; j < 4; ++j) { w1v[j] = ((const f32x4*)args.in[11] + ln_)[64 * j]; w2v[j] = ((const f32x4*)args.in[14] + ln_)[64 * j]; }
#pragma unroll 1
              for (int rb = wave * 32; rb < wave * 32 + 32; rb += 4) { v2u mv[4][4]; f32x4 xv[4][4];
#pragma unroll
                  for (int u = 0; u < 4; ++u) { const int r = r0 + rb + u; const v2u* mr = (const v2u*)(MIXB + (size_t)r * DM) + ln_; const f32x4* xr = (const f32x4*)(args.in[0] + (size_t)r * DM) + ln_;
#pragma unroll
                      for (int j = 0; j < 4; ++j) { mv[u][j] = mr[64 * j]; xv[u][j] = xr[64 * j]; } }
#pragma unroll
                  for (int u = 0; u < 4; ++u) { const int r = r0 + rb + u; f32x4 v[4]; float s = 0.f;
#pragma unroll
                      for (int j = 0; j < 4; ++j) { const v2u m = mv[u][j]; v[j] = (f32x4){__builtin_bit_cast(float, m.x << 16), __builtin_bit_cast(float, m.x & 0xffff0000u), __builtin_bit_cast(float, m.y << 16), __builtin_bit_cast(float, m.y & 0xffff0000u)};
                          s += (v[j].x * v[j].x + v[j].y * v[j].y) + (v[j].z * v[j].z + v[j].w * v[j].w); }
                      const float rs = __builtin_amdgcn_rsqf(wave_sum(s) * (1.f / DM) + EPS); float s2 = 0.f;
                      f32x4* orow = (f32x4*)(args.out + (size_t)r * DM) + ln_;
#pragma unroll
                      for (int j = 0; j < 4; ++j) { v[j] = xv[u][j] + v[j] * rs * w1v[j]; orow[64 * j] = v[j]; s2 += (v[j].x * v[j].x + v[j].y * v[j].y) + (v[j].z * v[j].z + v[j].w * v[j].w); }
                      const float rs2 = __builtin_amdgcn_rsqf(wave_sum(s2) * (1.f / DM) + EPS);
                      v2u* o8 = (v2u*)(XN2 + (size_t)r * DM) + ln_;
#pragma unroll
                      for (int j = 0; j < 4; ++j) { const f32x4 ww = w2v[j]; v2u o; o.x = pk2(v[j].x * rs2 * ww.x, v[j].y * rs2 * ww.y); o.y = pk2(v[j].z * rs2 * ww.z, v[j].w * rs2 * ww.w); o8[64 * j] = o; } } } }
            CU_LOCAL_SYNC();
        }
#undef CU_LOCAL_SYNC
    }
    SEAM(4);
    if (IN(5)) {
        pg8::Gemm g{(const bf16*)(ws + WS_CAT), Wup_t, MR, FF, DM}; pg8::StaticOrder S; S.init(MR, FF, G, bx);
        pg8::EpiRelu2 E{(bf16*)(ws + WS_HID), FF};
        pg8::gemm_phase<pg8::EpiRelu2, pg8::StaticOrder, true, true>(lds, g, S, E);
    }
    SEAM(5);
    if (IN(6)) {
        pg8::Gemm g{(const bf16*)(ws + WS_HID), Wdn_t, MR, DM, FF}; pg8::StaticOrder S; S.init(MR, DM, G, bx);
        pg8::EpiBf16<0> E{(bf16*)(ws + WS_MIX), DM, nullptr, 0, 0, 1.f};
        pg8::gemm_phase<pg8::EpiBf16<0>, pg8::StaticOrder, true, true>(lds, g, S, E);
    }
    SEAM(6);
    if (IN(7)) {
        const bf16* MIXB = (const bf16*)(ws + WS_MIX);
        f32x4 w1v[4];
#pragma unroll
        for (int j = 0; j < 4; ++j) w1v[j] = ((const f32x4*)args.in[15] + lane)[64 * j];
#pragma unroll 1
        for (int rb = gw; rb < MR; rb += 4 * NGW) { v2u mv[4][4]; f32x4 hv[4][4];
#pragma unroll
            for (int u = 0; u < 4; ++u) { const int r = rb + u * NGW; const v2u* mr = (const v2u*)(MIXB + (size_t)r * DM) + lane; const f32x4* hr = (const f32x4*)(args.out + (size_t)r * DM) + lane;
#pragma unroll
                for (int j = 0; j < 4; ++j) { mv[u][j] = mr[64 * j]; hv[u][j] = hr[64 * j]; } }
#pragma unroll
            for (int u = 0; u < 4; ++u) { const int r = rb + u * NGW; f32x4 v[4]; float s = 0.f;
#pragma unroll
                for (int j = 0; j < 4; ++j) { const v2u m = mv[u][j]; v[j] = (f32x4){__builtin_bit_cast(float, m.x << 16), __builtin_bit_cast(float, m.x & 0xffff0000u), __builtin_bit_cast(float, m.y << 16), __builtin_bit_cast(float, m.y & 0xffff0000u)};
                    s += (v[j].x * v[j].x + v[j].y * v[j].y) + (v[j].z * v[j].z + v[j].w * v[j].w); }
                const float rs = __builtin_amdgcn_rsqf(wave_sum(s) * (1.f / DM) + EPS);
                f32x4* orow = (f32x4*)(args.out + (size_t)r * DM) + lane;
#pragma unroll
                for (int j = 0; j < 4; ++j) orow[64 * j] = hv[u][j] + v[j] * rs * w1v[j]; } }
    }
    if (lo == 0 && hi == NPHASE) grid.sync();
#undef IN
#undef SEAM
}

extern "C" void kernel_launch(void* const* d_in, const int* in_sizes, int n_in, void* d_out, int out_size, void* d_ws, size_t ws_size, hipStream_t stream) {
    static int grid = 0;
    if (grid == 0) {
        if (n_in != 16 || in_sizes[0] != MR * DM || out_size != MR * DM || ws_size < WS_END) { fprintf(stderr, "kernel_launch: unexpected shapes / workspace (n_in %d, in0 %d, out %d, ws %zu)\n", n_in, n_in > 0 ? in_sizes[0] : -1, out_size, ws_size); grid = -1; return; }
        int dev = 0, cus = 0, per_cu = 0;
        if (hipGetDevice(&dev) != hipSuccess || hipDeviceGetAttribute(&cus, hipDeviceAttributeMultiprocessorCount, dev) != hipSuccess) { grid = -1; return; }
        if (hipFuncSetAttribute((const void*)hymba_fwd, hipFuncAttributeMaxDynamicSharedMemorySize, LDS_BYTES) != hipSuccess) { fprintf(stderr, "kernel_launch: hipFuncSetAttribute failed\n"); grid = -1; return; }
        if (hipOccupancyMaxActiveBlocksPerMultiprocessor(&per_cu, (const void*)hymba_fwd, NWAVES * 64, LDS_BYTES) != hipSuccess || per_cu < 1) { fprintf(stderr, "kernel_launch: occupancy query says %d\n", per_cu); per_cu = 1; }
        (void)hipGetLastError();
        grid = cus >= 256 ? 256 : cus;
        if (grid != 256) fprintf(stderr, "kernel_launch: %d CUs: this build needs 256 workgroups\n", cus);
    }
    if (grid < 0) return;
    (void)hipMemsetAsync((char*)d_ws + WS_CTL, 0, CTL_ZERO_BYTES, stream);
    Args a{};
    for (int i = 0; i < 16; ++i) a.in[i] = (const float*)d_in[i];
    a.out = (float*)d_out; a.ws = (unsigned char*)d_ws;
#if ONE_LAUNCH
    a.ph_lo = 0; a.ph_hi = NPHASE;
    void* kargs[] = {&a};
    hipError_t e = hipLaunchCooperativeKernel((const void*)hymba_fwd, dim3(grid), dim3(NWAVES * 64), kargs, LDS_BYTES, stream);
    if (e != hipSuccess) fprintf(stderr, "kernel_launch: cooperative launch failed: %s (grid %d)\n", hipGetErrorString(e), grid);
#else
    for (int p = 0; p < NPHASE; ++p) { a.ph_lo = p; a.ph_hi = p + 1; hipLaunchKernelGGL(hymba_fwd, dim3(grid), dim3(NWAVES * 64), LDS_BYTES, stream, a); }
#endif
}
```
